# Optimizing an MI355X kernel written in HIP

```python
import math
import jax, jax.numpy as jnp
from jax import lax
import numpy as np

D_MODEL = 1024
BATCH = 4
SEQ = 4096
DEPTH = 4

PLE_DIM = 256
D_FF = 2816
EPS = 1e-6

GLA_HEADS = 4
GLA_DK = 64
GLA_DV = 128
GLA_KW = GLA_HEADS * GLA_DK
GLA_VW = GLA_HEADS * GLA_DV
GLA_GATE_RANK = 16
GLA_GATE_TAU = 16.0
GLA_CHUNK = 64
LRU_WIDTH = 512
LRU_BLOCKS = 8
LRU_BLOCK_W = LRU_WIDTH // LRU_BLOCKS
LRU_CONV_W = 4
LRU_C = 8.0
HYB_IN = 2 * GLA_KW + 2 * GLA_VW + GLA_GATE_RANK + 2 * LRU_WIDTH
HYB_MIX = GLA_VW + LRU_WIDTH

SWA_HEADS = 16
SWA_KV_HEADS = 4
SWA_HEAD_DIM = 64
SWA_GROUP = SWA_HEADS // SWA_KV_HEADS
SWA_WINDOW = 128
SWA_BLOCK = 128
SWA_QKV = (SWA_HEADS + 2 * SWA_KV_HEADS) * SWA_HEAD_DIM

REL_BUCKETS = 32
REL_MAX_DIST = 128

N_EVEN = (DEPTH + 1) // 2
N_ODD = DEPTH // 2

kernel_name = "hybrid_gla_rglru_swa_macaron"


def rms_norm(x, g):
    xf = x.astype(jnp.float32)
    y = xf * lax.rsqrt(jnp.mean(xf * xf, axis=-1, keepdims=True) + EPS)
    return (y * g.astype(jnp.float32)).astype(x.dtype)


def swiglu(x, w_gate, w_up, w_down):
    return (jax.nn.silu(x @ w_gate) * (x @ w_up)) @ w_down


def t5_bucket(dist):
    max_exact = REL_BUCKETS // 2
    d = jnp.maximum(dist, 1).astype(jnp.float32)
    large = max_exact + (jnp.log(d / max_exact) / math.log(REL_MAX_DIST / max_exact)
                         * (REL_BUCKETS - max_exact)).astype(jnp.int32)
    large = jnp.minimum(large, REL_BUCKETS - 1)
    return jnp.where(dist < max_exact, dist, large)


def gla(q, k, v, log_f, r, norm_g):
    B, S, _ = q.shape
    N = S // GLA_CHUNK
    C = GLA_CHUNK

    def split(t, d):
        return t.reshape(B, N, C, GLA_HEADS, d).transpose(0, 3, 1, 2, 4).astype(jnp.float32)

    qc = split(q, GLA_DK) * (GLA_DK ** -0.5)
    kc = split(k, GLA_DK)
    vc = split(v, GLA_DV)
    b = jnp.cumsum(split(log_f, GLA_DK), axis=3)
    b_last = b[..., -1:, :]
    q_dec = qc * jnp.exp(b)
    k_dec = kc * jnp.exp(-b)
    causal = jnp.tril(jnp.ones((C, C), dtype=bool))
    att = jnp.where(causal, jnp.einsum('bhnik,bhnjk->bhnij', q_dec, k_dec), 0.0)
    o_intra = jnp.einsum('bhnij,bhnjv->bhniv', att, vc)
    kv = jnp.einsum('bhnjk,bhnjv->bhnkv', kc * jnp.exp(b_last - b), vc)
    decay = jnp.exp(b_last[..., 0, :])

    def step(state, inp):
        d, u = inp
        return d[..., None] * state + u, state

    s0 = jnp.zeros((B, GLA_HEADS, GLA_DK, GLA_DV), jnp.float32)
    _, s_prev = lax.scan(step, s0, (jnp.moveaxis(decay, 2, 0), jnp.moveaxis(kv, 2, 0)))
    s_prev = jnp.moveaxis(s_prev, 0, 2)
    o = o_intra + jnp.einsum('bhnik,bhnkv->bhniv', q_dec, s_prev)
    o = o * lax.rsqrt(jnp.mean(o * o, axis=-1, keepdims=True) + EPS)
    o = o.transpose(0, 2, 3, 1, 4).reshape(B, S, GLA_VW)
    o = o * norm_g.astype(jnp.float32) * jax.nn.silu(r.astype(jnp.float32))
    return o.astype(v.dtype)


def causal_dwconv(x, w, b):
    S = x.shape[1]
    K = w.shape[0]
    xp = jnp.pad(x, ((0, 0), (K - 1, 0), (0, 0)))
    out = xp[:, 0:S] * w[0]
    for tap in range(1, K):
        out = out + xp[:, tap:tap + S] * w[tap]
    return out + b


def rg_lru(x, w_a, b_a, w_x, b_x, lam):
    B, S, _ = x.shape
    xf = x.astype(jnp.float32)
    xb = xf.reshape(B, S, LRU_BLOCKS, LRU_BLOCK_W)
    r = jax.nn.sigmoid(jnp.einsum('bsgi,gij->bsgj', xb, w_a.astype(jnp.float32)).reshape(B, S, LRU_WIDTH) + b_a)
    i = jax.nn.sigmoid(jnp.einsum('bsgi,gij->bsgj', xb, w_x.astype(jnp.float32)).reshape(B, S, LRU_WIDTH) + b_x)
    log_a = -LRU_C * r * jax.nn.softplus(-lam.astype(jnp.float32))
    a = jnp.exp(log_a)
    u = jnp.sqrt(-jnp.expm1(2.0 * log_a)) * (i * xf)

    def combine(left, right):
        a1, b1 = left
        a2, b2 = right
        return a1 * a2, a2 * b1 + b2

    _, h = lax.associative_scan(combine, (a, u), axis=1)
    return h.astype(x.dtype)


def hybrid_mixer(h, w_in, w_out, gla_w_fup, gla_b_f, gla_norm, conv_w, conv_b,
                 lru_w_a, lru_b_a, lru_w_x, lru_b_x, lru_lambda):
    z = h @ w_in
    sizes = (GLA_KW, GLA_KW, GLA_VW, GLA_VW, GLA_GATE_RANK, LRU_WIDTH, LRU_WIDTH)
    idx = [int(c) for c in np.cumsum(sizes)[:-1]]
    q, k, v, r, f_low, xr, gr = jnp.split(z, idx, axis=-1)
    log_f = jax.nn.log_sigmoid((f_low @ gla_w_fup + gla_b_f).astype(jnp.float32)) / GLA_GATE_TAU
    o_a = gla(q, k, v, log_f, r, gla_norm)
    xr = causal_dwconv(xr, conv_w, conv_b)
    o_b = rg_lru(xr, lru_w_a, lru_b_a, lru_w_x, lru_b_x, lru_lambda) * jax.nn.gelu(gr)
    return jnp.concatenate([o_a, o_b], axis=-1) @ w_out


def swa(h, w_qkv, b_qkv, w_o, b_o, sinks, rel_bias):
    B, S, _ = h.shape
    NB = S // SWA_BLOCK
    BLK = SWA_BLOCK
    z = h @ w_qkv + b_qkv
    q, k, v = jnp.split(z, [SWA_HEADS * SWA_HEAD_DIM, (SWA_HEADS + SWA_KV_HEADS) * SWA_HEAD_DIM], axis=-1)
    q = q.reshape(B, NB, BLK, SWA_KV_HEADS, SWA_GROUP, SWA_HEAD_DIM)
    k = k.reshape(B, S, SWA_KV_HEADS, SWA_HEAD_DIM)
    v = v.reshape(B, S, SWA_KV_HEADS, SWA_HEAD_DIM)

    def band(t):
        prev = jnp.pad(t, ((0, 0), (BLK, 0), (0, 0), (0, 0)))[:, :S]
        return jnp.concatenate([prev.reshape(B, NB, BLK, SWA_KV_HEADS, SWA_HEAD_DIM),
                                t.reshape(B, NB, BLK, SWA_KV_HEADS, SWA_HEAD_DIM)], axis=2)

    kb, vb = band(k), band(v)
    scores = jnp.einsum('bnqhgd,bnkhd->bnhgqk', q, kb).astype(jnp.float32) * (SWA_HEAD_DIM ** -0.5)
    qi = jnp.arange(BLK)[:, None] + BLK
    kj = jnp.arange(2 * BLK)[None, :]
    dist = qi - kj
    bias = rel_bias.astype(jnp.float32)[t5_bucket(jnp.maximum(dist, 0))]
    bias = bias.transpose(2, 0, 1).reshape(SWA_KV_HEADS, SWA_GROUP, BLK, 2 * BLK)
    key_pos = jnp.arange(NB)[:, None] * BLK - BLK + kj
    valid = (dist >= 0) & (dist < SWA_WINDOW) & (key_pos[:, None, :] >= 0)
    scores = jnp.where(valid[None, :, None, None], scores + bias, -1e30)
    sink = jnp.broadcast_to(sinks.astype(jnp.float32).reshape(1, 1, SWA_KV_HEADS, SWA_GROUP, 1, 1),
                            scores.shape[:-1] + (1,))
    probs = jax.nn.softmax(jnp.concatenate([scores, sink], axis=-1), axis=-1)[..., :-1]
    o = jnp.einsum('bnhgqk,bnkhd->bnqhgd', probs.astype(v.dtype), vb)
    o = o.reshape(B, S, SWA_HEADS * SWA_HEAD_DIM)
    return o @ w_o + b_o


def setup_inputs(seed: int = 0) -> dict:
    key = jax.random.key(seed)
    ks = iter(jax.random.split(key, 48))

    def nrm(shape, scale):
        return jax.random.normal(next(ks), shape, jnp.float32) * scale

    def gain(shape):
        return 1.0 + nrm(shape, 0.02)

    a_init = jax.random.uniform(next(ks), (N_EVEN, LRU_WIDTH), jnp.float32, 0.9, 0.999)
    return {
        "x": nrm((BATCH, SEQ, D_MODEL), 1.0),
        "p": nrm((DEPTH, BATCH, SEQ, PLE_DIM), 1.0),
        "rel_bias": nrm((REL_BUCKETS, SWA_HEADS), 0.5),
        "final_norm": gain((D_MODEL,)),
        "ffn1_norm": gain((DEPTH, D_MODEL)),
        "ffn1_w_gate": nrm((DEPTH, D_MODEL, D_FF), D_MODEL ** -0.5),
        "ffn1_w_up": nrm((DEPTH, D_MODEL, D_FF), D_MODEL ** -0.5),
        "ffn1_w_down": nrm((DEPTH, D_FF, D_MODEL), D_FF ** -0.5),
        "mix_norm": gain((DEPTH, D_MODEL)),
        "ffn2_norm": gain((DEPTH, D_MODEL)),
        "ffn2_w_gate": nrm((DEPTH, D_MODEL, D_FF), D_MODEL ** -0.5),
        "ffn2_w_up": nrm((DEPTH, D_MODEL, D_FF), D_MODEL ** -0.5),
        "ffn2_w_down": nrm((DEPTH, D_FF, D_MODEL), D_FF ** -0.5),
        "ple_norm": gain((DEPTH, D_MODEL)),
        "ple_w_proj": nrm((DEPTH, PLE_DIM, D_MODEL), PLE_DIM ** -0.5),
        "ple_w_gate": nrm((DEPTH, D_MODEL, D_MODEL), D_MODEL ** -0.5),
        "hyb_w_in": nrm((N_EVEN, D_MODEL, HYB_IN), D_MODEL ** -0.5),
        "hyb_w_out": nrm((N_EVEN, HYB_MIX, D_MODEL), HYB_MIX ** -0.5),
        "gla_w_fup": nrm((N_EVEN, GLA_GATE_RANK, GLA_KW), GLA_GATE_RANK ** -0.5),
        "gla_b_f": nrm((N_EVEN, GLA_KW), 0.1),
        "gla_norm": gain((N_EVEN, GLA_VW)),
        "lru_conv_w": nrm((N_EVEN, LRU_CONV_W, LRU_WIDTH), LRU_CONV_W ** -0.5),
        "lru_conv_b": nrm((N_EVEN, LRU_WIDTH), 0.02),
        "lru_w_a": nrm((N_EVEN, LRU_BLOCKS, LRU_BLOCK_W, LRU_BLOCK_W), LRU_BLOCK_W ** -0.5),
        "lru_b_a": nrm((N_EVEN, LRU_WIDTH), 0.02),
        "lru_w_x": nrm((N_EVEN, LRU_BLOCKS, LRU_BLOCK_W, LRU_BLOCK_W), LRU_BLOCK_W ** -0.5),
        "lru_b_x": nrm((N_EVEN, LRU_WIDTH), 0.02),
        "lru_lambda": jnp.log(a_init) - jnp.log1p(-a_init),
        "swa_w_qkv": nrm((N_ODD, D_MODEL, SWA_QKV), D_MODEL ** -0.5),
        "swa_b_qkv": nrm((N_ODD, SWA_QKV), 0.02),
        "swa_w_o": nrm((N_ODD, SWA_HEADS * SWA_HEAD_DIM, D_MODEL), (SWA_HEADS * SWA_HEAD_DIM) ** -0.5),
        "swa_b_o": nrm((N_ODD, D_MODEL), 0.02),
        "swa_sinks": nrm((N_ODD, SWA_HEADS), 0.5),
    }


def reference(x, p, rel_bias, final_norm,
              ffn1_norm, ffn1_w_gate, ffn1_w_up, ffn1_w_down,
              mix_norm,
              ffn2_norm, ffn2_w_gate, ffn2_w_up, ffn2_w_down,
              ple_norm, ple_w_proj, ple_w_gate,
              hyb_w_in, hyb_w_out, gla_w_fup, gla_b_f, gla_norm,
              lru_conv_w, lru_conv_b, lru_w_a, lru_b_a, lru_w_x, lru_b_x, lru_lambda,
              swa_w_qkv, swa_b_qkv, swa_w_o, swa_b_o, swa_sinks):
    for i in range(DEPTH):
        x = x + 0.5 * swiglu(rms_norm(x, ffn1_norm[i]), ffn1_w_gate[i], ffn1_w_up[i], ffn1_w_down[i])
        h = rms_norm(x, mix_norm[i])
        if i % 2 == 0:
            e = i // 2
            x = x + hybrid_mixer(h, hyb_w_in[e], hyb_w_out[e], gla_w_fup[e], gla_b_f[e], gla_norm[e],
                                 lru_conv_w[e], lru_conv_b[e], lru_w_a[e], lru_b_a[e],
                                 lru_w_x[e], lru_b_x[e], lru_lambda[e])
        else:
            o = i // 2
            x = x + swa(h, swa_w_qkv[o], swa_b_qkv[o], swa_w_o[o], swa_b_o[o], swa_sinks[o], rel_bias)
        x = x + 0.5 * swiglu(rms_norm(x, ffn2_norm[i]), ffn2_w_gate[i], ffn2_w_up[i], ffn2_w_down[i])
        gate = jax.nn.sigmoid(rms_norm(x, ple_norm[i]) @ ple_w_gate[i])
        x = x + gate * (p[i] @ ple_w_proj[i])
    return rms_norm(x, final_norm)
```

```cpp
#include <hip/hip_runtime.h>
#include <hip/hip_cooperative_groups.h>
#include <cstdio>
namespace cg = cooperative_groups;

#ifndef COOP
#define COOP 0
#endif

#define LAS __attribute__((address_space(3)))
typedef unsigned short bf16_t;
typedef short bf16x8 __attribute__((ext_vector_type(8)));
typedef float f32x4 __attribute__((ext_vector_type(4)));
typedef float f32x2 __attribute__((ext_vector_type(2)));
typedef unsigned u32x4 __attribute__((ext_vector_type(4)));
typedef unsigned u32x2 __attribute__((ext_vector_type(2)));

constexpr int T = 16384, D = 1024, FF = 2816, SEQ = 4096;
constexpr int ZW = 2816, QKVW = 1536;
constexpr float EPS = 1e-6f;
constexpr int NTHREADS = 512;
constexpr int LDS_BYTES = 147456;

constexpr size_t WS_SSQ = 0;
constexpr size_t WS_WUP = 2097152;
constexpr size_t WS_WDN = WS_WUP + 8ull * 5632 * 1024 * 2;
constexpr size_t WS_WIN = WS_WDN + 8ull * 1024 * 2816 * 2;
constexpr size_t WS_WOUT = WS_WIN + 2ull * 2816 * 1024 * 2;
constexpr size_t WS_WQKV = WS_WOUT + 2ull * 1024 * 1024 * 2;
constexpr size_t WS_WO = WS_WQKV + 2ull * 1536 * 1024 * 2;
constexpr size_t WS_WPG = WS_WO + 2ull * 1024 * 1024 * 2;
constexpr size_t WS_WPP = WS_WPG + 4ull * 1024 * 1024 * 2;
constexpr size_t WS_XB = WS_WPP + 4ull * 1024 * 256 * 2;
constexpr size_t WS_PB = WS_XB + (size_t)T * 1024 * 2;
constexpr size_t WS_HZ = WS_PB + 4ull * T * 256 * 2;
constexpr size_t WS_MIX = WS_HZ + (size_t)T * 2816 * 2;
constexpr size_t WS_SCR = WS_MIX + (size_t)T * 1024 * 2;
constexpr size_t WS_S = WS_SCR;
constexpr size_t WS_HL = WS_S + 1024ull * 8192 * 4;
constexpr size_t WS_AC = WS_HL + (size_t)T * 512 * 4;
constexpr size_t WS_CARRY = WS_AC + (size_t)T * 512 * 4;
constexpr size_t WS_DECAY = WS_CARRY + 4ull * 64 * 512 * 4;
constexpr size_t WS_END = WS_DECAY + 1024ull * 64 * 4;
constexpr size_t WS_PP = WS_SCR;

struct Params {
    const float* in[33];
    float* out;
    unsigned char* ws;
    int ph_lo, ph_hi;
};

__device__ __forceinline__ float bf_lo(unsigned w) { return __uint_as_float(w << 16); }
__device__ __forceinline__ float bf_hi(unsigned w) { return __uint_as_float(w & 0xffff0000u); }
__device__ __forceinline__ unsigned f2bf(float f) { unsigned u = __float_as_uint(f); return (u + 0x7fffu + ((u >> 16) & 1u)) >> 16; }
__device__ __forceinline__ unsigned pk2(float lo, float hi) { return f2bf(lo) | (f2bf(hi) << 16); }
__device__ __forceinline__ float sigmoidf_(float x) { return 1.0f / (1.0f + __expf(-x)); }
__device__ __forceinline__ float siluf_(float x) { return x / (1.0f + __expf(-x)); }
__device__ __forceinline__ float gelu_tanh(float x) { const float y = 0.7978845608028654f * (x + 0.044715f * x * x * x); return x / (1.0f + __expf(-2.0f * y)); }
__device__ __forceinline__ float softplusf_(float x) { return fmaxf(x, 0.f) + log1pf(__expf(-fabsf(x))); }
__device__ __forceinline__ float logsigmoidf_(float x) { return fminf(x, 0.f) - log1pf(__expf(-fabsf(x))); }
__device__ __forceinline__ int otid() { int t = threadIdx.x; asm volatile("" : "+v"(t)); return t; }
__device__ __forceinline__ int obid() { int b = blockIdx.x; asm volatile("" : "+s"(b)); return b; }
__device__ __forceinline__ int ogrid() { int g = gridDim.x; asm volatile("" : "+s"(g)); return g; }
__device__ __forceinline__ float wave_sum(float v) {
#pragma unroll
    for (int o = 1; o < 64; o <<= 1) v += __shfl_xor(v, o);
    return v;
}

namespace pg8 {
constexpr int BM = 256, BK = 64, HALF = 128, HTB = HALF * BK * 2, STAGE_BYTES = 8 * HTB, NXCD = 8, WGM = 8;
__host__ __device__ __forceinline__ int lds_byte(int r, int c) { const int st = (r >> 4) * 2 + (c >> 5), rr = r & 15, cc = c & 31, ob = rr * 64 + cc * 2; return st * 1024 + (ob ^ (((ob >> 9) & 1) << 5)); }
__host__ __device__ __forceinline__ void stage_rc(int b, int& R, int& C) { const int st = b / 1024, sb = b % 1024, swz = sb ^ (((sb >> 9) & 1) << 5); R = (st >> 1) * 16 + swz / 64; C = (st & 1) * 32 + (swz % 64) / 2; }
struct Unit { int pm, pn; };
struct Gemm { const bf16_t* A; const bf16_t* Bt; int M, N, K; };
struct StaticOrder {
    int nM, nN, nwg, G, c;
    __device__ void init(int M, int N, int G_, int c_) { nM = M / BM; nN = N / BM; nwg = nM * nN; G = G_; c = c_; }
    __device__ bool next(int i, Unit& u) const {
        const long L = (long)i * G + c; if (L >= nwg) return false;
        int wgid = (int)L; { const int q = nwg / NXCD, r = nwg % NXCD, xcd = wgid % NXCD, off = wgid / NXCD; wgid = (xcd < r ? xcd * (q + 1) : r * (q + 1) + (xcd - r) * q) + off; }
        const int nig = WGM * nN, gid = wgid / nig, fm = gid * WGM, gsz = (nM - fm) < WGM ? (nM - fm) : WGM;
        u.pm = fm + ((wgid % nig) % gsz); u.pn = (wgid % nig) / gsz; return true;
    }
};

__device__ __forceinline__ float row_scale(const float* part, int row) {
    const f32x4* p = (const f32x4*)(part + (size_t)row * 16);
    const f32x4 a = p[0], b = p[1], c = p[2], d = p[3];
    const float s = (((a[0] + a[1]) + (a[2] + a[3])) + ((b[0] + b[1]) + (b[2] + b[3]))) + (((c[0] + c[1]) + (c[2] + c[3])) + ((d[0] + d[1]) + (d[2] + d[3])));
    return rsqrtf(s * (1.0f / 1024.0f) + EPS);
}
struct Epi {
    int mode;
    const float* ssq_in;
    float* ssq_out;
    const float* xin; float* xout; bf16_t* xb;
    bf16_t* ob; int ldo;
    float* of;
    const float* bias;
    float alpha;
    __device__ __forceinline__ void operator()(const f32x4 (&acc)[2][2][4][2], const Unit& u, int wr, int wc, int fr, int fq) const {
        const int row0 = u.pm * BM + wr * 64 + fr;
        if (mode == 0) {
            const int col0 = u.pn * HALF + wc * 32 + 4 * fq;
#pragma unroll
            for (int ai = 0; ai < 2; ++ai)
#pragma unroll
                for (int m = 0; m < 4; ++m) {
                    const int row = row0 + ai * HALF + m * 16;
                    const float s = row_scale(ssq_in, row);
                    bf16_t* rowp = ob + (size_t)row * FF + col0;
#pragma unroll
                    for (int n = 0; n < 2; ++n) {
                        const f32x4 g = acc[ai][0][m][n] * s, up = acc[ai][1][m][n] * s;
                        u32x2 w; w.x = pk2(siluf_(g[0]) * up[0], siluf_(g[1]) * up[1]); w.y = pk2(siluf_(g[2]) * up[2], siluf_(g[3]) * up[3]);
                        *(u32x2*)(rowp + n * 16) = w;
                    }
                }
        } else if (mode == 1) {
            const int col0 = u.pn * BM + wc * 32 + 4 * fq;
            f32x4 bv[2][2];
#pragma unroll
            for (int bj = 0; bj < 2; ++bj)
#pragma unroll
                for (int n = 0; n < 2; ++n) bv[bj][n] = bias ? *(const f32x4*)(bias + col0 + bj * HALF + n * 16) : (f32x4){0.f, 0.f, 0.f, 0.f};
#pragma unroll
            for (int ai = 0; ai < 2; ++ai)
#pragma unroll
                for (int m = 0; m < 4; ++m) {
                    const int row = row0 + ai * HALF + m * 16;
                    const float s = row_scale(ssq_in, row);
                    bf16_t* rowp = ob + (size_t)row * ldo + col0;
#pragma unroll
                    for (int bj = 0; bj < 2; ++bj)
#pragma unroll
                        for (int n = 0; n < 2; ++n) {
                            const f32x4 v = acc[ai][bj][m][n] * s + bv[bj][n];
                            u32x2 w; w.x = pk2(v[0], v[1]); w.y = pk2(v[2], v[3]);
                            *(u32x2*)(rowp + bj * HALF + n * 16) = w;
                        }
                }
        } else if (mode == 2) {
            const int col0 = u.pn * BM + wc * 32 + 4 * fq;
#pragma unroll
            for (int ai = 0; ai < 2; ++ai)
#pragma unroll
                for (int m = 0; m < 4; ++m) {
                    float* rowp = of + (size_t)(row0 + ai * HALF + m * 16) * D + col0;
#pragma unroll
                    for (int bj = 0; bj < 2; ++bj)
#pragma unroll
                        for (int n = 0; n < 2; ++n) *(f32x4*)(rowp + bj * HALF + n * 16) = acc[ai][bj][m][n];
                }
        } else {
            const int col0 = u.pn * BM + wc * 32 + 4 * fq;
#pragma unroll
            for (int ai = 0; ai < 2; ++ai)
#pragma unroll
                for (int m = 0; m < 4; ++m) {
                    const int row = row0 + ai * HALF + m * 16;
                    const size_t off = (size_t)row * D + col0;
                    float s = 1.0f;
                    if (mode == 4) s = row_scale(ssq_in, row);
                    float ss = 0.f;
#pragma unroll
                    for (int bj = 0; bj < 2; ++bj)
#pragma unroll
                        for (int n = 0; n < 2; ++n) {
                            const int co = bj * HALF + n * 16;
                            const f32x4 xi = *(const f32x4*)(xin + off + co);
                            f32x4 v;
                            if (mode == 3) {
                                const f32x4 bvv = bias ? *(const f32x4*)(bias + col0 + co) : (f32x4){0.f, 0.f, 0.f, 0.f};
                                v = xi + acc[ai][bj][m][n] * alpha + bvv;
                            } else {
                                const f32x4 pp = *(const f32x4*)(of + off + co);
                                const f32x4 a = acc[ai][bj][m][n] * s;
                                v[0] = xi[0] + sigmoidf_(a[0]) * pp[0]; v[1] = xi[1] + sigmoidf_(a[1]) * pp[1];
                                v[2] = xi[2] + sigmoidf_(a[2]) * pp[2]; v[3] = xi[3] + sigmoidf_(a[3]) * pp[3];
                            }
                            *(f32x4*)(xout + off + co) = v;
                            u32x2 w; w.x = pk2(v[0], v[1]); w.y = pk2(v[2], v[3]);
                            *(u32x2*)(xb + off + co) = w;
                            ss += (v[0] * v[0] + v[1] * v[1]) + (v[2] * v[2] + v[3] * v[3]);
                        }
                    ss += __shfl_xor(ss, 16); ss += __shfl_xor(ss, 32);
                    if (fq == 0) ssq_out[(size_t)row * 16 + u.pn * 4 + wc] = ss;
                }
        }
    }
};

template <class EpiT, class Sched>
__device__ __forceinline__ void gemm_phase(LAS unsigned char* lds, const Gemm g, const Sched& S, const EpiT& E) {
    const int tid = otid(), wid = __builtin_amdgcn_readfirstlane(tid >> 6), lane = tid & 63, wr = wid >> 2, wc = wid & 3, fr = lane & 15, fq = lane >> 4;
    const int K = g.K, nt = K / BK;
    unsigned voffA[2], voffB[2];
#pragma unroll
    for (int i = 0; i < 2; ++i) { int R, C; stage_rc(tid * 16 + i * 8192, R, C); voffA[i] = (unsigned)(R * K + C) * 2u; voffB[i] = (unsigned)(R * K + C) * 2u; }
    const size_t kstep = (size_t)(BK * 2);
    const size_t hstep = (size_t)HALF * K * 2;
    const size_t tstep = 2 * hstep;
    const unsigned ldsw = (unsigned)wid * 1024u;
    const int aoff = lds_byte(wr * 64 + fr, fq * 8), boff = lds_byte(wc * 32 + fr, fq * 8);
#define PG8_SA(b, h) (((b) * 2 + (h)) * HTB)
#define PG8_SB(b, h) ((4 + (b) * 2 + (h)) * HTB)
#define PG8_STAGE(bufoff, gbase, voff) do { _Pragma("unroll") for (int _i = 0; _i < 2; ++_i) \
        __builtin_amdgcn_global_load_lds((const unsigned*)((const char*)(gbase) + (voff)[_i]), (LAS unsigned*)(lds + (bufoff) + ldsw + _i * 8192), 16, 0, 0); } while (0)
#define PG8_LDA(dst, b, h) do { _Pragma("unroll") for (int m = 0; m < 4; ++m) _Pragma("unroll") for (int k = 0; k < 2; ++k) dst[m][k] = *(const LAS bf16x8*)(lds + PG8_SA(b, h) + aoff + m * 2048 + k * 1024); } while (0)
#define PG8_LDB(dst, b, h) do { _Pragma("unroll") for (int n = 0; n < 2; ++n) _Pragma("unroll") for (int k = 0; k < 2; ++k) dst[n][k] = *(const LAS bf16x8*)(lds + PG8_SB(b, h) + boff + n * 2048 + k * 1024); } while (0)
#define PG8_MMA(ai, bj, At, Bt) do { __builtin_amdgcn_s_setprio(1); _Pragma("unroll") for (int m = 0; m < 4; ++m) _Pragma("unroll") for (int n = 0; n < 2; ++n) _Pragma("unroll") for (int k = 0; k < 2; ++k) \
        acc[ai][bj][m][n] = __builtin_amdgcn_mfma_f32_16x16x32_bf16(Bt[n][k], At[m][k], acc[ai][bj][m][n], 0, 0, 0); __builtin_amdgcn_s_setprio(0); } while (0)
#define PG8_WAIT_V(n) asm volatile("s_waitcnt vmcnt(" #n ")" ::: "memory")
#define PG8_WAIT_L(n) asm volatile("s_waitcnt lgkmcnt(" #n ")" ::: "memory")
#define PG8_BAR __builtin_amdgcn_s_barrier()
#define PG8_SCHED __builtin_amdgcn_sched_barrier(0)
    Unit cur, nxt; int ui = 0;
    if (!S.next(0, cur)) return;
    f32x4 acc[2][2][4][2];
#pragma unroll
    for (int a = 0; a < 2; ++a)
#pragma unroll
        for (int b = 0; b < 2; ++b)
#pragma unroll
            for (int m = 0; m < 4; ++m)
#pragma unroll
                for (int n = 0; n < 2; ++n) acc[a][b][m][n] = (f32x4){0.f, 0.f, 0.f, 0.f};
    bf16x8 At[4][2], B0[2][2], B1[2][2];
    const char* cA = (const char*)g.A + (size_t)cur.pm * tstep; const char* cB = (const char*)g.Bt + (size_t)cur.pn * tstep;
    PG8_STAGE(PG8_SB(0, 0), cB, voffB); PG8_STAGE(PG8_SA(0, 0), cA, voffA); PG8_STAGE(PG8_SB(0, 1), cB + hstep, voffB); PG8_STAGE(PG8_SA(0, 1), cA + hstep, voffA);
    if (wr == 1) PG8_BAR;
    PG8_WAIT_V(4); PG8_BAR;
    PG8_STAGE(PG8_SB(1, 0), cB + kstep, voffB); PG8_STAGE(PG8_SA(1, 0), cA + kstep, voffA); PG8_STAGE(PG8_SB(1, 1), cB + hstep + kstep, voffB);
    PG8_WAIT_V(6); PG8_BAR;
    for (;;) {
        const bool has_next = S.next(ui + 1, nxt);
        const char* nA = has_next ? (const char*)g.A + (size_t)nxt.pm * tstep : cA; const char* nB = has_next ? (const char*)g.Bt + (size_t)nxt.pn * tstep : cB;
        for (int t = 0; t < nt; t += 2) {
            const bool last = (t == nt - 2);
            const char* a1 = cA + (size_t)(t + 1) * kstep;
            const char* a2 = last ? nA : cA + (size_t)(t + 2) * kstep; const char* b2 = last ? nB : cB + (size_t)(t + 2) * kstep;
            const char* a3 = a2 + kstep; const char* b3 = b2 + kstep;
            PG8_LDB(B0, 0, 0); PG8_SCHED; PG8_LDA(At, 0, 0); PG8_STAGE(PG8_SA(1, 1), a1 + hstep, voffA);
            PG8_WAIT_L(8); PG8_BAR; PG8_WAIT_L(0); PG8_MMA(0, 0, At, B0); PG8_BAR; PG8_SCHED;
            PG8_LDB(B1, 0, 1); PG8_STAGE(PG8_SB(0, 0), b2, voffB);
            PG8_BAR; PG8_WAIT_L(0); PG8_MMA(0, 1, At, B1); PG8_BAR;
            PG8_LDA(At, 0, 1); PG8_STAGE(PG8_SA(0, 0), a2, voffA);
            PG8_BAR; PG8_WAIT_L(0); PG8_MMA(1, 0, At, B0); PG8_BAR; PG8_SCHED;
            PG8_STAGE(PG8_SB(0, 1), b2 + hstep, voffB);
            PG8_WAIT_V(6); PG8_BAR; PG8_MMA(1, 1, At, B1); PG8_BAR;
            PG8_LDB(B0, 1, 0); PG8_SCHED; PG8_LDA(At, 1, 0); PG8_STAGE(PG8_SA(0, 1), a2 + hstep, voffA);
            PG8_WAIT_L(8); PG8_BAR; PG8_WAIT_L(0); PG8_MMA(0, 0, At, B0); PG8_BAR; PG8_SCHED;
            PG8_LDB(B1, 1, 1); PG8_STAGE(PG8_SB(1, 0), b3, voffB);
            PG8_BAR; PG8_WAIT_L(0); PG8_MMA(0, 1, At, B1); PG8_BAR;
            PG8_LDA(At, 1, 1); PG8_STAGE(PG8_SA(1, 0), a3, voffA);
            PG8_BAR; PG8_WAIT_L(0); PG8_MMA(1, 0, At, B0); PG8_BAR; PG8_SCHED;
            PG8_STAGE(PG8_SB(1, 1), b3 + hstep, voffB);
            PG8_WAIT_V(6); PG8_BAR; PG8_MMA(1, 1, At, B1); PG8_BAR;
        }
        E(acc, cur, wr, wc, fr, fq);
        if (!has_next) break;
#pragma unroll
        for (int a = 0; a < 2; ++a)
#pragma unroll
            for (int b = 0; b < 2; ++b)
#pragma unroll
                for (int m = 0; m < 4; ++m)
#pragma unroll
                    for (int n = 0; n < 2; ++n) acc[a][b][m][n] = (f32x4){0.f, 0.f, 0.f, 0.f};
        cur = nxt; cA = nA; cB = nB; ++ui;
    }
    PG8_WAIT_V(0);
    if (wr == 0) PG8_BAR;
    PG8_BAR;
#undef PG8_SA
#undef PG8_SB
#undef PG8_STAGE
#undef PG8_LDA
#undef PG8_LDB
#undef PG8_MMA
#undef PG8_WAIT_V
#undef PG8_WAIT_L
#undef PG8_BAR
#undef PG8_SCHED
}
}

__device__ __forceinline__ void run_gemm(LAS unsigned char* lds, const bf16_t* A, const bf16_t* Bt, int N, int K, const pg8::Epi& E) {
    pg8::Gemm g{A, Bt, T, N, K}; pg8::StaticOrder S; S.init(T, N, ogrid(), obid());
    pg8::gemm_phase<pg8::Epi, pg8::StaticOrder>(lds, g, S, E);
}

struct CvtJob { const float* W; const float* gain; bf16_t* dst; int K, ldw, col0, ncols, mode; };

__device__ __forceinline__ CvtJob get_job(const Params& P, int j) {
    CvtJob J; J.gain = nullptr; J.col0 = 0; J.mode = 0;
    unsigned char* ws = P.ws;
    if (j < 16) {
        const int f = j >> 1, part = j & 1, L = f >> 1, w = f & 1;
        const float* src = w ? (part ? P.in[11] : P.in[10]) : (part ? P.in[6] : P.in[5]);
        J.W = src + (size_t)L * 1024 * 2816; J.gain = (w ? P.in[9] : P.in[4]) + L * 1024;
        J.dst = (bf16_t*)(ws + WS_WUP) + (size_t)f * 5632 * 1024 + (size_t)part * 128 * 1024;
        J.K = 1024; J.ldw = 2816; J.ncols = 2816; J.mode = 1;
    } else if (j < 24) {
        const int f = j - 16, L = f >> 1, w = f & 1;
        J.W = (w ? P.in[12] : P.in[7]) + (size_t)L * 2816 * 1024;
        J.dst = (bf16_t*)(ws + WS_WDN) + (size_t)f * 1024 * 2816;
        J.K = 2816; J.ldw = 1024; J.ncols = 1024;
    } else if (j < 28) {
        const int e = (j - 24) >> 1, part = (j - 24) & 1;
        J.W = P.in[16] + (size_t)e * 1024 * 2576; J.gain = P.in[8] + (2 * e) * 1024;
        J.dst = (bf16_t*)(ws + WS_WIN) + (size_t)e * 2816 * 1024 + (part ? (size_t)1536 * 1024 : 0);
        J.K = 1024; J.ldw = 2576; J.col0 = part ? 1552 : 0; J.ncols = part ? 1024 : 1536;
    } else if (j < 30) {
        const int e = j - 28;
        J.W = P.in[17] + (size_t)e * 1024 * 1024; J.dst = (bf16_t*)(ws + WS_WOUT) + (size_t)e * 1024 * 1024;
        J.K = 1024; J.ldw = 1024; J.ncols = 1024;
    } else if (j < 32) {
        const int o = j - 30;
        J.W = P.in[28] + (size_t)o * 1024 * 1536; J.gain = P.in[8] + (2 * o + 1) * 1024;
        J.dst = (bf16_t*)(ws + WS_WQKV) + (size_t)o * 1536 * 1024;
        J.K = 1024; J.ldw = 1536; J.ncols = 1536;
    } else if (j < 34) {
        const int o = j - 32;
        J.W = P.in[30] + (size_t)o * 1024 * 1024; J.dst = (bf16_t*)(ws + WS_WO) + (size_t)o * 1024 * 1024;
        J.K = 1024; J.ldw = 1024; J.ncols = 1024;
    } else if (j < 38) {
        const int L = j - 34;
        J.W = P.in[15] + (size_t)L * 1024 * 1024; J.gain = P.in[13] + L * 1024;
        J.dst = (bf16_t*)(ws + WS_WPG) + (size_t)L * 1024 * 1024;
        J.K = 1024; J.ldw = 1024; J.ncols = 1024;
    } else {
        const int L = j - 38;
        J.W = P.in[14] + (size_t)L * 256 * 1024; J.dst = (bf16_t*)(ws + WS_WPP) + (size_t)L * 1024 * 256;
        J.K = 256; J.ldw = 1024; J.ncols = 1024;
    }
    return J;
}

__device__ __forceinline__ void cvt_item(const CvtJob& J, int item, LAS float* scr, int lane) {
    const int nblk = J.ncols / 32, kb = item / nblk, nb = item % nblk, k0 = 64 * kb, n0 = 32 * nb;
#pragma unroll 8
    for (int i = 0; i < 32; ++i) {
        const int kk = 2 * i + (lane >> 5);
        float w = J.W[(size_t)(k0 + kk) * J.ldw + J.col0 + n0 + (lane & 31)];
        if (J.gain) w *= J.gain[k0 + kk];
        scr[kk * 33 + (lane & 31)] = w;
    }
    asm volatile("s_waitcnt lgkmcnt(0)" ::: "memory");
    const int c = lane & 7;
#pragma unroll
    for (int j = 0; j < 4; ++j) {
        const int n = (lane >> 3) + 8 * j; const LAS float* s = scr + (8 * c) * 33 + n;
        u32x4 o; o.x = pk2(s[0 * 33], s[1 * 33]); o.y = pk2(s[2 * 33], s[3 * 33]); o.z = pk2(s[4 * 33], s[5 * 33]); o.w = pk2(s[6 * 33], s[7 * 33]);
        const int nn = n0 + n; const int row = J.mode ? ((nn >> 7) * 256 + (nn & 127)) : nn;
        *(u32x4*)(J.dst + (size_t)row * J.K + k0 + 8 * c) = o;
    }
    asm volatile("s_waitcnt lgkmcnt(0)" ::: "memory");
}

__device__ __forceinline__ void phase_prepass(const Params& P, LAS unsigned char* lds) {
    const int tid = otid(), lane = tid & 63, wave = tid >> 6;
    const int gw = obid() * 8 + wave, NGW = ogrid() * 8;
    const int gt = obid() * NTHREADS + tid, NGT = ogrid() * NTHREADS;
    unsigned char* ws = P.ws;
    LAS float* scr = (LAS float*)(lds + wave * 8448);
    for (int j = 0; j < 42; ++j) {
        const CvtJob J = get_job(P, j);
        const int nitems = (J.K / 64) * (J.ncols / 32);
        for (int it = gw; it < nitems; it += NGW) cvt_item(J, it, scr, lane);
    }
    for (int idx = gt; idx < 2 * 256 * 1024; idx += NGT) {
        const int e = idx >> 18, n = (idx >> 10) & 255, k = idx & 1023;
        const float* wi = P.in[16] + (size_t)e * 1024 * 2576 + (size_t)k * 2576 + 1536;
        const float* wf = P.in[18] + e * 16 * 256 + n;
        float s = 0.f;
#pragma unroll
        for (int r = 0; r < 16; ++r) s += wi[r] * wf[r * 256];
        s *= P.in[8][(2 * e) * 1024 + k];
        ((bf16_t*)(ws + WS_WIN))[(size_t)e * 2816 * 1024 + (size_t)(2560 + n) * 1024 + k] = (bf16_t)f2bf(s);
    }
    float* ssq = (float*)(ws + WS_SSQ);
    bf16_t* xb = (bf16_t*)(ws + WS_MIX);
    for (int m = gw; m < T; m += NGW) {
        const f32x4* xr = (const f32x4*)(P.in[0] + (size_t)m * D) + lane;
        f32x4 v[4]; float s = 0.f;
#pragma unroll
        for (int j = 0; j < 4; ++j) { v[j] = xr[64 * j]; s += (v[j][0] * v[j][0] + v[j][1] * v[j][1]) + (v[j][2] * v[j][2] + v[j][3] * v[j][3]); }
        s = wave_sum(s);
        u32x2* o8 = (u32x2*)(xb + (size_t)m * D) + lane;
#pragma unroll
        for (int j = 0; j < 4; ++j) { u32x2 w; w.x = pk2(v[j][0], v[j][1]); w.y = pk2(v[j][2], v[j][3]); o8[64 * j] = w; }
        if (lane < 16) ssq[(size_t)m * 16 + lane] = (lane == 0) ? s : 0.f;
    }
    const f32x4* p4 = (const f32x4*)P.in[1]; u32x2* pb = (u32x2*)(ws + WS_PB);
    for (int i = gt; i < 4 * T * 256 / 4; i += NGT) { const f32x4 v = p4[i]; u32x2 w; w.x = pk2(v[0], v[1]); w.y = pk2(v[2], v[3]); pb[i] = w; }
}

constexpr int LDT = 68;
constexpr int GO_BT = 0, GO_SEG = 4352, GO_QDT = 4864, GO_KDNT = 9216, GO_ATT = 13568, GO_V = 17920, GO_S = 26112;

template <bool WITH_Q>
__device__ __forceinline__ void gla_prolog(const Params& P, LAS float* L, int e, int t0, int h, float (&kv)[8], float (&qv)[8]) {
    const int tid = otid(), lane = tid & 63, wave = tid >> 6;
    const bf16_t* z = (const bf16_t*)(P.ws + WS_HZ) + (size_t)(t0 + lane) * ZW;
    const u32x4 k8 = *(const u32x4*)(z + 256 + h * 64 + 8 * wave);
    const u32x4 f8 = *(const u32x4*)(z + 2560 + h * 64 + 8 * wave);
    kv[0] = bf_lo(k8.x); kv[1] = bf_hi(k8.x); kv[2] = bf_lo(k8.y); kv[3] = bf_hi(k8.y); kv[4] = bf_lo(k8.z); kv[5] = bf_hi(k8.z); kv[6] = bf_lo(k8.w); kv[7] = bf_hi(k8.w);
    if (WITH_Q) {
        const u32x4 q8 = *(const u32x4*)(z + h * 64 + 8 * wave);
        qv[0] = bf_lo(q8.x); qv[1] = bf_hi(q8.x); qv[2] = bf_lo(q8.y); qv[3] = bf_hi(q8.y); qv[4] = bf_lo(q8.z); qv[5] = bf_hi(q8.z); qv[6] = bf_lo(q8.w); qv[7] = bf_hi(q8.w);
    }
    float fv[8];
    fv[0] = bf_lo(f8.x); fv[1] = bf_hi(f8.x); fv[2] = bf_lo(f8.y); fv[3] = bf_hi(f8.y); fv[4] = bf_lo(f8.z); fv[5] = bf_hi(f8.z); fv[6] = bf_lo(f8.w); fv[7] = bf_hi(f8.w);
    const float* bfp = P.in[19] + e * 256 + h * 64 + 8 * wave;
#pragma unroll
    for (int j = 0; j < 8; ++j) L[GO_BT + (8 * wave + j) * LDT + lane] = logsigmoidf_(fv[j] + bfp[j]) * (1.0f / 16.0f);
    __syncthreads();
    float pr[8];
    {
        const f32x4 a = *(const LAS f32x4*)(L + GO_BT + lane * LDT + 8 * wave), b = *(const LAS f32x4*)(L + GO_BT + lane * LDT + 8 * wave + 4);
        pr[0] = a[0]; pr[1] = pr[0] + a[1]; pr[2] = pr[1] + a[2]; pr[3] = pr[2] + a[3]; pr[4] = pr[3] + b[0]; pr[5] = pr[4] + b[1]; pr[6] = pr[5] + b[2]; pr[7] = pr[6] + b[3];
        L[GO_SEG + wave * 64 + lane] = pr[7];
    }
    __syncthreads();
    {
        float off = 0.f;
        for (int s = 0; s < wave; ++s) off += L[GO_SEG + s * 64 + lane];
        f32x4 a, b; a[0] = pr[0] + off; a[1] = pr[1] + off; a[2] = pr[2] + off; a[3] = pr[3] + off; b[0] = pr[4] + off; b[1] = pr[5] + off; b[2] = pr[6] + off; b[3] = pr[7] + off;
        *(LAS f32x4*)(L + GO_BT + lane * LDT + 8 * wave) = a; *(LAS f32x4*)(L + GO_BT + lane * LDT + 8 * wave + 4) = b;
    }
    __syncthreads();
}

__device__ __forceinline__ void load_v_tile(const Params& P, LAS float* L, int t0, int h) {
    const int tid = otid();
#pragma unroll
    for (int r = 0; r < 2; ++r) {
        const int c = tid + 512 * r, row = c >> 4, col8 = (c & 15) * 8;
        const u32x4 v8 = *(const u32x4*)((const bf16_t*)(P.ws + WS_HZ) + (size_t)(t0 + row) * ZW + 512 + h * 128 + col8);
        f32x4 a, b; a[0] = bf_lo(v8.x); a[1] = bf_hi(v8.x); a[2] = bf_lo(v8.y); a[3] = bf_hi(v8.y); b[0] = bf_lo(v8.z); b[1] = bf_hi(v8.z); b[2] = bf_lo(v8.w); b[3] = bf_hi(v8.w);
        *(LAS f32x4*)(L + GO_V + row * 128 + col8) = a; *(LAS f32x4*)(L + GO_V + row * 128 + col8 + 4) = b;
    }
}

__device__ __forceinline__ void phase_g1(const Params& P, LAS unsigned char* lds, int e) {
    LAS float* L = (LAS float*)lds;
    const int tid = otid(), lane = tid & 63, wave = tid >> 6;
    float* Sbuf = (float*)(P.ws + WS_S); float* decay = (float*)(P.ws + WS_DECAY);
    for (int item = obid(), gstep = ogrid(); item < 1024; item += gstep) {
        const int h = item & 3, bn = item >> 2, b = bn >> 6, n = bn & 63;
        const int t0 = b * SEQ + n * 64;
        float kv[8], qv[8];
        gla_prolog<false>(P, L, e, t0, h, kv, qv);
        {
            f32x4 a, bq;
#pragma unroll
            for (int j = 0; j < 8; ++j) {
                const float bv = L[GO_BT + (8 * wave + j) * LDT + lane], bl = L[GO_BT + (8 * wave + j) * LDT + 63];
                const float val = kv[j] * __expf(bl - bv);
                if (j < 4) a[j] = val; else bq[j - 4] = val;
            }
            *(LAS f32x4*)(L + GO_QDT + lane * LDT + 8 * wave) = a; *(LAS f32x4*)(L + GO_QDT + lane * LDT + 8 * wave + 4) = bq;
        }
        load_v_tile(P, L, t0, h);
        if (tid < 64) decay[item * 64 + tid] = __expf(L[GO_BT + tid * LDT + 63]);
        __syncthreads();
        const int tdk = tid >> 5, tdv = tid & 31;
        f32x4 acc[4];
#pragma unroll
        for (int i = 0; i < 4; ++i) acc[i] = (f32x4){0.f, 0.f, 0.f, 0.f};
#pragma unroll 4
        for (int j = 0; j < 64; ++j) {
            const f32x4 a = *(const LAS f32x4*)(L + GO_QDT + j * LDT + 4 * tdk);
            const f32x4 bb = *(const LAS f32x4*)(L + GO_V + j * 128 + 4 * tdv);
#pragma unroll
            for (int i = 0; i < 4; ++i) acc[i] += a[i] * bb;
        }
#pragma unroll
        for (int i = 0; i < 4; ++i) *(f32x4*)(Sbuf + (size_t)item * 8192 + (4 * tdk + i) * 128 + 4 * tdv) = acc[i];
        __syncthreads();
    }
}

__device__ __forceinline__ void phase_g2(const Params& P) {
    float* Sbuf = (float*)(P.ws + WS_S); const float* decay = (const float*)(P.ws + WS_DECAY);
    for (int idx = obid() * NTHREADS + otid(); idx < 16 * 8192; idx += ogrid() * NTHREADS) {
        const int bh = idx >> 13, el = idx & 8191, b = bh >> 2, h = bh & 3, dk = el >> 7;
        float run = 0.f;
        for (int n0 = 0; n0 < 64; n0 += 8) {
            float kvn[8], dc[8];
#pragma unroll
            for (int j = 0; j < 8; ++j) { const int item = ((b * 64 + n0 + j) << 2) + h; kvn[j] = Sbuf[(size_t)item * 8192 + el]; dc[j] = decay[item * 64 + dk]; }
#pragma unroll
            for (int j = 0; j < 8; ++j) { const int item = ((b * 64 + n0 + j) << 2) + h; Sbuf[(size_t)item * 8192 + el] = run; run = dc[j] * run + kvn[j]; }
        }
    }
}

__device__ __forceinline__ void phase_g3(const Params& P, LAS unsigned char* lds, int e) {
    LAS float* L = (LAS float*)lds;
    const int tid = otid(), lane = tid & 63, wave = tid >> 6;
    const float* Sbuf = (const float*)(P.ws + WS_S);
    const bf16_t* zb = (const bf16_t*)(P.ws + WS_HZ);
    bf16_t* mix = (bf16_t*)(P.ws + WS_MIX);
    for (int item = obid(), gstep = ogrid(); item < 1024; item += gstep) {
        const int h = item & 3, bn = item >> 2, b = bn >> 6, n = bn & 63;
        const int t0 = b * SEQ + n * 64;
        float kv[8], qv[8];
        gla_prolog<true>(P, L, e, t0, h, kv, qv);
#pragma unroll
        for (int j = 0; j < 8; ++j) {
            const float bv = L[GO_BT + (8 * wave + j) * LDT + lane];
            L[GO_QDT + (8 * wave + j) * LDT + lane] = qv[j] * 0.125f * __expf(bv);
            L[GO_KDNT + (8 * wave + j) * LDT + lane] = kv[j] * __expf(-bv);
        }
        load_v_tile(P, L, t0, h);
#pragma unroll
        for (int r = 0; r < 4; ++r) { const int c = tid + 512 * r; *(LAS f32x4*)(L + GO_S + 4 * c) = *(const f32x4*)(Sbuf + (size_t)item * 8192 + 4 * c); }
        __syncthreads();
        const int ti = tid >> 5, tj = tid & 31;
        {
            f32x2 c[4];
#pragma unroll
            for (int i = 0; i < 4; ++i) c[i] = (f32x2){0.f, 0.f};
#pragma unroll 4
            for (int k = 0; k < 64; ++k) {
                const f32x4 a = *(const LAS f32x4*)(L + GO_QDT + k * LDT + 4 * ti);
                const f32x2 bb = *(const LAS f32x2*)(L + GO_KDNT + k * LDT + 2 * tj);
#pragma unroll
                for (int i = 0; i < 4; ++i) c[i] += a[i] * bb;
            }
#pragma unroll
            for (int jj = 0; jj < 2; ++jj) {
                f32x4 w;
#pragma unroll
                for (int i = 0; i < 4; ++i) w[i] = (2 * tj + jj <= 4 * ti + i) ? c[i][jj] : 0.f;
                *(LAS f32x4*)(L + GO_ATT + (2 * tj + jj) * LDT + 4 * ti) = w;
            }
        }
        __syncthreads();
        f32x4 o[4];
#pragma unroll
        for (int i = 0; i < 4; ++i) o[i] = (f32x4){0.f, 0.f, 0.f, 0.f};
#pragma unroll 4
        for (int j = 0; j < 64; ++j) {
            const f32x4 a = *(const LAS f32x4*)(L + GO_ATT + j * LDT + 4 * ti);
            const f32x4 bb = *(const LAS f32x4*)(L + GO_V + j * 128 + 4 * tj);
#pragma unroll
            for (int i = 0; i < 4; ++i) o[i] += a[i] * bb;
        }
#pragma unroll 4
        for (int k = 0; k < 64; ++k) {
            const f32x4 a = *(const LAS f32x4*)(L + GO_QDT + k * LDT + 4 * ti);
            const f32x4 bb = *(const LAS f32x4*)(L + GO_S + k * 128 + 4 * tj);
#pragma unroll
            for (int i = 0; i < 4; ++i) o[i] += a[i] * bb;
        }
        const f32x4 ng = *(const f32x4*)(P.in[20] + e * 512 + h * 128 + 4 * tj);
#pragma unroll
        for (int i = 0; i < 4; ++i) {
            float ss = (o[i][0] * o[i][0] + o[i][1] * o[i][1]) + (o[i][2] * o[i][2] + o[i][3] * o[i][3]);
            ss += __shfl_xor(ss, 1); ss += __shfl_xor(ss, 2); ss += __shfl_xor(ss, 4); ss += __shfl_xor(ss, 8); ss += __shfl_xor(ss, 16);
            const float rs = rsqrtf(ss * (1.0f / 128.0f) + EPS);
            const size_t tok = (size_t)(t0 + 4 * ti + i);
            const u32x2 r2 = *(const u32x2*)(zb + tok * ZW + 1024 + h * 128 + 4 * tj);
            const float r0 = bf_lo(r2.x), r1 = bf_hi(r2.x), r2f = bf_lo(r2.y), r3 = bf_hi(r2.y);
            u32x2 w;
            w.x = pk2(o[i][0] * rs * ng[0] * siluf_(r0), o[i][1] * rs * ng[1] * siluf_(r1));
            w.y = pk2(o[i][2] * rs * ng[2] * siluf_(r2f), o[i][3] * rs * ng[3] * siluf_(r3));
            *(u32x2*)(mix + tok * D + h * 128 + 4 * tj) = w;
        }
        __syncthreads();
    }
}

constexpr int LO_XR = 0, LO_XCT = 4288, LO_WA = 8640, LO_WX = 12736, LO_RT = 16832, LO_IT = 21184, LO_SEGA = 25536, LO_SEGH = 26048;

__device__ __forceinline__ void phase_l1(const Params& P, LAS unsigned char* lds, int e) {
    LAS float* L = (LAS float*)lds;
    const int tid = otid(), lane = tid & 63, wave = tid >> 6;
    const bf16_t* zb = (const bf16_t*)(P.ws + WS_HZ);
    float* HL = (float*)(P.ws + WS_HL); float* AC = (float*)(P.ws + WS_AC);
    for (int item = obid(), gstep = ogrid(); item < 2048; item += gstep) {
        const int g = item & 7, bc = item >> 3, b = bc >> 6, c = bc & 63;
        const int t0 = b * SEQ + c * 64, ch0 = g * 64;
        for (int cc = tid; cc < 67 * 8; cc += NTHREADS) {
            const int row = cc >> 3, c8 = (cc & 7) * 8;
            u32x4 v8 = (u32x4){0u, 0u, 0u, 0u};
            if (c > 0 || row >= 3) v8 = *(const u32x4*)(zb + (size_t)(t0 + row - 3) * ZW + 1536 + ch0 + c8);
            f32x4 a, bq; a[0] = bf_lo(v8.x); a[1] = bf_hi(v8.x); a[2] = bf_lo(v8.y); a[3] = bf_hi(v8.y); bq[0] = bf_lo(v8.z); bq[1] = bf_hi(v8.z); bq[2] = bf_lo(v8.w); bq[3] = bf_hi(v8.w);
            *(LAS f32x4*)(L + LO_XR + row * 64 + c8) = a; *(LAS f32x4*)(L + LO_XR + row * 64 + c8 + 4) = bq;
        }
        {
            const f32x4* wa = (const f32x4*)(P.in[23] + (size_t)(e * 8 + g) * 4096); const f32x4* wx = (const f32x4*)(P.in[25] + (size_t)(e * 8 + g) * 4096);
#pragma unroll
            for (int r = 0; r < 2; ++r) { const int i4 = tid + 512 * r; *(LAS f32x4*)(L + LO_WA + 4 * i4) = wa[i4]; *(LAS f32x4*)(L + LO_WX + 4 * i4) = wx[i4]; }
        }
        __syncthreads();
        {
            const float* cw = P.in[21] + e * 4 * 512 + ch0 + lane;
            const float w0 = cw[0], w1 = cw[512], w2 = cw[1024], w3 = cw[1536], cb = P.in[22][e * 512 + ch0 + lane];
            f32x4 a, bq;
#pragma unroll
            for (int j = 0; j < 8; ++j) {
                const int t = 8 * wave + j;
                const float v = L[LO_XR + (t + 0) * 64 + lane] * w0 + L[LO_XR + (t + 1) * 64 + lane] * w1 + L[LO_XR + (t + 2) * 64 + lane] * w2 + L[LO_XR + (t + 3) * 64 + lane] * w3 + cb;
                if (j < 4) a[j] = v; else bq[j - 4] = v;
            }
            *(LAS f32x4*)(L + LO_XCT + lane * LDT + 8 * wave) = a; *(LAS f32x4*)(L + LO_XCT + lane * LDT + 8 * wave + 4) = bq;
        }
        __syncthreads();
        {
            const int half = tid >> 8, tt = (tid & 255) >> 4, tj = tid & 15;
            LAS float* W = L + (half ? LO_WX : LO_WA);
            f32x4 acc[4];
#pragma unroll
            for (int i = 0; i < 4; ++i) acc[i] = (f32x4){0.f, 0.f, 0.f, 0.f};
#pragma unroll 4
            for (int i = 0; i < 64; ++i) {
                const f32x4 a = *(const LAS f32x4*)(L + LO_XCT + i * LDT + 4 * tt);
                const f32x4 bb = *(const LAS f32x4*)(W + i * 64 + 4 * tj);
#pragma unroll
                for (int q = 0; q < 4; ++q) acc[q] += a[q] * bb;
            }
            const f32x4 bias = *(const f32x4*)((half ? P.in[26] : P.in[24]) + e * 512 + ch0 + 4 * tj);
            LAS float* O = L + (half ? LO_IT : LO_RT);
#pragma unroll
            for (int jj = 0; jj < 4; ++jj) {
                f32x4 w;
#pragma unroll
                for (int q = 0; q < 4; ++q) w[q] = sigmoidf_(acc[q][jj] + bias[jj]);
                *(LAS f32x4*)(O + (4 * tj + jj) * LDT + 4 * tt) = w;
            }
        }
        __syncthreads();
        {
            const float sp = softplusf_(-P.in[27][e * 512 + ch0 + lane]);
            const f32x4 r0 = *(const LAS f32x4*)(L + LO_RT + lane * LDT + 8 * wave), r1 = *(const LAS f32x4*)(L + LO_RT + lane * LDT + 8 * wave + 4);
            const f32x4 i0 = *(const LAS f32x4*)(L + LO_IT + lane * LDT + 8 * wave), i1 = *(const LAS f32x4*)(L + LO_IT + lane * LDT + 8 * wave + 4);
            const f32x4 x0 = *(const LAS f32x4*)(L + LO_XCT + lane * LDT + 8 * wave), x1 = *(const LAS f32x4*)(L + LO_XCT + lane * LDT + 8 * wave + 4);
            float Hl[8], Al[8]; float Hr = 0.f, Ar = 1.f;
#pragma unroll
            for (int j = 0; j < 8; ++j) {
                const float rr = j < 4 ? r0[j & 3] : r1[j & 3], ii = j < 4 ? i0[j & 3] : i1[j & 3], xx = j < 4 ? x0[j & 3] : x1[j & 3];
                const float la = -8.0f * rr * sp; const float a = __expf(la);
                const float u = sqrtf(-expm1f(2.0f * la)) * (ii * xx);
                Hr = a * Hr + u; Ar *= a; Hl[j] = Hr; Al[j] = Ar;
            }
            L[LO_SEGA + wave * 64 + lane] = Ar; L[LO_SEGH + wave * 64 + lane] = Hr;
            __syncthreads();
            float Hin = 0.f, Ain = 1.f;
            for (int s = 0; s < wave; ++s) { const float sa = L[LO_SEGA + s * 64 + lane], sh = L[LO_SEGH + s * 64 + lane]; Hin = sa * Hin + sh; Ain *= sa; }
#pragma unroll
            for (int j = 0; j < 8; ++j) {
                const size_t o = (size_t)(t0 + 8 * wave + j) * 512 + ch0 + lane;
                HL[o] = Hl[j] + Al[j] * Hin; AC[o] = Al[j] * Ain;
            }
        }
        __syncthreads();
    }
}

__device__ __forceinline__ void phase_l2(const Params& P) {
    const float* HL = (const float*)(P.ws + WS_HL); const float* AC = (const float*)(P.ws + WS_AC); float* carry = (float*)(P.ws + WS_CARRY);
    for (int idx = obid() * NTHREADS + otid(); idx < 4 * 512; idx += ogrid() * NTHREADS) {
        const int b = idx >> 9, ch = idx & 511;
        float run = 0.f;
        for (int c0 = 0; c0 < 64; c0 += 8) {
            float hl[8], ac[8];
#pragma unroll
            for (int j = 0; j < 8; ++j) { const size_t o = (size_t)(b * SEQ + (c0 + j) * 64 + 63) * 512 + ch; hl[j] = HL[o]; ac[j] = AC[o]; }
#pragma unroll
            for (int j = 0; j < 8; ++j) { carry[(b * 64 + c0 + j) * 512 + ch] = run; run = ac[j] * run + hl[j]; }
        }
    }
}

__device__ __forceinline__ void phase_l3(const Params& P) {
    const float* HL = (const float*)(P.ws + WS_HL); const float* AC = (const float*)(P.ws + WS_AC); const float* carry = (const float*)(P.ws + WS_CARRY);
    const bf16_t* zb = (const bf16_t*)(P.ws + WS_HZ); bf16_t* mix = (bf16_t*)(P.ws + WS_MIX);
    for (int idx = obid() * NTHREADS + otid(); idx < T * 128; idx += ogrid() * NTHREADS) {
        const int tok = idx >> 7, ch = (idx & 127) * 4;
        const int b = tok >> 12, c = (tok & 4095) >> 6;
        const f32x4 hl = *(const f32x4*)(HL + (size_t)tok * 512 + ch), ac = *(const f32x4*)(AC + (size_t)tok * 512 + ch), cr = *(const f32x4*)(carry + (b * 64 + c) * 512 + ch);
        const u32x2 g2 = *(const u32x2*)(zb + (size_t)tok * ZW + 2048 + ch);
        const f32x4 hh = hl + ac * cr;
        u32x2 w; w.x = pk2(hh[0] * gelu_tanh(bf_lo(g2.x)), hh[1] * gelu_tanh(bf_hi(g2.x))); w.y = pk2(hh[2] * gelu_tanh(bf_lo(g2.y)), hh[3] * gelu_tanh(bf_hi(g2.y)));
        *(u32x2*)(mix + (size_t)tok * D + 512 + ch) = w;
    }
}

constexpr int AK_LD = 72, AV_LD = 264;
constexpr int AO_K = 0, AO_VT = 256 * AK_LD * 2, AO_BIAS = AO_VT + 64 * AV_LD * 2;

__device__ __forceinline__ void phase_attn(const Params& P, LAS unsigned char* lds, int o) {
    const int tid = otid(), lane = tid & 63, wave = tid >> 6, l15 = lane & 15, quad = lane >> 4;
    const bf16_t* qkv = (const bf16_t*)(P.ws + WS_HZ);
    bf16_t* mix = (bf16_t*)(P.ws + WS_MIX);
    LAS bf16_t* KS = (LAS bf16_t*)(lds + AO_K); LAS bf16_t* VT = (LAS bf16_t*)(lds + AO_VT); LAS float* BIAS = (LAS float*)(lds + AO_BIAS);
    for (int item = obid(), gstep = ogrid(); item < 512; item += gstep) {
        const int hk = item & 3, n = (item >> 2) & 31, b = item >> 7;
        const int tok0 = b * SEQ + n * 128 - 128;
#pragma unroll
        for (int r = 0; r < 4; ++r) {
            const int c = r * 512 + tid, key = c >> 3, dc = c & 7;
            u32x4 v = (u32x4){0u, 0u, 0u, 0u};
            if (n > 0 || key >= 128) v = *(const u32x4*)(qkv + (size_t)(tok0 + key) * QKVW + 1024 + hk * 64 + dc * 8);
            *(LAS u32x4*)(KS + key * AK_LD + dc * 8) = v;
        }
#pragma unroll
        for (int r = 0; r < 4; ++r) {
            const int c = r * 512 + tid, key = c & 255, dvc = c >> 8;
            u32x4 v = (u32x4){0u, 0u, 0u, 0u};
            if (n > 0 || key >= 128) v = *(const u32x4*)(qkv + (size_t)(tok0 + key) * QKVW + 1280 + hk * 64 + dvc * 8);
            LAS bf16_t* d = VT + (dvc * 8) * AV_LD + key;
            d[0 * AV_LD] = (bf16_t)(v.x & 0xffffu); d[1 * AV_LD] = (bf16_t)(v.x >> 16); d[2 * AV_LD] = (bf16_t)(v.y & 0xffffu); d[3 * AV_LD] = (bf16_t)(v.y >> 16);
            d[4 * AV_LD] = (bf16_t)(v.z & 0xffffu); d[5 * AV_LD] = (bf16_t)(v.z >> 16); d[6 * AV_LD] = (bf16_t)(v.w & 0xffffu); d[7 * AV_LD] = (bf16_t)(v.w >> 16);
        }
        {
            const int g = tid >> 7, dist = tid & 127;
            int bucket = dist;
            if (dist >= 16) { int lg = 16 + (int)(__logf((float)dist * 0.0625f) / 2.0794415416798357f * 16.0f); bucket = lg < 31 ? lg : 31; }
            BIAS[g * 128 + dist] = P.in[2][bucket * 16 + hk * 4 + g];
        }
        __syncthreads();
        const int g = wave >> 1, half = wave & 1, head = hk * 4 + g;
        const float sink = P.in[32][o * 16 + head];
        for (int rt = 0; rt < 4; ++rt) {
            const int q0 = 64 * half + 16 * rt, qi = q0 + l15;
            const size_t qtok = (size_t)(b * SEQ + n * 128 + qi);
            bf16x8 qf[2];
            qf[0] = *(const bf16x8*)(qkv + qtok * QKVW + head * 64 + 8 * quad);
            qf[1] = *(const bf16x8*)(qkv + qtok * QKVW + head * 64 + 32 + 8 * quad);
            const int grp0 = q0 >> 5, tile0 = 2 * grp0;
            f32x4 s[10];
#pragma unroll
            for (int tt = 0; tt < 10; ++tt) {
                const int key = 16 * (tile0 + tt) + l15;
                const bf16x8 k0 = *(const LAS bf16x8*)(KS + key * AK_LD + 8 * quad), k1 = *(const LAS bf16x8*)(KS + key * AK_LD + 32 + 8 * quad);
                f32x4 z = (f32x4){0.f, 0.f, 0.f, 0.f};
                z = __builtin_amdgcn_mfma_f32_16x16x32_bf16(k0, qf[0], z, 0, 0, 0);
                z = __builtin_amdgcn_mfma_f32_16x16x32_bf16(k1, qf[1], z, 0, 0, 0);
                s[tt] = z;
            }
            float mx = sink;
#pragma unroll
            for (int tt = 0; tt < 10; ++tt)
#pragma unroll
                for (int r = 0; r < 4; ++r) {
                    const int kj = 16 * (tile0 + tt) + 4 * quad + r, dist = 128 + qi - kj;
                    const bool valid = (dist >= 0) && (dist < 128) && (n > 0 || kj >= 128);
                    const float sc = valid ? s[tt][r] * 0.125f + BIAS[g * 128 + (dist & 127)] : -1e30f;
                    s[tt][r] = sc; mx = fmaxf(mx, sc);
                }
            mx = fmaxf(mx, __shfl_xor(mx, 16)); mx = fmaxf(mx, __shfl_xor(mx, 32));
            float l = 0.f;
#pragma unroll
            for (int tt = 0; tt < 10; ++tt)
#pragma unroll
                for (int r = 0; r < 4; ++r) { const float p = __expf(s[tt][r] - mx); s[tt][r] = p; l += p; }
            l += __shfl_xor(l, 16); l += __shfl_xor(l, 32);
            l += __expf(sink - mx);
            f32x4 oacc[4];
#pragma unroll
            for (int t = 0; t < 4; ++t) oacc[t] = (f32x4){0.f, 0.f, 0.f, 0.f};
#pragma unroll
            for (int jp = 0; jp < 5; ++jp) {
                u32x4 pw; pw.x = pk2(s[2 * jp][0], s[2 * jp][1]); pw.y = pk2(s[2 * jp][2], s[2 * jp][3]); pw.z = pk2(s[2 * jp + 1][0], s[2 * jp + 1][1]); pw.w = pk2(s[2 * jp + 1][2], s[2 * jp + 1][3]);
                const bf16x8 pf = __builtin_bit_cast(bf16x8, pw);
                const int keybase = 32 * (grp0 + jp);
#pragma unroll
                for (int t = 0; t < 4; ++t) {
                    const LAS bf16_t* vp = VT + (16 * t + l15) * AV_LD + keybase + 4 * quad;
                    const u32x2 va = *(const LAS u32x2*)vp, vb = *(const LAS u32x2*)(vp + 16);
                    u32x4 vw; vw.x = va.x; vw.y = va.y; vw.z = vb.x; vw.w = vb.y;
                    oacc[t] = __builtin_amdgcn_mfma_f32_16x16x32_bf16(__builtin_bit_cast(bf16x8, vw), pf, oacc[t], 0, 0, 0);
                }
            }
            const float inv = 1.0f / l;
#pragma unroll
            for (int t = 0; t < 4; ++t) {
                u32x2 w; w.x = pk2(oacc[t][0] * inv, oacc[t][1] * inv); w.y = pk2(oacc[t][2] * inv, oacc[t][3] * inv);
                *(u32x2*)(mix + qtok * D + head * 64 + 16 * t + 4 * quad) = w;
            }
        }
        __syncthreads();
    }
}

__device__ __forceinline__ void phase_final(const Params& P) {
    const int tid_ = otid(); const int lane = tid_ & 63, wave = tid_ >> 6;
    const float* ssq = (const float*)(P.ws + WS_SSQ);
    for (int m = obid() * 8 + wave, mstep = ogrid() * 8; m < T; m += mstep) {
        const float s = pg8::row_scale(ssq, m);
        f32x4* xr = (f32x4*)(P.out + (size_t)m * D) + lane; const f32x4* gp = (const f32x4*)P.in[3] + lane;
#pragma unroll
        for (int j = 0; j < 4; ++j) xr[64 * j] = xr[64 * j] * s * gp[64 * j];
    }
}

__global__ void __launch_bounds__(NTHREADS, 2) mk_fwd(Params P_arg) {
    extern __shared__ __attribute__((aligned(16))) unsigned char lds_raw[];
    LAS unsigned char* lds = (LAS unsigned char*)lds_raw;
    cg::grid_group grid = cg::this_grid();
    for (int ph = P_arg.ph_lo; ph < P_arg.ph_hi; ++ph) {
        bool did = true;
        const __attribute__((address_space(4))) Params* Pk = (const __attribute__((address_space(4))) Params*)__builtin_amdgcn_kernarg_segment_ptr();
        asm volatile("" : "+s"(Pk));
        const Params& P = *(const Params*)Pk;
        unsigned char* ws = P.ws;
        float* ssq = (float*)(ws + WS_SSQ);
        bf16_t* XB = (bf16_t*)(ws + WS_XB); bf16_t* XBALT = (bf16_t*)(ws + WS_MIX); bf16_t* HZ = (bf16_t*)(ws + WS_HZ); bf16_t* MIX = (bf16_t*)(ws + WS_MIX);
        float* PP = (float*)(ws + WS_PP);
        if (ph == 0) phase_prepass(P, lds);
        else if (ph == 41) phase_final(P);
        else {
            const int L = (ph - 1) / 10, s = (ph - 1) % 10, even = !(L & 1), eo = L >> 1;
            if (s == 3) {
                if (even) { phase_g1(P, lds, eo); phase_l1(P, lds, eo); } else phase_attn(P, lds, eo);
            } else if (s == 4) {
                if (even) { phase_g2(P); phase_l2(P); } else did = false;
            } else if (s == 5) {
                if (even) { phase_g3(P, lds, eo); phase_l3(P); } else did = false;
            } else {
                const int ng = (s == 7) ? 2 : 1;
#pragma nounroll
                for (int gi = 0; gi < ng; ++gi) {
                    pg8::Epi E; E.mode = 0; E.ssq_in = nullptr; E.ssq_out = nullptr; E.xin = nullptr; E.xout = nullptr; E.xb = nullptr; E.ob = nullptr; E.ldo = 0; E.of = nullptr; E.bias = nullptr; E.alpha = 1.0f;
                    const bf16_t* A = XB; const bf16_t* Bt = nullptr; int N = 1024, K = 1024;
                    if (gi == 1) {
                        E.mode = 2; E.of = PP; A = (const bf16_t*)(ws + WS_PB) + (size_t)L * T * 256; Bt = (const bf16_t*)(ws + WS_WPP) + (size_t)L * 1024 * 256; N = 1024; K = 256;
                    } else if (s == 0 || s == 7) {
                        const int w = (s == 7);
                        E.mode = 0; E.ssq_in = ssq + (size_t)((4 * L + (w ? 2 : 0)) & 1) * T * 16; E.ob = HZ; E.ldo = FF;
                        A = w ? XB : XBALT; Bt = (const bf16_t*)(ws + WS_WUP) + (size_t)(2 * L + w) * 5632 * 1024; N = 5632; K = 1024;
                    } else if (s == 1 || s == 8) {
                        const int w = (s == 8);
                        E.mode = 3; E.xin = (L == 0 && !w) ? P.in[0] : P.out; E.xout = P.out; E.xb = XB; E.ssq_out = ssq + (size_t)((4 * L + (w ? 3 : 1)) & 1) * T * 16; E.alpha = 0.5f;
                        A = HZ; Bt = (const bf16_t*)(ws + WS_WDN) + (size_t)(2 * L + w) * 1024 * 2816; N = 1024; K = 2816;
                    } else if (s == 2) {
                        E.mode = 1; E.ssq_in = ssq + (size_t)((4 * L + 1) & 1) * T * 16; E.ob = HZ; A = XB; K = 1024;
                        if (even) { E.ldo = ZW; Bt = (const bf16_t*)(ws + WS_WIN) + (size_t)eo * 2816 * 1024; N = 2816; }
                        else { E.ldo = QKVW; E.bias = P.in[29] + eo * 1536; Bt = (const bf16_t*)(ws + WS_WQKV) + (size_t)eo * 1536 * 1024; N = 1536; }
                    } else if (s == 6) {
                        E.mode = 3; E.xin = P.out; E.xout = P.out; E.xb = XB; E.ssq_out = ssq + (size_t)((4 * L + 2) & 1) * T * 16; E.alpha = 1.0f;
                        E.bias = even ? nullptr : P.in[31] + eo * 1024;
                        A = MIX; Bt = even ? (const bf16_t*)(ws + WS_WOUT) + (size_t)eo * 1024 * 1024 : (const bf16_t*)(ws + WS_WO) + (size_t)eo * 1024 * 1024; N = 1024; K = 1024;
                    } else {
                        E.mode = 4; E.ssq_in = ssq + (size_t)((4 * L + 3) & 1) * T * 16; E.ssq_out = ssq + (size_t)((4 * L + 4) & 1) * T * 16; E.of = PP; E.xin = P.out; E.xout = P.out; E.xb = XBALT;
                        A = XB; Bt = (const bf16_t*)(ws + WS_WPG) + (size_t)L * 1024 * 1024; N = 1024; K = 1024;
                    }
                    run_gemm(lds, A, Bt, N, K, E);
                }
            }
        }
        if (did && ph + 1 < P_arg.ph_hi) grid.sync();
    }
}

extern "C" void kernel_launch(void* const* d_in, const int* in_sizes, int n_in, void* d_out, int out_size, void* d_ws, size_t ws_size, hipStream_t stream) {
    static int grid = 0;
    if (grid == 0) {
        if (n_in != 33 || out_size != T * D || ws_size < WS_END) { fprintf(stderr, "kernel_launch: unexpected shapes (n_in %d out %d ws %zu need %zu)\n", n_in, out_size, ws_size, (size_t)WS_END); grid = -1; return; }
        int dev = 0, cus = 0, per_cu = 0;
        hipGetDevice(&dev); hipDeviceGetAttribute(&cus, hipDeviceAttributeMultiprocessorCount, dev);
        if (hipFuncSetAttribute((const void*)mk_fwd, hipFuncAttributeMaxDynamicSharedMemorySize, LDS_BYTES) != hipSuccess) { fprintf(stderr, "hipFuncSetAttribute failed\n"); grid = -1; return; }
        if (hipOccupancyMaxActiveBlocksPerMultiprocessor(&per_cu, (const void*)mk_fwd, NTHREADS, LDS_BYTES) != hipSuccess || per_cu < 1) per_cu = 1;
        (void)hipGetLastError();
        grid = cus * 1;
    }
    if (grid < 0) return;
    Params p{};
    for (int i = 0; i < 33; ++i) p.in[i] = (const float*)d_in[i];
    p.out = (float*)d_out; p.ws = (unsigned char*)d_ws;
#if COOP
    p.ph_lo = 0; p.ph_hi = 42;
    void* args[] = {&p};
    hipError_t e = hipLaunchCooperativeKernel((const void*)mk_fwd, dim3(grid), dim3(NTHREADS), args, LDS_BYTES, stream);
    if (e != hipSuccess) fprintf(stderr, "cooperative launch failed: %s (grid %d)\n", hipGetErrorString(e), grid);
#else
    for (int ph = 0; ph < 42; ++ph) {
        if (ph >= 1 && ph <= 40) { const int L = (ph - 1) / 10, s = (ph - 1) % 10; if ((L & 1) && (s == 4 || s == 5)) continue; }
        p.ph_lo = ph; p.ph_hi = ph + 1;
        hipLaunchKernelGGL(mk_fwd, dim3(grid), dim3(NTHREADS), LDS_BYTES, stream, p);
    }
#endif
}
```

```cpp
#include <hip/hip_runtime.h>
#include <hip/hip_cooperative_groups.h>
#include <cstdio>
namespace cg = cooperative_groups;

#ifndef COOP
#define COOP 1
#endif

#ifndef PROBE_DUP
#define PROBE_DUP 0
#endif
#define LAS __attribute__((address_space(3)))
typedef unsigned short bf16_t;
typedef short bf16x8 __attribute__((ext_vector_type(8)));
typedef float f32x4 __attribute__((ext_vector_type(4)));
typedef float f32x2 __attribute__((ext_vector_type(2)));
typedef unsigned u32x4 __attribute__((ext_vector_type(4)));
typedef unsigned u32x2 __attribute__((ext_vector_type(2)));

constexpr int T = 16384, D = 1024, FF = 2816, SEQ = 4096;
constexpr int ZW = 2816, QKVW = 1536;
constexpr float EPS = 1e-6f;
constexpr int NTHREADS = 512;
constexpr int LDS_BYTES = 147456;

constexpr size_t WS_SSQ = 0;
constexpr size_t WS_WUP = 2097152;
constexpr size_t WS_WDN = WS_WUP + 8ull * 5632 * 1024 * 2;
constexpr size_t WS_WIN = WS_WDN + 8ull * 1024 * 2816 * 2;
constexpr size_t WS_WOUT = WS_WIN + 2ull * 2816 * 1024 * 2;
constexpr size_t WS_WQKV = WS_WOUT + 2ull * 1024 * 1024 * 2;
constexpr size_t WS_WO = WS_WQKV + 2ull * 1536 * 1024 * 2;
constexpr size_t WS_WPG = WS_WO + 2ull * 1024 * 1024 * 2;
constexpr size_t WS_WPP = WS_WPG + 4ull * 1024 * 1024 * 2;
constexpr size_t WS_XB = WS_WPP + 4ull * 1024 * 256 * 2;
constexpr size_t WS_PB = WS_XB + (size_t)T * 1024 * 2;
constexpr size_t WS_HZ = WS_PB + 4ull * T * 256 * 2;
constexpr size_t WS_MIX = WS_HZ + (size_t)T * 2816 * 2;
constexpr size_t WS_SCR = WS_MIX + (size_t)T * 1024 * 2;
constexpr size_t WS_S = WS_SCR;
constexpr size_t WS_HL = WS_S + 1024ull * 8192 * 4;
constexpr size_t WS_AC = WS_HL + (size_t)T * 512 * 4;
constexpr size_t WS_CARRY = WS_AC + (size_t)T * 512 * 4;
constexpr size_t WS_DECAY = WS_CARRY + 4ull * 64 * 512 * 4;
constexpr size_t WS_CTL = WS_DECAY + 1024ull * 64 * 4;
constexpr size_t CTL_BYTES = 16384;
constexpr size_t WS_QK0 = WS_CTL + CTL_BYTES;
constexpr size_t WS_END = WS_QK0 + 8192;
constexpr size_t WS_PP = WS_SCR;

struct Params {
    const float* in[33];
    float* out;
    unsigned char* ws;
    int ph_lo, ph_hi;
};

__device__ __forceinline__ float bf_lo(unsigned w) { return __uint_as_float(w << 16); }
__device__ __forceinline__ float bf_hi(unsigned w) { return __uint_as_float(w & 0xffff0000u); }
__device__ __forceinline__ unsigned f2bf(float f) { unsigned u = __float_as_uint(f); return (u + 0x7fffu + ((u >> 16) & 1u)) >> 16; }
__device__ __forceinline__ unsigned pk2(float lo, float hi) { unsigned r; asm volatile("v_cvt_pk_bf16_f32 %0, %1, %2" : "=v"(r) : "v"(lo), "v"(hi)); return r; }
__device__ __forceinline__ float sigmoidf_(float x) { return __builtin_amdgcn_rcpf(1.0f + __expf(-x)); }
__device__ __forceinline__ float siluf_(float x) { return x * __builtin_amdgcn_rcpf(1.0f + __expf(-x)); }
__device__ __forceinline__ float gelu_tanh(float x) { const float y = 0.7978845608028654f * (x + 0.044715f * x * x * x); return x / (1.0f + __expf(-2.0f * y)); }
__device__ __forceinline__ float softplusf_(float x) { return fmaxf(x, 0.f) + log1pf(__expf(-fabsf(x))); }
__device__ __forceinline__ float logsigmoidf_(float x) { return fminf(x, 0.f) - __logf(1.0f + __expf(-fabsf(x))); }
__device__ __forceinline__ int otid() { int t = threadIdx.x; asm volatile("" : "+v"(t)); return t; }
__device__ __forceinline__ int obid() { int b = blockIdx.x; asm volatile("" : "+s"(b)); return b; }
__device__ __forceinline__ int ogrid() { int g = gridDim.x; asm volatile("" : "+s"(g)); return g; }
__device__ __forceinline__ int pinv32(int c) { return 16 * ((c >> 2) & 1) + 4 * (c >> 3) + (c & 3); }
__device__ __forceinline__ float wave_sum(float v) {
#pragma unroll
    for (int o = 1; o < 64; o <<= 1) v += __shfl_xor(v, o);
    return v;
}

namespace pg8 {
constexpr int BM = 256, BK = 64, HALF = 128, HTB = HALF * BK * 2, STAGE_BYTES = 8 * HTB, NXCD = 8, WGM = 8;
__host__ __device__ __forceinline__ int lds_byte(int r, int c) { const int st = (r >> 4) * 2 + (c >> 5), rr = r & 15, cc = c & 31, ob = rr * 64 + cc * 2; return st * 1024 + (ob ^ (((ob >> 9) & 1) << 5)); }
__host__ __device__ __forceinline__ void stage_rc(int b, int& R, int& C) { const int st = b / 1024, sb = b % 1024, swz = sb ^ (((sb >> 9) & 1) << 5); R = (st >> 1) * 16 + swz / 64; C = (st & 1) * 32 + (swz % 64) / 2; }
struct Unit { int pm, pn; };
struct Gemm { const bf16_t* A; const bf16_t* Bt; int M, N, K; };
struct StaticOrder {
    int nM, nN, nwg, G, c;
    __device__ void init(int M, int N, int G_, int c_) { nM = M / BM; nN = N / BM; nwg = nM * nN; G = G_; c = c_; }
    __device__ bool next(int i, Unit& u) const {
        const long L = (long)i * G + c; if (L >= nwg) return false;
        int wgid = (int)L; { const int q = nwg / NXCD, r = nwg % NXCD, xcd = wgid % NXCD, off = wgid / NXCD; wgid = (xcd < r ? xcd * (q + 1) : r * (q + 1) + (xcd - r) * q) + off; }
        const int nig = WGM * nN, gid = wgid / nig, fm = gid * WGM, gsz = (nM - fm) < WGM ? (nM - fm) : WGM;
        u.pm = fm + ((wgid % nig) % gsz); u.pn = (wgid % nig) / gsz; return true;
    }
};

__device__ __forceinline__ float row_scale(const float* part, int row) {
    const f32x4* p = (const f32x4*)(part + (size_t)row * 16);
    const f32x4 a = p[0], b = p[1], c = p[2], d = p[3];
    const float s = (((a[0] + a[1]) + (a[2] + a[3])) + ((b[0] + b[1]) + (b[2] + b[3]))) + (((c[0] + c[1]) + (c[2] + c[3])) + ((d[0] + d[1]) + (d[2] + d[3])));
    return rsqrtf(s * (1.0f / 1024.0f) + EPS);
}
struct Epi {
    int mode;
    const float* ssq_in;
    float* ssq_out;
    const float* xin;
    const bf16_t* hin; const bf16_t* lin; bf16_t* xb; bf16_t* lout;
    bf16_t* ob; int ldo;
    float* of;
    const float* bias;
    float alpha;
    __device__ __forceinline__ void scales2(const Unit& u, int wr, int fr, int fq, float& sA, float& sB) const {
        const int rowA = u.pm * BM + wr * 64 + fq * 16 + fr;
        const f32x4* pa = (const f32x4*)(ssq_in + (size_t)rowA * 16); const f32x4* pb = (const f32x4*)(ssq_in + (size_t)(rowA + HALF) * 16);
        const f32x4 a0 = pa[0], a1 = pa[1], a2 = pa[2], a3 = pa[3], b0 = pb[0], b1 = pb[1], b2 = pb[2], b3 = pb[3];
        const float ta = (((a0[0] + a0[1]) + (a0[2] + a0[3])) + ((a1[0] + a1[1]) + (a1[2] + a1[3]))) + (((a2[0] + a2[1]) + (a2[2] + a2[3])) + ((a3[0] + a3[1]) + (a3[2] + a3[3])));
        const float tb = (((b0[0] + b0[1]) + (b0[2] + b0[3])) + ((b1[0] + b1[1]) + (b1[2] + b1[3]))) + (((b2[0] + b2[1]) + (b2[2] + b2[3])) + ((b3[0] + b3[1]) + (b3[2] + b3[3])));
        sA = rsqrtf(ta * (1.0f / 1024.0f) + EPS); sB = rsqrtf(tb * (1.0f / 1024.0f) + EPS);
    }
    template <int mode> __device__ __forceinline__ void run(const f32x4 (&acc)[2][2][4][2], const Unit& u, int wr, int wc, int fr, int fq, const LAS float* sc) const {
        const int row0 = u.pm * BM + wr * 64 + fr;
        if (mode == 0) {
            const int col0 = u.pn * HALF + wc * 32 + 8 * fq;
#pragma unroll
            for (int ai = 0; ai < 2; ++ai)
#pragma unroll
                for (int m = 0; m < 4; ++m) {
                    const int row = row0 + ai * HALF + m * 16;
                    const float s = sc[ai * HALF + wr * 64 + m * 16 + fr];
                    const f32x4 g0 = acc[ai][0][m][0] * s, u0 = acc[ai][1][m][0] * s, g1 = acc[ai][0][m][1] * s, u1 = acc[ai][1][m][1] * s;
                    u32x4 w;
                    w.x = pk2(siluf_(g0[0]) * u0[0], siluf_(g0[1]) * u0[1]); w.y = pk2(siluf_(g0[2]) * u0[2], siluf_(g0[3]) * u0[3]);
                    w.z = pk2(siluf_(g1[0]) * u1[0], siluf_(g1[1]) * u1[1]); w.w = pk2(siluf_(g1[2]) * u1[2], siluf_(g1[3]) * u1[3]);
                    *(u32x4*)(ob + (size_t)row * FF + col0) = w;
                }
        } else if (mode == 1) {
            const int col0 = u.pn * BM + wc * 32 + 8 * fq;
            f32x4 bv[2][2];
#pragma unroll
            for (int bj = 0; bj < 2; ++bj)
#pragma unroll
                for (int n = 0; n < 2; ++n) bv[bj][n] = bias ? *(const f32x4*)(bias + col0 + bj * HALF + 4 * n) : (f32x4){0.f, 0.f, 0.f, 0.f};
#pragma unroll
            for (int ai = 0; ai < 2; ++ai)
#pragma unroll
                for (int m = 0; m < 4; ++m) {
                    const int row = row0 + ai * HALF + m * 16;
                    const float s = sc[ai * HALF + wr * 64 + m * 16 + fr];
                    bf16_t* rowp = ob + (size_t)row * ldo + col0;
#pragma unroll
                    for (int bj = 0; bj < 2; ++bj) {
                        const f32x4 v0 = acc[ai][bj][m][0] * s + bv[bj][0], v1 = acc[ai][bj][m][1] * s + bv[bj][1];
                        u32x4 w; w.x = pk2(v0[0], v0[1]); w.y = pk2(v0[2], v0[3]); w.z = pk2(v1[0], v1[1]); w.w = pk2(v1[2], v1[3]);
                        *(u32x4*)(rowp + bj * HALF) = w;
                    }
                }
        } else if (mode == 2) {
            const int col0 = u.pn * BM + wc * 32 + 8 * fq;
#pragma unroll
            for (int ai = 0; ai < 2; ++ai)
#pragma unroll
                for (int m = 0; m < 4; ++m) {
                    bf16_t* rowp = ob + (size_t)(row0 + ai * HALF + m * 16) * D + col0;
#pragma unroll
                    for (int bj = 0; bj < 2; ++bj) {
                        const f32x4 v0 = acc[ai][bj][m][0], v1 = acc[ai][bj][m][1];
                        u32x4 w; w.x = pk2(v0[0], v0[1]); w.y = pk2(v0[2], v0[3]); w.z = pk2(v1[0], v1[1]); w.w = pk2(v1[2], v1[3]);
                        *(u32x4*)(rowp + bj * HALF) = w;
                    }
                }
        } else {
            const int col0 = u.pn * BM + wc * 32 + 8 * fq;
            f32x4 bvv[4];
#pragma unroll
            for (int q = 0; q < 4; ++q) bvv[q] = (mode != 4 && bias) ? *(const f32x4*)(bias + col0 + (q >> 1) * HALF + (q & 1) * 4) : (f32x4){0.f, 0.f, 0.f, 0.f};
            f32x4 xi[2][4]; u32x4 pq[2][2]; u32x4 xh[2][2], xl[2][2];
            {
                const size_t off = (size_t)row0 * D + col0;
#pragma unroll
                for (int bj = 0; bj < 2; ++bj) {
                    const size_t o = off + bj * HALF;
                    if (mode == 5) { xi[0][2 * bj] = *(const f32x4*)(xin + o); xi[0][2 * bj + 1] = *(const f32x4*)(xin + o + 4); }
                    else { xh[0][bj] = *(const u32x4*)(hin + o); xl[0][bj] = *(const u32x4*)(lin + o); }
                    if (mode == 4) pq[0][bj] = *(const u32x4*)(ob + o);
                }
            }
#pragma unroll
            for (int g = 0; g < 8; ++g) {
                const int ai = g >> 2, m = g & 3, cb = g & 1, nb = cb ^ 1;
                const int row = row0 + ai * HALF + m * 16;
                const size_t off = (size_t)row * D + col0;
                if (g < 7) {
                    const size_t offn = (size_t)(row0 + ((g + 1) >> 2) * HALF + ((g + 1) & 3) * 16) * D + col0;
#pragma unroll
                    for (int bj = 0; bj < 2; ++bj) {
                        const size_t o = offn + bj * HALF;
                        if (mode == 5) { xi[nb][2 * bj] = *(const f32x4*)(xin + o); xi[nb][2 * bj + 1] = *(const f32x4*)(xin + o + 4); }
                        else { xh[nb][bj] = *(const u32x4*)(hin + o); xl[nb][bj] = *(const u32x4*)(lin + o); }
                        if (mode == 4) pq[nb][bj] = *(const u32x4*)(ob + o);
                    }
                }
                float s = 1.f;
                if (mode == 4) s = sc[ai * HALF + wr * 64 + m * 16 + fr];
                float ss = 0.f;
#pragma unroll
                for (int bj = 0; bj < 2; ++bj) {
                    u32x4 wh, wl;
#pragma unroll
                    for (int n = 0; n < 2; ++n) {
                        const int q = 2 * bj + n;
                        const unsigned h0 = n ? xh[cb][bj].z : xh[cb][bj].x, h1 = n ? xh[cb][bj].w : xh[cb][bj].y, l0 = n ? xl[cb][bj].z : xl[cb][bj].x, l1 = n ? xl[cb][bj].w : xl[cb][bj].y;
                        f32x4 xo;
                        if (mode == 5) xo = xi[cb][q];
                        else { xo[0] = bf_lo(h0) + bf_lo(l0); xo[1] = bf_hi(h0) + bf_hi(l0); xo[2] = bf_lo(h1) + bf_lo(l1); xo[3] = bf_hi(h1) + bf_hi(l1); }
                        f32x4 v;
                        if (mode != 4) v = xo + acc[ai][bj][m][n] * alpha + bvv[q];
                        else {
                            const f32x4 a = acc[ai][bj][m][n] * s;
                            const unsigned p0 = n ? pq[cb][bj].z : pq[cb][bj].x, p1 = n ? pq[cb][bj].w : pq[cb][bj].y;
                            v[0] = xo[0] + sigmoidf_(a[0]) * bf_lo(p0); v[1] = xo[1] + sigmoidf_(a[1]) * bf_hi(p0);
                            v[2] = xo[2] + sigmoidf_(a[2]) * bf_lo(p1); v[3] = xo[3] + sigmoidf_(a[3]) * bf_hi(p1);
                        }
                        const unsigned w0 = pk2(v[0], v[1]), w1 = pk2(v[2], v[3]);
                        const unsigned m0 = pk2(v[0] - bf_lo(w0), v[1] - bf_hi(w0)), m1 = pk2(v[2] - bf_lo(w1), v[3] - bf_hi(w1));
                        if (n == 0) { wh.x = w0; wh.y = w1; wl.x = m0; wl.y = m1; } else { wh.z = w0; wh.w = w1; wl.z = m0; wl.w = m1; }
                        ss += (v[0] * v[0] + v[1] * v[1]) + (v[2] * v[2] + v[3] * v[3]);
                    }
                    *(u32x4*)(xb + off + bj * HALF) = wh;
                    *(u32x4*)(lout + off + bj * HALF) = wl;
                }
                ss += __shfl_xor(ss, 16); ss += __shfl_xor(ss, 32);
                if (fq == 0) ssq_out[(size_t)row * 16 + u.pn * 4 + wc] = ss;
            }
        }
    }
};

template <int MODE, class EpiT, class Sched>
__device__ __forceinline__ void gemm_phase(LAS unsigned char* lds, const Gemm g, const Sched& S, const EpiT& E) {
    const int tid = otid(), wid = __builtin_amdgcn_readfirstlane(tid >> 6), lane = tid & 63, wr = wid >> 2, wc = wid & 3, fr = lane & 15, fq = lane >> 4;
    const int K = g.K, nt = K / BK;
    unsigned voffA[2], voffB[2];
#pragma unroll
    for (int i = 0; i < 2; ++i) { int R, C; stage_rc(tid * 16 + i * 8192, R, C); voffA[i] = (unsigned)(R * K + C) * 2u; voffB[i] = (unsigned)(R * K + C) * 2u; }
    const size_t kstep = (size_t)(BK * 2);
    const size_t hstep = (size_t)HALF * K * 2;
    const size_t tstep = 2 * hstep;
    const unsigned ldsw = (unsigned)wid * 1024u;
    const int aoff = lds_byte(wr * 64 + fr, fq * 8), boff = lds_byte(wc * 32 + fr, fq * 8);
#define PG8_SA(b, h) (((b) * 2 + (h)) * HTB)
#define PG8_SB(b, h) ((4 + (b) * 2 + (h)) * HTB)
#define PG8_STAGE(bufoff, gbase, voff) do { _Pragma("unroll") for (int _i = 0; _i < 2; ++_i) \
        __builtin_amdgcn_global_load_lds((const unsigned*)((const char*)(gbase) + (voff)[_i]), (LAS unsigned*)(lds + (bufoff) + ldsw + _i * 8192), 16, 0, 0); } while (0)
#define PG8_LDA(dst, b, h) do { _Pragma("unroll") for (int m = 0; m < 4; ++m) _Pragma("unroll") for (int k = 0; k < 2; ++k) dst[m][k] = *(const LAS bf16x8*)(lds + PG8_SA(b, h) + aoff + m * 2048 + k * 1024); } while (0)
#define PG8_LDB(dst, b, h) do { _Pragma("unroll") for (int n = 0; n < 2; ++n) _Pragma("unroll") for (int k = 0; k < 2; ++k) dst[n][k] = *(const LAS bf16x8*)(lds + PG8_SB(b, h) + boff + n * 2048 + k * 1024); } while (0)
#define PG8_MMA(ai, bj, At, Bt) do { __builtin_amdgcn_s_setprio(1); _Pragma("unroll") for (int m = 0; m < 4; ++m) _Pragma("unroll") for (int n = 0; n < 2; ++n) _Pragma("unroll") for (int k = 0; k < 2; ++k) \
        acc[ai][bj][m][n] = __builtin_amdgcn_mfma_f32_16x16x32_bf16(Bt[n][k], At[m][k], acc[ai][bj][m][n], 0, 0, 0); __builtin_amdgcn_s_setprio(0); } while (0)
#define PG8_WAIT_V(n) asm volatile("s_waitcnt vmcnt(" #n ")" ::: "memory")
#define PG8_WAIT_L(n) asm volatile("s_waitcnt lgkmcnt(" #n ")" ::: "memory")
#define PG8_BAR __builtin_amdgcn_s_barrier()
#define PG8_SCHED __builtin_amdgcn_sched_barrier(0)
    Unit cur, nxt; int ui = 0;
    if (!S.next(0, cur)) return;
    LAS float* SC = (LAS float*)(lds + STAGE_BYTES);
    if (MODE <= 1 || MODE == 4) {
        constexpr int NU = (MODE == 4) ? 1 : 6;
        f32x4 pa[NU], pb[NU]; bool ok[NU];
#pragma unroll
        for (int i = 0; i < NU; ++i) {
            Unit uu; ok[i] = S.next(i, uu);
            const int row = (ok[i] ? uu.pm : cur.pm) * BM + (tid >> 1);
            const f32x4* p = (const f32x4*)(E.ssq_in + (size_t)row * 16) + (tid & 1) * 2;
            pa[i] = p[0]; pb[i] = p[1];
        }
#pragma unroll
        for (int i = 0; i < NU; ++i) {
            float s = ((pa[i][0] + pa[i][1]) + (pa[i][2] + pa[i][3])) + ((pb[i][0] + pb[i][1]) + (pb[i][2] + pb[i][3]));
            s += __shfl_xor(s, 1);
            if (!(tid & 1)) SC[i * 256 + (tid >> 1)] = rsqrtf(s * (1.0f / 1024.0f) + EPS);
        }
        __syncthreads();
    }
    f32x4 acc[2][2][4][2];
#pragma unroll
    for (int a = 0; a < 2; ++a)
#pragma unroll
        for (int b = 0; b < 2; ++b)
#pragma unroll
            for (int m = 0; m < 4; ++m)
#pragma unroll
                for (int n = 0; n < 2; ++n) acc[a][b][m][n] = (f32x4){0.f, 0.f, 0.f, 0.f};
    bf16x8 At[4][2], B0[2][2], B1[2][2];
    const char* cA = (const char*)g.A + (size_t)cur.pm * tstep; const char* cB = (const char*)g.Bt + (size_t)cur.pn * tstep;
    PG8_STAGE(PG8_SB(0, 0), cB, voffB); PG8_STAGE(PG8_SA(0, 0), cA, voffA); PG8_STAGE(PG8_SB(0, 1), cB + hstep, voffB); PG8_STAGE(PG8_SA(0, 1), cA + hstep, voffA);
    if (wr == 1) PG8_BAR;
    PG8_WAIT_V(4); PG8_BAR;
    PG8_STAGE(PG8_SB(1, 0), cB + kstep, voffB); PG8_STAGE(PG8_SA(1, 0), cA + kstep, voffA); PG8_STAGE(PG8_SB(1, 1), cB + hstep + kstep, voffB);
    PG8_WAIT_V(6); PG8_BAR;
    for (;;) {
        const bool has_next = S.next(ui + 1, nxt);
        const char* nA = has_next ? (const char*)g.A + (size_t)nxt.pm * tstep : cA; const char* nB = has_next ? (const char*)g.Bt + (size_t)nxt.pn * tstep : cB;
        for (int t = 0; t < nt; t += 2) {
            const bool last = (t == nt - 2);
            const char* a1 = cA + (size_t)(t + 1) * kstep;
            const char* a2 = last ? nA : cA + (size_t)(t + 2) * kstep; const char* b2 = last ? nB : cB + (size_t)(t + 2) * kstep;
            const char* a3 = a2 + kstep; const char* b3 = b2 + kstep;
            PG8_LDB(B0, 0, 0); PG8_SCHED; PG8_LDA(At, 0, 0); PG8_STAGE(PG8_SA(1, 1), a1 + hstep, voffA);
            PG8_WAIT_L(8); PG8_BAR; PG8_WAIT_L(0); PG8_MMA(0, 0, At, B0); PG8_BAR; PG8_SCHED;
            PG8_LDB(B1, 0, 1); PG8_STAGE(PG8_SB(0, 0), b2, voffB);
            PG8_BAR; PG8_WAIT_L(0); PG8_MMA(0, 1, At, B1); PG8_BAR;
            PG8_LDA(At, 0, 1); PG8_STAGE(PG8_SA(0, 0), a2, voffA);
            PG8_BAR; PG8_WAIT_L(0); PG8_MMA(1, 0, At, B0); PG8_BAR; PG8_SCHED;
            PG8_STAGE(PG8_SB(0, 1), b2 + hstep, voffB);
            PG8_WAIT_V(6); PG8_BAR; PG8_MMA(1, 1, At, B1); PG8_BAR;
            PG8_LDB(B0, 1, 0); PG8_SCHED; PG8_LDA(At, 1, 0); PG8_STAGE(PG8_SA(0, 1), a2 + hstep, voffA);
            PG8_WAIT_L(8); PG8_BAR; PG8_WAIT_L(0); PG8_MMA(0, 0, At, B0); PG8_BAR; PG8_SCHED;
            PG8_LDB(B1, 1, 1); PG8_STAGE(PG8_SB(1, 0), b3, voffB);
            PG8_BAR; PG8_WAIT_L(0); PG8_MMA(0, 1, At, B1); PG8_BAR;
            PG8_LDA(At, 1, 1); PG8_STAGE(PG8_SA(1, 0), a3, voffA);
            PG8_BAR; PG8_WAIT_L(0); PG8_MMA(1, 0, At, B0); PG8_BAR; PG8_SCHED;
            PG8_STAGE(PG8_SB(1, 1), b3 + hstep, voffB);
            PG8_WAIT_V(6); PG8_BAR; PG8_MMA(1, 1, At, B1); PG8_BAR;
        }
        E.template run<MODE>(acc, cur, wr, wc, fr, fq, SC + ui * 256);
        if (!has_next) break;
#pragma unroll
        for (int a = 0; a < 2; ++a)
#pragma unroll
            for (int b = 0; b < 2; ++b)
#pragma unroll
                for (int m = 0; m < 4; ++m)
#pragma unroll
                    for (int n = 0; n < 2; ++n) acc[a][b][m][n] = (f32x4){0.f, 0.f, 0.f, 0.f};
        cur = nxt; cA = nA; cB = nB; ++ui;
    }
    PG8_WAIT_V(0);
    if (wr == 0) PG8_BAR;
    PG8_BAR;
#undef PG8_SA
#undef PG8_SB
#undef PG8_STAGE
#undef PG8_LDA
#undef PG8_LDB
#undef PG8_MMA
#undef PG8_WAIT_V
#undef PG8_WAIT_L
#undef PG8_BAR
#undef PG8_SCHED
}
}

__device__ __forceinline__ void run_gemm(LAS unsigned char* lds, const bf16_t* A, const bf16_t* Bt, int N, int K, const pg8::Epi& E, int c0 = 0) {
    const int G_ = ogrid() - c0, c_ = obid() - c0;
    if (c_ < 0) return;
    pg8::Gemm g{A, Bt, T, N, K}; pg8::StaticOrder S; S.init(T, N, G_, c_);
    switch (E.mode) {
    case 0: pg8::gemm_phase<0, pg8::Epi, pg8::StaticOrder>(lds, g, S, E); break;
    case 1: pg8::gemm_phase<1, pg8::Epi, pg8::StaticOrder>(lds, g, S, E); break;
    case 2: pg8::gemm_phase<2, pg8::Epi, pg8::StaticOrder>(lds, g, S, E); break;
    case 3: pg8::gemm_phase<3, pg8::Epi, pg8::StaticOrder>(lds, g, S, E); break;
    case 4: pg8::gemm_phase<4, pg8::Epi, pg8::StaticOrder>(lds, g, S, E); break;
    default: pg8::gemm_phase<5, pg8::Epi, pg8::StaticOrder>(lds, g, S, E); break;
    }
}

struct CvtJob { const float* W; const float* gain; bf16_t* dst; int K, ldw, col0, ncols, mode; };

__device__ __forceinline__ CvtJob get_job(const Params& P, int j) {
    CvtJob J; J.gain = nullptr; J.col0 = 0; J.mode = 0;
    unsigned char* ws = P.ws;
    if (j < 16) {
        const int f = j >> 1, part = j & 1, L = f >> 1, w = f & 1;
        const float* src = w ? (part ? P.in[11] : P.in[10]) : (part ? P.in[6] : P.in[5]);
        J.W = src + (size_t)L * 1024 * 2816; J.gain = (w ? P.in[9] : P.in[4]) + L * 1024;
        J.dst = (bf16_t*)(ws + WS_WUP) + (size_t)f * 5632 * 1024 + (size_t)part * 128 * 1024;
        J.K = 1024; J.ldw = 2816; J.ncols = 2816; J.mode = 1;
    } else if (j < 24) {
        const int f = j - 16, L = f >> 1, w = f & 1;
        J.W = (w ? P.in[12] : P.in[7]) + (size_t)L * 2816 * 1024;
        J.dst = (bf16_t*)(ws + WS_WDN) + (size_t)f * 1024 * 2816;
        J.K = 2816; J.ldw = 1024; J.ncols = 1024;
    } else if (j < 28) {
        const int e = (j - 24) >> 1, part = (j - 24) & 1;
        J.W = P.in[16] + (size_t)e * 1024 * 2576; J.gain = P.in[8] + (2 * e) * 1024;
        J.dst = (bf16_t*)(ws + WS_WIN) + (size_t)e * 2816 * 1024 + (part ? (size_t)1536 * 1024 : 0);
        J.K = 1024; J.ldw = 2576; J.col0 = part ? 1552 : 0; J.ncols = part ? 1024 : 1536;
    } else if (j < 30) {
        const int e = j - 28;
        J.W = P.in[17] + (size_t)e * 1024 * 1024; J.dst = (bf16_t*)(ws + WS_WOUT) + (size_t)e * 1024 * 1024;
        J.K = 1024; J.ldw = 1024; J.ncols = 1024;
    } else if (j < 32) {
        const int o = j - 30;
        J.W = P.in[28] + (size_t)o * 1024 * 1536; J.gain = P.in[8] + (2 * o + 1) * 1024;
        J.dst = (bf16_t*)(ws + WS_WQKV) + (size_t)o * 1536 * 1024;
        J.K = 1024; J.ldw = 1536; J.ncols = 1536;
    } else if (j < 34) {
        const int o = j - 32;
        J.W = P.in[30] + (size_t)o * 1024 * 1024; J.dst = (bf16_t*)(ws + WS_WO) + (size_t)o * 1024 * 1024;
        J.K = 1024; J.ldw = 1024; J.ncols = 1024;
    } else if (j < 38) {
        const int L = j - 34;
        J.W = P.in[15] + (size_t)L * 1024 * 1024; J.gain = P.in[13] + L * 1024;
        J.dst = (bf16_t*)(ws + WS_WPG) + (size_t)L * 1024 * 1024;
        J.K = 1024; J.ldw = 1024; J.ncols = 1024;
    } else {
        const int L = j - 38;
        J.W = P.in[14] + (size_t)L * 256 * 1024; J.dst = (bf16_t*)(ws + WS_WPP) + (size_t)L * 1024 * 256;
        J.K = 256; J.ldw = 1024; J.ncols = 1024;
    }
    return J;
}

__device__ __forceinline__ void cvt_item64(const CvtJob& J, int item, LAS float* scr, int lane) {
    const int nblk = J.ncols / 64, kb = item / nblk, nb = item - kb * nblk, k0 = 64 * kb, n0 = 64 * nb;
    const int r4 = lane >> 4, c4 = (lane & 15) * 4;
    f32x4 w[16];
#pragma unroll
    for (int i = 0; i < 16; ++i) w[i] = *(const f32x4*)(J.W + (size_t)(k0 + 4 * i + r4) * J.ldw + J.col0 + n0 + c4);
    if (J.gain) {
#pragma unroll
        for (int i = 0; i < 16; ++i) w[i] = w[i] * J.gain[k0 + 4 * i + r4];
    }
#pragma unroll
    for (int i = 0; i < 16; ++i) { LAS float* d = scr + (4 * i + r4) * 65 + c4; d[0] = w[i][0]; d[1] = w[i][1]; d[2] = w[i][2]; d[3] = w[i][3]; }
    asm volatile("s_waitcnt lgkmcnt(0)" ::: "memory");
    const int c = lane & 7;
#pragma unroll
    for (int j = 0; j < 8; ++j) {
        const int n = (lane >> 3) + 8 * j; const LAS float* s = scr + (8 * c) * 65 + n;
        u32x4 o; o.x = pk2(s[0 * 65], s[1 * 65]); o.y = pk2(s[2 * 65], s[3 * 65]); o.z = pk2(s[4 * 65], s[5 * 65]); o.w = pk2(s[6 * 65], s[7 * 65]);
        const int nn = n0 + n; const int row_ = J.mode ? ((nn >> 7) * 256 + (nn & 127)) : nn;
        const int row = (row_ & ~31) + pinv32(row_ & 31);
        *(u32x4*)(J.dst + (size_t)row * J.K + k0 + 8 * c) = o;
    }
    asm volatile("s_waitcnt lgkmcnt(0)" ::: "memory");
}
__device__ __forceinline__ void cvt_map(int it, int& job, int& local) {
    if (it < 16896) { job = it / 704; local = it - job * 704; }
    else {
        int r = it - 16896;
        if (r < 1280) { const int e = r / 640, rr = r - e * 640, part = rr >= 384; local = part ? rr - 384 : rr; job = 24 + 2 * e + part; }
        else { r -= 1280;
            if (r < 512) { job = 28 + (r >> 8); local = r & 255; }
            else { r -= 512;
                if (r < 768) { const int o = r / 384; job = 30 + o; local = r - o * 384; }
                else { r -= 768;
                    if (r < 1536) { job = 32 + (r >> 8); local = r & 255; }
                    else { r -= 1536; job = 38 + (r >> 6); local = r & 63; } } } }
    }
}

__device__ __forceinline__ void first_token_qk(const Params& P, LAS unsigned char* lds, int L, int c0) {
    const int j = obid() - c0;
    if (j < 0 || j >= 64) return;
    const int e = L >> 1, tid = otid(), col = tid & 7, dg = tid >> 3;
    const float* W = P.in[16] + (size_t)e * 1024 * 2576 + 8 * j + col;
    float w[16];
#pragma unroll
    for (int q = 0; q < 16; ++q) w[q] = W[(size_t)(dg * 16 + q) * 2576];
    LAS float* X = (LAS float*)lds;
    {
        const int b = tid >> 7, d0 = (tid & 127) * 8;
        const size_t o = (size_t)(b * SEQ) * D + d0;
        const u32x4 h8 = *(const u32x4*)((const bf16_t*)(P.ws + WS_XB) + o), l8 = *(const u32x4*)((const bf16_t*)P.out + o);
        const f32x4 g0 = *(const f32x4*)(P.in[8] + L * 1024 + d0), g1 = *(const f32x4*)(P.in[8] + L * 1024 + d0 + 4);
        f32x4 a, c;
        a[0] = (bf_lo(h8.x) + bf_lo(l8.x)) * g0[0]; a[1] = (bf_hi(h8.x) + bf_hi(l8.x)) * g0[1]; a[2] = (bf_lo(h8.y) + bf_lo(l8.y)) * g0[2]; a[3] = (bf_hi(h8.y) + bf_hi(l8.y)) * g0[3];
        c[0] = (bf_lo(h8.z) + bf_lo(l8.z)) * g1[0]; c[1] = (bf_hi(h8.z) + bf_hi(l8.z)) * g1[1]; c[2] = (bf_lo(h8.w) + bf_lo(l8.w)) * g1[2]; c[3] = (bf_hi(h8.w) + bf_hi(l8.w)) * g1[3];
        *(LAS f32x4*)(X + b * 1024 + d0) = a; *(LAS f32x4*)(X + b * 1024 + d0 + 4) = c;
    }
    __syncthreads();
    float acc[4] = {0.f, 0.f, 0.f, 0.f};
#pragma unroll
    for (int b = 0; b < 4; ++b)
#pragma unroll
        for (int q4 = 0; q4 < 4; ++q4) {
            const f32x4 xv = *(const LAS f32x4*)(X + b * 1024 + dg * 16 + 4 * q4);
            acc[b] += xv[0] * w[4 * q4] + xv[1] * w[4 * q4 + 1] + xv[2] * w[4 * q4 + 2] + xv[3] * w[4 * q4 + 3];
        }
    LAS float* R = X + 4096;
#pragma unroll
    for (int b = 0; b < 4; ++b) R[(dg * 8 + col) * 4 + b] = acc[b];
    __syncthreads();
    if (tid < 32) {
        const int c = tid & 7, b = tid >> 3;
        float s = 0.f;
        for (int g = 0; g < 64; ++g) s += R[(g * 8 + c) * 4 + b];
        const float* ssq = (const float*)(P.ws + WS_SSQ) + (size_t)((4 * L + 1) & 1) * T * 16;
        ((float*)(P.ws + WS_QK0))[b * 512 + 8 * j + c] = s * pg8::row_scale(ssq, b * SEQ);
    }
    __syncthreads();
}

__device__ __forceinline__ void layer_small_cvt(const Params& P, int L, int c0) {
    const int nb = ogrid() - c0, bi = obid() - c0;
    if (bi < 0) return;
    const int gt = bi * NTHREADS + otid(), NGT = nb * NTHREADS;
    unsigned char* ws = P.ws;
    const f32x4* p4 = (const f32x4*)P.in[1] + (size_t)L * (T * 256 / 4); u32x2* pb = (u32x2*)(ws + WS_PB) + (size_t)L * (T * 256 / 4);
#pragma unroll 8
    for (int i = gt; i < T * 256 / 4; i += NGT) { const f32x4 v = p4[i]; u32x2 w; w.x = pk2(v[0], v[1]); w.y = pk2(v[2], v[3]); pb[i] = w; }
    if (!(L & 1)) {
        const int e = L >> 1;
        for (int idx = gt; idx < 256 * 1024; idx += NGT) {
            const int n = idx >> 10, k = idx & 1023;
            const float* wi = P.in[16] + (size_t)e * 1024 * 2576 + (size_t)k * 2576 + 1536;
            const float* wf = P.in[18] + e * 16 * 256 + n;
            float s = 0.f;
#pragma unroll
            for (int r = 0; r < 16; ++r) s += wi[r] * wf[r * 256];
            s *= P.in[8][(2 * e) * 1024 + k];
            ((bf16_t*)(ws + WS_WIN))[(size_t)e * 2816 * 1024 + (size_t)(2560 + (n & ~31) + pinv32(n & 31)) * 1024 + k] = (bf16_t)f2bf(s);
        }
    }
}

__device__ __forceinline__ void phase_prepass(const Params& P, LAS unsigned char* lds) {
    const int tid = otid(), lane = tid & 63, wave = tid >> 6;
    const int gw = obid() * 8 + wave, NGW = ogrid() * 8;
    const int gt = obid() * NTHREADS + tid, NGT = ogrid() * NTHREADS;
    unsigned char* ws = P.ws;
    LAS float* scr = (LAS float*)(lds + wave * 16640);
    for (int rp_ = 0; rp_ < (PROBE_DUP == 9 ? 2 : 1); ++rp_)
    for (int it = gw; it < 21248; it += NGW) {
        int job, local; cvt_map(it, job, local);
        const CvtJob J = get_job(P, job);
        cvt_item64(J, local, scr, lane);
    }
    float* ssq = (float*)(ws + WS_SSQ);
    bf16_t* xb = (bf16_t*)(ws + WS_MIX);
    for (int m = gw; m < T; m += NGW) {
        const f32x4* xr = (const f32x4*)(P.in[0] + (size_t)m * D) + lane;
        f32x4 v[4]; float s = 0.f;
#pragma unroll
        for (int j = 0; j < 4; ++j) { v[j] = xr[64 * j]; s += (v[j][0] * v[j][0] + v[j][1] * v[j][1]) + (v[j][2] * v[j][2] + v[j][3] * v[j][3]); }
        s = wave_sum(s);
        u32x2* o8 = (u32x2*)(xb + (size_t)m * D) + lane;
#pragma unroll
        for (int j = 0; j < 4; ++j) { u32x2 w; w.x = pk2(v[j][0], v[j][1]); w.y = pk2(v[j][2], v[j][3]); o8[64 * j] = w; }
        if (lane < 16) ssq[(size_t)m * 16 + lane] = (lane == 0) ? s : 0.f;
    }
}

constexpr int LDT = 68;
constexpr int GO_BT = 0, GO_SEG = 4352, GO_QDT = 4864, GO_KDNT = 9216, GO_ATT = 13568, GO_V = 17920, GO_S = 26112;

template <bool WITH_Q>
__device__ __forceinline__ void gla_prolog(LAS float* L, const u32x4 k8, const u32x4 f8, const u32x4 q8, const f32x4 bf0, const f32x4 bf1, float (&kv)[8], float (&qv)[8]) {
    const int tid = otid(), lane = tid & 63, wave = tid >> 6;
    kv[0] = bf_lo(k8.x); kv[1] = bf_hi(k8.x); kv[2] = bf_lo(k8.y); kv[3] = bf_hi(k8.y); kv[4] = bf_lo(k8.z); kv[5] = bf_hi(k8.z); kv[6] = bf_lo(k8.w); kv[7] = bf_hi(k8.w);
    if (WITH_Q) {
        qv[0] = bf_lo(q8.x); qv[1] = bf_hi(q8.x); qv[2] = bf_lo(q8.y); qv[3] = bf_hi(q8.y); qv[4] = bf_lo(q8.z); qv[5] = bf_hi(q8.z); qv[6] = bf_lo(q8.w); qv[7] = bf_hi(q8.w);
    }
    float fv[8];
    fv[0] = bf_lo(f8.x); fv[1] = bf_hi(f8.x); fv[2] = bf_lo(f8.y); fv[3] = bf_hi(f8.y); fv[4] = bf_lo(f8.z); fv[5] = bf_hi(f8.z); fv[6] = bf_lo(f8.w); fv[7] = bf_hi(f8.w);
#pragma unroll
    for (int j = 0; j < 8; ++j) L[GO_BT + (8 * wave + j) * LDT + lane] = logsigmoidf_(fv[j] + (j < 4 ? bf0[j & 3] : bf1[j & 3])) * (1.0f / 16.0f);
    __syncthreads();
    float pr[8];
    {
        const f32x4 a = *(const LAS f32x4*)(L + GO_BT + lane * LDT + 8 * wave), b = *(const LAS f32x4*)(L + GO_BT + lane * LDT + 8 * wave + 4);
        pr[0] = a[0]; pr[1] = pr[0] + a[1]; pr[2] = pr[1] + a[2]; pr[3] = pr[2] + a[3]; pr[4] = pr[3] + b[0]; pr[5] = pr[4] + b[1]; pr[6] = pr[5] + b[2]; pr[7] = pr[6] + b[3];
        L[GO_SEG + wave * 64 + lane] = pr[7];
    }
    __syncthreads();
    {
        float off = 0.f;
        for (int s = 0; s < wave; ++s) off += L[GO_SEG + s * 64 + lane];
        f32x4 a, b; a[0] = pr[0] + off; a[1] = pr[1] + off; a[2] = pr[2] + off; a[3] = pr[3] + off; b[0] = pr[4] + off; b[1] = pr[5] + off; b[2] = pr[6] + off; b[3] = pr[7] + off;
        *(LAS f32x4*)(L + GO_BT + lane * LDT + 8 * wave) = a; *(LAS f32x4*)(L + GO_BT + lane * LDT + 8 * wave + 4) = b;
    }
    __syncthreads();
}

constexpr int MLD = 72;
constexpr int GB_QDB = 19456, GB_KDB = 28672, GB_VT = 37888, GB_STB = 56320, GB_RED = 74752;

__device__ __forceinline__ void stage_vT(LAS unsigned char* lds, int tid, const u32x4 (&vv)[2]) {
    LAS bf16_t* VT = (LAS bf16_t*)(lds + GB_VT);
#pragma unroll
    for (int r = 0; r < 2; ++r) {
        const int c = r * 512 + tid, j = c & 63, vc = c >> 6;
        const u32x4 v = vv[r];
        LAS bf16_t* d = VT + (32 * (vc >> 2) + 4 * (vc & 3)) * MLD + j;
        d[0 * MLD] = (bf16_t)(v.x & 0xffffu); d[1 * MLD] = (bf16_t)(v.x >> 16); d[2 * MLD] = (bf16_t)(v.y & 0xffffu); d[3 * MLD] = (bf16_t)(v.y >> 16);
        d[16 * MLD] = (bf16_t)(v.z & 0xffffu); d[17 * MLD] = (bf16_t)(v.z >> 16); d[18 * MLD] = (bf16_t)(v.w & 0xffffu); d[19 * MLD] = (bf16_t)(v.w >> 16);
    }
}

#define GLA_LOAD(ITEM, WITHQ) do { const int h_ = (ITEM) & 3, bn_ = (ITEM) >> 2, t0_ = (bn_ >> 6) * SEQ + (bn_ & 63) * 64; \
        const bf16_t* z_ = (const bf16_t*)(P.ws + WS_HZ) + (size_t)(t0_ + lane) * ZW; \
        k8 = *(const u32x4*)(z_ + 256 + h_ * 64 + 8 * wave); f8 = *(const u32x4*)(z_ + 2560 + h_ * 64 + 8 * wave); \
        if (WITHQ) q8 = *(const u32x4*)(z_ + h_ * 64 + 8 * wave); \
        _Pragma("unroll") for (int r_ = 0; r_ < 2; ++r_) { const int c_ = r_ * 512 + tid; \
            vv[r_] = *(const u32x4*)((const bf16_t*)(P.ws + WS_HZ) + (size_t)(t0_ + (c_ & 63)) * ZW + 512 + h_ * 128 + (c_ >> 6) * 8); } \
        const float* bfp_ = P.in[19] + e * 256 + h_ * 64 + 8 * wave; bf0 = *(const f32x4*)bfp_; bf1 = *(const f32x4*)(bfp_ + 4); } while (0)

__device__ __forceinline__ void phase_g1(const Params& P, LAS unsigned char* lds, int e) {
    LAS float* L = (LAS float*)lds;
    const int tid = otid(), lane = tid & 63, wave = tid >> 6, l15 = lane & 15, quad = lane >> 4;
    float* Sbuf = (float*)(P.ws + WS_S); float* decay = (float*)(P.ws + WS_DECAY);
    LAS bf16_t* KDB = (LAS bf16_t*)(lds + GB_KDB); LAS bf16_t* VT = (LAS bf16_t*)(lds + GB_VT);
    u32x4 k8, f8, q8 = (u32x4){0u, 0u, 0u, 0u}, vv[2]; f32x4 bf0, bf1;
    const int gstep = ogrid(), item0 = obid();
    if (item0 < 1024) GLA_LOAD(item0, false);
    for (int item = item0; item < 1024; item += gstep) {
        float kv[8], qv[8];
        gla_prolog<false>(L, k8, f8, q8, bf0, bf1, kv, qv);
#pragma unroll
        for (int j = 0; j < 8; ++j) {
            const float bv = L[GO_BT + (8 * wave + j) * LDT + lane], bl = L[GO_BT + (8 * wave + j) * LDT + 63];
            KDB[(8 * wave + j) * MLD + lane] = (bf16_t)f2bf(kv[j] * __expf(bl - bv));
        }
        stage_vT(lds, tid, vv);
        if (item + gstep < 1024) GLA_LOAD(item + gstep, false);
        if (tid < 64) decay[item * 64 + tid] = __expf(L[GO_BT + tid * LDT + 63]);
        __syncthreads();
        const int dk0 = 16 * (wave & 3);
        const bf16x8 bk0 = *(const LAS bf16x8*)(KDB + (dk0 + l15) * MLD + 8 * quad), bk1 = *(const LAS bf16x8*)(KDB + (dk0 + l15) * MLD + 32 + 8 * quad);
#pragma unroll
        for (int t = 0; t < 4; ++t) {
            const int dv0 = 16 * ((wave >> 2) * 4 + t);
            const bf16x8 a0 = *(const LAS bf16x8*)(VT + (dv0 + l15) * MLD + 8 * quad), a1 = *(const LAS bf16x8*)(VT + (dv0 + l15) * MLD + 32 + 8 * quad);
            f32x4 acc = (f32x4){0.f, 0.f, 0.f, 0.f};
            acc = __builtin_amdgcn_mfma_f32_16x16x32_bf16(a0, bk0, acc, 0, 0, 0);
            acc = __builtin_amdgcn_mfma_f32_16x16x32_bf16(a1, bk1, acc, 0, 0, 0);
            const int tp = (wave >> 2) * 4 + t;
            float* o = Sbuf + (size_t)item * 8192 + (32 * (tp >> 1) + 8 * quad + 4 * (tp & 1)) * 64 + dk0 + l15;
            o[0] = acc[0]; o[64] = acc[1]; o[128] = acc[2]; o[192] = acc[3];
        }
        __syncthreads();
    }
}

__device__ __forceinline__ void phase_g2(const Params& P) {
    float* Sbuf = (float*)(P.ws + WS_S); const float* decay = (const float*)(P.ws + WS_DECAY);
    for (int idx = obid() * NTHREADS + otid(); idx < 16 * 8192; idx += ogrid() * NTHREADS) {
        const int bh = idx >> 13, el = idx & 8191, b = bh >> 2, h = bh & 3, dk = el & 63;
        float run = 0.f;
        for (int n0 = 0; n0 < 64; n0 += 32) {
            float kvn[32], dc[32];
#pragma unroll
            for (int j = 0; j < 32; ++j) { const int item = ((b * 64 + n0 + j) << 2) + h; kvn[j] = Sbuf[(size_t)item * 8192 + el]; dc[j] = decay[item * 64 + dk]; }
#pragma unroll
            for (int j = 0; j < 32; ++j) { const int item = ((b * 64 + n0 + j) << 2) + h; Sbuf[(size_t)item * 8192 + el] = run; run = dc[j] * run + kvn[j]; }
        }
    }
}

__device__ __forceinline__ void phase_g3(const Params& P, LAS unsigned char* lds, int e) {
    LAS float* L = (LAS float*)lds;
    const int tid = otid(), lane = tid & 63, wave = tid >> 6, l15 = lane & 15, quad = lane >> 4;
    const float* Sbuf = (const float*)(P.ws + WS_S);
    const bf16_t* zb = (const bf16_t*)(P.ws + WS_HZ);
    bf16_t* mix = (bf16_t*)(P.ws + WS_MIX);
    LAS bf16_t* QDB = (LAS bf16_t*)(lds + GB_QDB); LAS bf16_t* KDB = (LAS bf16_t*)(lds + GB_KDB); LAS bf16_t* VT = (LAS bf16_t*)(lds + GB_VT); LAS bf16_t* STB = (LAS bf16_t*)(lds + GB_STB);
    LAS float* RED = (LAS float*)(lds + GB_RED);
    u32x4 k8, f8, q8, vv[2]; f32x4 bf0, bf1, sv[4];
    const int gstep = ogrid(), item0 = obid();
#define G3_LOADS(ITEM) do { _Pragma("unroll") for (int r_ = 0; r_ < 4; ++r_) sv[r_] = *(const f32x4*)(Sbuf + (size_t)(ITEM) * 8192 + 4 * (r_ * 512 + tid)); } while (0)
    if (item0 < 1024) { GLA_LOAD(item0, true); G3_LOADS(item0); }
    for (int item = item0; item < 1024; item += gstep) {
        const int h = item & 3, bn = item >> 2, b = bn >> 6, n = bn & 63;
        const int t0 = b * SEQ + n * 64;
        float kv[8], qv[8];
        gla_prolog<true>(L, k8, f8, q8, bf0, bf1, kv, qv);
        {
            float qd[8], kd[8];
#pragma unroll
            for (int j = 0; j < 8; ++j) {
                const float bv = L[GO_BT + (8 * wave + j) * LDT + lane];
                qd[j] = qv[j] * 0.125f * __expf(bv); kd[j] = kv[j] * __expf(-bv);
            }
            u32x4 wq, wk;
            wq.x = pk2(qd[0], qd[1]); wq.y = pk2(qd[2], qd[3]); wq.z = pk2(qd[4], qd[5]); wq.w = pk2(qd[6], qd[7]);
            wk.x = pk2(kd[0], kd[1]); wk.y = pk2(kd[2], kd[3]); wk.z = pk2(kd[4], kd[5]); wk.w = pk2(kd[6], kd[7]);
            *(LAS u32x4*)(QDB + lane * MLD + 8 * wave) = wq; *(LAS u32x4*)(KDB + lane * MLD + 8 * wave) = wk;
        }
        stage_vT(lds, tid, vv);
#pragma unroll
        for (int r = 0; r < 4; ++r) {
            const int c = r * 512 + tid, v = c >> 4, k4 = (c & 15) * 4;
            u32x2 w; w.x = pk2(sv[r][0], sv[r][1]); w.y = pk2(sv[r][2], sv[r][3]);
            *(LAS u32x2*)(STB + ((v & ~31) + pinv32(v & 31)) * MLD + k4) = w;
        }
        if (item + gstep < 1024) { GLA_LOAD(item + gstep, true); G3_LOADS(item + gstep); }
        __syncthreads();
        const int it = wave & 3, i0 = 16 * it, vh = wave >> 2;
        const bf16x8 bq0 = *(const LAS bf16x8*)(QDB + (i0 + l15) * MLD + 8 * quad), bq1 = *(const LAS bf16x8*)(QDB + (i0 + l15) * MLD + 32 + 8 * quad);
        f32x4 s[4];
#pragma unroll
        for (int jt = 0; jt < 4; ++jt) {
            const bf16x8 a0 = *(const LAS bf16x8*)(KDB + (16 * jt + l15) * MLD + 8 * quad), a1 = *(const LAS bf16x8*)(KDB + (16 * jt + l15) * MLD + 32 + 8 * quad);
            f32x4 z = (f32x4){0.f, 0.f, 0.f, 0.f};
            z = __builtin_amdgcn_mfma_f32_16x16x32_bf16(a0, bq0, z, 0, 0, 0);
            z = __builtin_amdgcn_mfma_f32_16x16x32_bf16(a1, bq1, z, 0, 0, 0);
#pragma unroll
            for (int r = 0; r < 4; ++r) z[r] = (16 * jt + 4 * quad + r <= i0 + l15) ? z[r] : 0.f;
            s[jt] = z;
            if (jt == 0 && n == 0 && it == 0) {
                const float* qk = (const float*)(P.ws + WS_QK0) + b * 512 + h * 64 + lane;
                const float c0v = wave_sum(qk[0] * qk[256]) * 0.125f;
                if (lane == 0) s[0][0] = c0v;
            }
        }
        bf16x8 pf[2];
#pragma unroll
        for (int jp = 0; jp < 2; ++jp) {
            u32x4 pw; pw.x = pk2(s[2 * jp][0], s[2 * jp][1]); pw.y = pk2(s[2 * jp][2], s[2 * jp][3]); pw.z = pk2(s[2 * jp + 1][0], s[2 * jp + 1][1]); pw.w = pk2(s[2 * jp + 1][2], s[2 * jp + 1][3]);
            pf[jp] = __builtin_bit_cast(bf16x8, pw);
        }
        f32x4 o[4]; float ss = 0.f;
#pragma unroll
        for (int t = 0; t < 4; ++t) {
            const int v0 = 16 * (vh * 4 + t);
            f32x4 acc = (f32x4){0.f, 0.f, 0.f, 0.f};
#pragma unroll
            for (int jp = 0; jp < 2; ++jp) {
                const LAS bf16_t* vp = VT + (v0 + l15) * MLD + 32 * jp + 4 * quad;
                const u32x2 va = *(const LAS u32x2*)vp, vb = *(const LAS u32x2*)(vp + 16);
                u32x4 vw; vw.x = va.x; vw.y = va.y; vw.z = vb.x; vw.w = vb.y;
                acc = __builtin_amdgcn_mfma_f32_16x16x32_bf16(__builtin_bit_cast(bf16x8, vw), pf[jp], acc, 0, 0, 0);
            }
            const bf16x8 s0 = *(const LAS bf16x8*)(STB + (v0 + l15) * MLD + 8 * quad), s1 = *(const LAS bf16x8*)(STB + (v0 + l15) * MLD + 32 + 8 * quad);
            acc = __builtin_amdgcn_mfma_f32_16x16x32_bf16(s0, bq0, acc, 0, 0, 0);
            acc = __builtin_amdgcn_mfma_f32_16x16x32_bf16(s1, bq1, acc, 0, 0, 0);
            o[t] = acc;
            ss += (acc[0] * acc[0] + acc[1] * acc[1]) + (acc[2] * acc[2] + acc[3] * acc[3]);
        }
        ss += __shfl_xor(ss, 16); ss += __shfl_xor(ss, 32);
        if (quad == 0) RED[vh * 64 + i0 + l15] = ss;
        __syncthreads();
        const float rs = rsqrtf((RED[i0 + l15] + RED[64 + i0 + l15]) * (1.0f / 128.0f) + EPS);
        const size_t tok = (size_t)(t0 + i0 + l15);
#pragma unroll
        for (int a = 0; a < 2; ++a) {
            const int v = 32 * (vh * 2 + a) + 8 * quad;
            const f32x4 ng0 = *(const f32x4*)(P.in[20] + e * 512 + h * 128 + v), ng1 = *(const f32x4*)(P.in[20] + e * 512 + h * 128 + v + 4);
            const u32x4 r4 = *(const u32x4*)(zb + tok * ZW + 1024 + h * 128 + v);
            u32x4 w;
            w.x = pk2(o[2 * a][0] * rs * ng0[0] * siluf_(bf_lo(r4.x)), o[2 * a][1] * rs * ng0[1] * siluf_(bf_hi(r4.x)));
            w.y = pk2(o[2 * a][2] * rs * ng0[2] * siluf_(bf_lo(r4.y)), o[2 * a][3] * rs * ng0[3] * siluf_(bf_hi(r4.y)));
            w.z = pk2(o[2 * a + 1][0] * rs * ng1[0] * siluf_(bf_lo(r4.z)), o[2 * a + 1][1] * rs * ng1[1] * siluf_(bf_hi(r4.z)));
            w.w = pk2(o[2 * a + 1][2] * rs * ng1[2] * siluf_(bf_lo(r4.w)), o[2 * a + 1][3] * rs * ng1[3] * siluf_(bf_hi(r4.w)));
            *(u32x4*)(mix + tok * D + h * 128 + v) = w;
        }
        __syncthreads();
    }
#undef G3_LOADS
}
#undef GLA_LOAD

constexpr int LO_XR = 0, LO_XCT = 4288;
constexpr int LB_XCB = 34560, LB_WAT = 43776, LB_WXT = 52992;
constexpr int LO_RT = 15552, LO_IT = 19904, LO_SEGA = 24256, LO_SEGH = 24768;

__device__ __forceinline__ void phase_l1(const Params& P, LAS unsigned char* lds, int e) {
    LAS float* L = (LAS float*)lds;
    const int tid = otid(), lane = tid & 63, wave = tid >> 6, l15 = lane & 15, quad = lane >> 4;
    const bf16_t* zb = (const bf16_t*)(P.ws + WS_HZ);
    float* HL = (float*)(P.ws + WS_HL); float* AC = (float*)(P.ws + WS_AC);
    LAS bf16_t* XCB = (LAS bf16_t*)(lds + LB_XCB); LAS bf16_t* WAT = (LAS bf16_t*)(lds + LB_WAT); LAS bf16_t* WXT = (LAS bf16_t*)(lds + LB_WXT);
    const int gstep = ogrid(), item0 = obid();
    const bool wconst = (gstep & 7) == 0;
    u32x4 xq0 = (u32x4){0u, 0u, 0u, 0u}, xq1 = (u32x4){0u, 0u, 0u, 0u};
#define L1_LOADXR(ITEM) do { const int g_ = (ITEM) & 7, bc_ = (ITEM) >> 3, c_ = bc_ & 63, t0_ = (bc_ >> 6) * SEQ + c_ * 64; \
        { const int row = tid >> 3, c8 = (tid & 7) * 8; xq0 = (u32x4){0u, 0u, 0u, 0u}; if (c_ > 0 || row >= 3) xq0 = *(const u32x4*)(zb + (size_t)(t0_ + row - 3) * ZW + 1536 + g_ * 64 + c8); } \
        if (tid < 24) { const int row = 64 + (tid >> 3), c8 = (tid & 7) * 8; xq1 = *(const u32x4*)(zb + (size_t)(t0_ + row - 3) * ZW + 1536 + g_ * 64 + c8); } } while (0)
    if (item0 < 2048) L1_LOADXR(item0);
    for (int item = item0; item < 2048; item += gstep) {
        const int g = item & 7, bc = item >> 3, b = bc >> 6, c = bc & 63;
        const int t0 = b * SEQ + c * 64, ch0 = g * 64;
        {
            const int row = tid >> 3, c8 = (tid & 7) * 8;
            f32x4 a, bq; a[0] = bf_lo(xq0.x); a[1] = bf_hi(xq0.x); a[2] = bf_lo(xq0.y); a[3] = bf_hi(xq0.y); bq[0] = bf_lo(xq0.z); bq[1] = bf_hi(xq0.z); bq[2] = bf_lo(xq0.w); bq[3] = bf_hi(xq0.w);
            *(LAS f32x4*)(L + LO_XR + row * 64 + c8) = a; *(LAS f32x4*)(L + LO_XR + row * 64 + c8 + 4) = bq;
            if (tid < 24) {
                const int row1 = 64 + (tid >> 3);
                a[0] = bf_lo(xq1.x); a[1] = bf_hi(xq1.x); a[2] = bf_lo(xq1.y); a[3] = bf_hi(xq1.y); bq[0] = bf_lo(xq1.z); bq[1] = bf_hi(xq1.z); bq[2] = bf_lo(xq1.w); bq[3] = bf_hi(xq1.w);
                *(LAS f32x4*)(L + LO_XR + row1 * 64 + c8) = a; *(LAS f32x4*)(L + LO_XR + row1 * 64 + c8 + 4) = bq;
            }
        }
        if (item + gstep < 2048) L1_LOADXR(item + gstep);
        if (!wconst || item == item0) {
            const f32x4* wa = (const f32x4*)(P.in[23] + (size_t)(e * 8 + g) * 4096); const f32x4* wx = (const f32x4*)(P.in[25] + (size_t)(e * 8 + g) * 4096);
#pragma unroll
            for (int r = 0; r < 2; ++r) {
                const int i4 = tid + 512 * r, i = i4 >> 4, j4 = (i4 & 15) * 4;
                const f32x4 va = wa[i4], vx = wx[i4];
#pragma unroll
                for (int q = 0; q < 4; ++q) { WAT[(j4 + q) * MLD + i] = (bf16_t)f2bf(va[q]); WXT[(j4 + q) * MLD + i] = (bf16_t)f2bf(vx[q]); }
            }
        }
        __syncthreads();
        {
            const float* cw = P.in[21] + e * 4 * 512 + ch0 + lane;
            const float w0 = cw[0], w1 = cw[512], w2 = cw[1024], w3 = cw[1536], cb = P.in[22][e * 512 + ch0 + lane];
            f32x4 a, bq;
#pragma unroll
            for (int j = 0; j < 8; ++j) {
                const int t = 8 * wave + j;
                const float v = L[LO_XR + (t + 0) * 64 + lane] * w0 + L[LO_XR + (t + 1) * 64 + lane] * w1 + L[LO_XR + (t + 2) * 64 + lane] * w2 + L[LO_XR + (t + 3) * 64 + lane] * w3 + cb;
                if (j < 4) a[j] = v; else bq[j - 4] = v;
                XCB[t * MLD + lane] = (bf16_t)f2bf(v);
            }
            *(LAS f32x4*)(L + LO_XCT + lane * LDT + 8 * wave) = a; *(LAS f32x4*)(L + LO_XCT + lane * LDT + 8 * wave + 4) = bq;
        }
        __syncthreads();
        {
            const int gate = wave >> 2, tt0 = 16 * (wave & 3);
            const LAS bf16_t* WT = gate ? WXT : WAT;
            const bf16x8 a0 = *(const LAS bf16x8*)(XCB + (tt0 + l15) * MLD + 8 * quad), a1 = *(const LAS bf16x8*)(XCB + (tt0 + l15) * MLD + 32 + 8 * quad);
            LAS float* O = L + (gate ? LO_IT : LO_RT);
            const float* bp = (gate ? P.in[26] : P.in[24]) + e * 512 + ch0;
#pragma unroll
            for (int jt = 0; jt < 4; ++jt) {
                const bf16x8 b0 = *(const LAS bf16x8*)(WT + (16 * jt + l15) * MLD + 8 * quad), b1 = *(const LAS bf16x8*)(WT + (16 * jt + l15) * MLD + 32 + 8 * quad);
                f32x4 acc = (f32x4){0.f, 0.f, 0.f, 0.f};
                acc = __builtin_amdgcn_mfma_f32_16x16x32_bf16(a0, b0, acc, 0, 0, 0);
                acc = __builtin_amdgcn_mfma_f32_16x16x32_bf16(a1, b1, acc, 0, 0, 0);
                const float bias = bp[16 * jt + l15];
                f32x4 w;
#pragma unroll
                for (int r = 0; r < 4; ++r) w[r] = sigmoidf_(acc[r] + bias);
                *(LAS f32x4*)(O + (16 * jt + l15) * LDT + tt0 + 4 * quad) = w;
            }
        }
        __syncthreads();
        {
            const float sp = softplusf_(-P.in[27][e * 512 + ch0 + lane]);
            const f32x4 r0 = *(const LAS f32x4*)(L + LO_RT + lane * LDT + 8 * wave), r1 = *(const LAS f32x4*)(L + LO_RT + lane * LDT + 8 * wave + 4);
            const f32x4 i0 = *(const LAS f32x4*)(L + LO_IT + lane * LDT + 8 * wave), i1 = *(const LAS f32x4*)(L + LO_IT + lane * LDT + 8 * wave + 4);
            const f32x4 x0 = *(const LAS f32x4*)(L + LO_XCT + lane * LDT + 8 * wave), x1 = *(const LAS f32x4*)(L + LO_XCT + lane * LDT + 8 * wave + 4);
            float Hl[8], Al[8]; float Hr = 0.f, Ar = 1.f;
#pragma unroll
            for (int j = 0; j < 8; ++j) {
                const float rr = j < 4 ? r0[j & 3] : r1[j & 3], ii = j < 4 ? i0[j & 3] : i1[j & 3], xx = j < 4 ? x0[j & 3] : x1[j & 3];
                const float la = -8.0f * rr * sp; const float a = __expf(la);
                const float u = __builtin_amdgcn_sqrtf(fmaxf(__builtin_fmaf(-a, a, 1.0f), 0.f)) * (ii * xx);
                Hr = a * Hr + u; Ar *= a; Hl[j] = Hr; Al[j] = Ar;
            }
            L[LO_SEGA + wave * 64 + lane] = Ar; L[LO_SEGH + wave * 64 + lane] = Hr;
            __syncthreads();
            float Hin = 0.f, Ain = 1.f;
            for (int s = 0; s < wave; ++s) { const float sa = L[LO_SEGA + s * 64 + lane], sh = L[LO_SEGH + s * 64 + lane]; Hin = sa * Hin + sh; Ain *= sa; }
#pragma unroll
            for (int j = 0; j < 8; ++j) {
                const size_t o = (size_t)(t0 + 8 * wave + j) * 512 + ch0 + lane;
                HL[o] = Hl[j] + Al[j] * Hin; AC[o] = Al[j] * Ain;
            }
        }
        __syncthreads();
    }
#undef L1_LOADXR
}

__device__ __forceinline__ void phase_l2(const Params& P) {
    const float* HL = (const float*)(P.ws + WS_HL); const float* AC = (const float*)(P.ws + WS_AC); float* carry = (float*)(P.ws + WS_CARRY);
    const int tid = otid(), lane = tid & 63, wave = tid >> 6;
    for (int seq = obid() * 8 + wave, sstep = ogrid() * 8; seq < 4 * 512; seq += sstep) {
        const int b = seq >> 9, ch = seq & 511;
        const size_t o = (size_t)(b * SEQ + lane * 64 + 63) * 512 + ch;
        float a = AC[o], h = HL[o];
#pragma unroll
        for (int d = 1; d < 64; d <<= 1) {
            const float ap = __shfl_up(a, d), hp = __shfl_up(h, d);
            if (lane >= d) { h = a * hp + h; a = ap * a; }
        }
        const float hin = __shfl_up(h, 1);
        carry[(b * 64 + lane) * 512 + ch] = lane == 0 ? 0.f : hin;
    }
}

__device__ __forceinline__ void phase_l3(const Params& P) {
    const float* HL = (const float*)(P.ws + WS_HL); const float* AC = (const float*)(P.ws + WS_AC); const float* carry = (const float*)(P.ws + WS_CARRY);
    const bf16_t* zb = (const bf16_t*)(P.ws + WS_HZ); bf16_t* mix = (bf16_t*)(P.ws + WS_MIX);
#pragma unroll 4
    for (int idx = obid() * NTHREADS + otid(); idx < T * 128; idx += ogrid() * NTHREADS) {
        const int tok = idx >> 7, ch = (idx & 127) * 4;
        const int b = tok >> 12, c = (tok & 4095) >> 6;
        const f32x4 hl = *(const f32x4*)(HL + (size_t)tok * 512 + ch), ac = *(const f32x4*)(AC + (size_t)tok * 512 + ch), cr = *(const f32x4*)(carry + (b * 64 + c) * 512 + ch);
        const u32x2 g2 = *(const u32x2*)(zb + (size_t)tok * ZW + 2048 + ch);
        const f32x4 hh = hl + ac * cr;
        u32x2 w; w.x = pk2(hh[0] * gelu_tanh(bf_lo(g2.x)), hh[1] * gelu_tanh(bf_hi(g2.x))); w.y = pk2(hh[2] * gelu_tanh(bf_lo(g2.y)), hh[3] * gelu_tanh(bf_hi(g2.y)));
        *(u32x2*)(mix + (size_t)tok * D + 512 + ch) = w;
    }
}

constexpr int AK_LD = 72, AV_LD = 264;
constexpr int AO_K = 0, AO_VT = 256 * AK_LD * 2, AO_BIAS = AO_VT + 64 * AV_LD * 2;

__device__ __forceinline__ void phase_attn(const Params& P, LAS unsigned char* lds, int o) {
    const int tid = otid(), lane = tid & 63, wave = tid >> 6, l15 = lane & 15, quad = lane >> 4;
    const bf16_t* qkv = (const bf16_t*)(P.ws + WS_HZ);
    bf16_t* mix = (bf16_t*)(P.ws + WS_MIX);
    LAS bf16_t* KS = (LAS bf16_t*)(lds + AO_K); LAS bf16_t* VT = (LAS bf16_t*)(lds + AO_VT); LAS float* BIAS = (LAS float*)(lds + AO_BIAS);
    const int gstep = ogrid(), item0 = obid();
    const bool hkconst = (gstep & 3) == 0;
    for (int item = item0; item < 512; item += gstep) {
        const int hk = item & 3, n = (item >> 2) & 31, b = item >> 7;
        const int tok0 = b * SEQ + n * 128 - 128;
#pragma unroll
        for (int r = 0; r < 4; ++r) {
            const int c = r * 512 + tid, key = c >> 3, dc = c & 7;
            u32x4 v = (u32x4){0u, 0u, 0u, 0u};
            if (n > 0 || key >= 128) v = *(const u32x4*)(qkv + (size_t)(tok0 + key) * QKVW + 1024 + hk * 64 + dc * 8);
            *(LAS u32x4*)(KS + key * AK_LD + dc * 8) = v;
        }
#pragma unroll
        for (int r = 0; r < 4; ++r) {
            const int c = r * 512 + tid, key = c & 255, dvc = c >> 8;
            u32x4 v = (u32x4){0u, 0u, 0u, 0u};
            if (n > 0 || key >= 128) v = *(const u32x4*)(qkv + (size_t)(tok0 + key) * QKVW + 1280 + hk * 64 + dvc * 8);
            LAS bf16_t* d = VT + (32 * (dvc >> 2) + 4 * (dvc & 3)) * AV_LD + key;
            d[0 * AV_LD] = (bf16_t)(v.x & 0xffffu); d[1 * AV_LD] = (bf16_t)(v.x >> 16); d[2 * AV_LD] = (bf16_t)(v.y & 0xffffu); d[3 * AV_LD] = (bf16_t)(v.y >> 16);
            d[16 * AV_LD] = (bf16_t)(v.z & 0xffffu); d[17 * AV_LD] = (bf16_t)(v.z >> 16); d[18 * AV_LD] = (bf16_t)(v.w & 0xffffu); d[19 * AV_LD] = (bf16_t)(v.w >> 16);
        }
        if (!hkconst || item == item0) {
            for (int idx = tid; idx < 4 * 192; idx += NTHREADS) {
                const int g = idx / 192, j = idx - g * 192, dist = (191 - j) - 32;
                float val = -1e30f;
                if (dist >= 0 && dist < 128) {
                    int bucket = dist;
                    if (dist >= 16) { int lg = 16 + (int)(__logf((float)dist * 0.0625f) / 2.0794415416798357f * 16.0f); bucket = lg < 31 ? lg : 31; }
                    val = P.in[2][bucket * 16 + hk * 4 + g] * 1.4426950408889634f;
                }
                BIAS[idx] = val;
            }
        }
        __syncthreads();
        const int g = wave >> 1, half = wave & 1, head = hk * 4 + g;
        const float sink2 = P.in[32][o * 16 + head] * 1.4426950408889634f;
        bf16x8 qn0, qn1;
        {
            const size_t qt = (size_t)(b * SEQ + n * 128 + 64 * half + l15);
            qn0 = *(const bf16x8*)(qkv + qt * QKVW + head * 64 + 8 * quad); qn1 = *(const bf16x8*)(qkv + qt * QKVW + head * 64 + 32 + 8 * quad);
        }
#pragma nounroll
        for (int rt = 0; rt < 4; ++rt) {
            const int q0 = 64 * half + 16 * rt, qi = q0 + l15;
            const size_t qtok = (size_t)(b * SEQ + n * 128 + qi);
            bf16x8 qf[2]; qf[0] = qn0; qf[1] = qn1;
            if (rt < 3) {
                const size_t qt = qtok + 16;
                qn0 = *(const bf16x8*)(qkv + qt * QKVW + head * 64 + 8 * quad); qn1 = *(const bf16x8*)(qkv + qt * QKVW + head * 64 + 32 + 8 * quad);
            }
            const int grp0 = q0 >> 5, tile0 = 2 * grp0;
            f32x4 s[10];
#pragma unroll
            for (int tt = 0; tt < 10; ++tt) {
                const int key = 16 * (tile0 + tt) + l15;
                const bf16x8 k0 = *(const LAS bf16x8*)(KS + key * AK_LD + 8 * quad), k1 = *(const LAS bf16x8*)(KS + key * AK_LD + 32 + 8 * quad);
                f32x4 z = (f32x4){0.f, 0.f, 0.f, 0.f};
                z = __builtin_amdgcn_mfma_f32_16x16x32_bf16(k0, qf[0], z, 0, 0, 0);
                z = __builtin_amdgcn_mfma_f32_16x16x32_bf16(k1, qf[1], z, 0, 0, 0);
                s[tt] = z;
            }
            float mx = sink2;
            {
                const LAS float* tb = BIAS + g * 192 + (31 - (q0 & 31) - l15 + 4 * quad);
#pragma unroll
                for (int tt = 0; tt < 10; ++tt)
#pragma unroll
                    for (int r = 0; r < 4; ++r) {
                        const float sc = __builtin_fmaf(s[tt][r], 0.125f * 1.4426950408889634f, tb[16 * tt + r]);
                        s[tt][r] = sc;
                    }
                if (n == 0) {
#pragma unroll
                    for (int tt = 0; tt < 10; ++tt)
#pragma unroll
                        for (int r = 0; r < 4; ++r) { const int kj = 16 * (tile0 + tt) + 4 * quad + r; if (kj < 128) s[tt][r] = -1e30f; }
                }
#pragma unroll
                for (int tt = 0; tt < 10; ++tt)
#pragma unroll
                    for (int r = 0; r < 4; ++r) mx = fmaxf(mx, s[tt][r]);
            }
            mx = fmaxf(mx, __shfl_xor(mx, 16)); mx = fmaxf(mx, __shfl_xor(mx, 32));
            float l = 0.f;
#pragma unroll
            for (int tt = 0; tt < 10; ++tt)
#pragma unroll
                for (int r = 0; r < 4; ++r) { const float p = __builtin_amdgcn_exp2f(s[tt][r] - mx); s[tt][r] = p; l += p; }
            l += __shfl_xor(l, 16); l += __shfl_xor(l, 32);
            l += __builtin_amdgcn_exp2f(sink2 - mx);
            f32x4 oacc[4];
#pragma unroll
            for (int t = 0; t < 4; ++t) oacc[t] = (f32x4){0.f, 0.f, 0.f, 0.f};
#pragma unroll
            for (int jp = 0; jp < 5; ++jp) {
                u32x4 pw; pw.x = pk2(s[2 * jp][0], s[2 * jp][1]); pw.y = pk2(s[2 * jp][2], s[2 * jp][3]); pw.z = pk2(s[2 * jp + 1][0], s[2 * jp + 1][1]); pw.w = pk2(s[2 * jp + 1][2], s[2 * jp + 1][3]);
                const bf16x8 pf = __builtin_bit_cast(bf16x8, pw);
                const int keybase = 32 * (grp0 + jp);
#pragma unroll
                for (int t = 0; t < 4; ++t) {
                    const LAS bf16_t* vp = VT + (16 * t + l15) * AV_LD + keybase + 4 * quad;
                    const u32x2 va = *(const LAS u32x2*)vp, vb = *(const LAS u32x2*)(vp + 16);
                    u32x4 vw; vw.x = va.x; vw.y = va.y; vw.z = vb.x; vw.w = vb.y;
                    oacc[t] = __builtin_amdgcn_mfma_f32_16x16x32_bf16(__builtin_bit_cast(bf16x8, vw), pf, oacc[t], 0, 0, 0);
                }
            }
            const float inv = 1.0f / l;
#pragma unroll
            for (int a = 0; a < 2; ++a) {
                u32x4 w; w.x = pk2(oacc[2 * a][0] * inv, oacc[2 * a][1] * inv); w.y = pk2(oacc[2 * a][2] * inv, oacc[2 * a][3] * inv);
                w.z = pk2(oacc[2 * a + 1][0] * inv, oacc[2 * a + 1][1] * inv); w.w = pk2(oacc[2 * a + 1][2] * inv, oacc[2 * a + 1][3] * inv);
                *(u32x4*)(mix + qtok * D + head * 64 + 32 * a + 8 * quad) = w;
            }
        }
        __syncthreads();
    }
}

__device__ __forceinline__ void phase_final(const Params& P) {
    const int tid_ = otid(); const int lane = tid_ & 63, wave = tid_ >> 6;
    const float* ssq = (const float*)(P.ws + WS_SSQ);
    const bf16_t* hi = (const bf16_t*)(P.ws + WS_MIX); const bf16_t* lo = (const bf16_t*)(P.ws + WS_HZ);
    for (int m = obid() * 8 + wave, mstep = ogrid() * 8; m < T; m += mstep) {
        const float s = pg8::row_scale(ssq, m);
        f32x4* xr = (f32x4*)(P.out + (size_t)m * D) + lane; const f32x4* gp = (const f32x4*)P.in[3] + lane;
        const u32x2* hp = (const u32x2*)(hi + (size_t)m * D) + lane; const u32x2* lp = (const u32x2*)(lo + (size_t)m * D) + lane;
#pragma unroll
        for (int j = 0; j < 4; ++j) {
            const u32x2 h2 = hp[64 * j], l2 = lp[64 * j]; const f32x4 g4 = gp[64 * j];
            f32x4 o; o[0] = (bf_lo(h2.x) + bf_lo(l2.x)) * s * g4[0]; o[1] = (bf_hi(h2.x) + bf_hi(l2.x)) * s * g4[1]; o[2] = (bf_lo(h2.y) + bf_lo(l2.y)) * s * g4[2]; o[3] = (bf_hi(h2.y) + bf_hi(l2.y)) * s * g4[3];
            xr[64 * j] = o;
        }
    }
}

#define XB_TMO      128
#define XB_XCNT(j)  (256  + 64 * (j))
#define XB_XSUB(j)  (1280 + 64 * (j))
#define XB_XGEN(j)  (2304 + 64 * (j))
#define XB_TOP      3328
#define XB_TOPGEN   3392
#define XCD_BAR_WORDS 3456
#define XB_SPIN_CAP (1u << 18)
__device__ __forceinline__ unsigned xb_ld(unsigned* p)              { return __hip_atomic_load(p, __ATOMIC_RELAXED, __HIP_MEMORY_SCOPE_AGENT); }
__device__ __forceinline__ unsigned xb_add(unsigned* p, unsigned v) { return __hip_atomic_fetch_add(p, v, __ATOMIC_RELAXED, __HIP_MEMORY_SCOPE_AGENT); }
__device__ __forceinline__ unsigned xb_xcc_id() { return (unsigned)__builtin_amdgcn_s_getreg((3 << 11) | 20) & 0xFu; }
#define XB_SPIN(cond, bar) do { unsigned _sp = 0; while (cond) { __builtin_amdgcn_s_sleep(1); \
    if ((++_sp & 255u) == 0u) { if (xb_ld(&(bar)[XB_TMO])) break; if (_sp > XB_SPIN_CAP) { atomicAdd(&(bar)[XB_TMO], 1u); break; } } } } while (0)
struct XcdBarrier { unsigned* bar; unsigned x; volatile LAS unsigned* st; };
__device__ __forceinline__ XcdBarrier xcd_barrier_post(unsigned* bar, volatile LAS unsigned* st) {
    XcdBarrier b; b.bar = bar; b.x = xb_xcc_id(); b.st = st;
    if (threadIdx.x == 0) (void)xb_add(&bar[XB_XCNT(b.x)], 1u);
    return b;
}
__device__ __forceinline__ void xcd_barrier_complete(unsigned* bar, unsigned x, unsigned& nloc, unsigned& nx) {
    const unsigned G = gridDim.x * gridDim.y * gridDim.z;
    unsigned sum, cnt, mine, sp = 0u;
    for (;;) {
        sum = 0u; cnt = 0u; mine = 0u;
#pragma unroll
        for (unsigned j = 0; j < 16; ++j) { const unsigned c = xb_ld(&bar[XB_XCNT(j)]); sum += c; cnt += (c > 0u) ? 1u : 0u; mine = (j == x) ? c : mine; }
        if (sum == G) break;
        __builtin_amdgcn_s_sleep(1);
        if ((++sp & 255u) == 0u) { if (xb_ld(&bar[XB_TMO])) break; if (sp > XB_SPIN_CAP) { atomicAdd(&bar[XB_TMO], 1u); break; } }
    }
    nloc = mine > 0u ? mine : 1u; nx = cnt > 0u ? cnt : 1u;
}
__device__ __forceinline__ void xcd_barrier(const XcdBarrier& b) {
    asm volatile("s_waitcnt vmcnt(0)" ::: "memory");
    __syncthreads();
    if (threadIdx.x == 0) {
        unsigned* bar = b.bar;
        __builtin_amdgcn_s_waitcnt(0);
        unsigned nloc = b.st[0], nx = b.st[1];
        if (nloc == 0u) { xcd_barrier_complete(bar, b.x, nloc, nx); b.st[0] = nloc; b.st[1] = nx; }
        const unsigned old = xb_add(&bar[XB_XSUB(b.x)], 1u);
        const unsigned gen = old / nloc;
        if (old + 1u == (gen + 1u) * nloc) {
            __builtin_amdgcn_fence(__ATOMIC_RELEASE, "agent");
            asm volatile("s_waitcnt vmcnt(0)" ::: "memory");
            const unsigned og = xb_add(&bar[XB_TOP], 1u);
            const unsigned tg = og / nx;
            if (og + 1u == (tg + 1u) * nx) xb_add(&bar[XB_TOPGEN], 1u);
            else XB_SPIN(xb_ld(&bar[XB_TOPGEN]) == tg, bar);
            __builtin_amdgcn_fence(__ATOMIC_ACQUIRE, "agent");
            xb_add(&bar[XB_XGEN(b.x)], 1u);
            asm volatile("s_waitcnt vmcnt(0)" ::: "memory");
        } else {
            XB_SPIN(xb_ld(&bar[XB_XGEN(b.x)]) == gen, bar);
            __builtin_amdgcn_fence(__ATOMIC_ACQUIRE, "agent");
            asm volatile("s_waitcnt vmcnt(0)" ::: "memory");
        }
    }
    __syncthreads();
}

__global__ void __launch_bounds__(NTHREADS, 2) mk_fwd(Params P_arg) {
    extern __shared__ __attribute__((aligned(16))) unsigned char lds_raw[];
    LAS unsigned char* lds = (LAS unsigned char*)lds_raw;
    cg::grid_group grid = cg::this_grid();
    volatile LAS unsigned* bar_st = (volatile LAS unsigned*)(lds + LDS_BYTES - 64);
    if (threadIdx.x == 0) { bar_st[0] = 0u; bar_st[1] = 0u; }
    __syncthreads();
    const XcdBarrier xbar = xcd_barrier_post((unsigned*)(P_arg.ws + WS_CTL), bar_st);
    for (int ph = P_arg.ph_lo; ph < P_arg.ph_hi; ++ph) {
        bool did = true;
        int nrep = 1;
        {
            const int s_ = (ph >= 1 && ph <= 40) ? (ph - 1) % 10 : -1, L_ = (ph - 1) / 10;
            if (PROBE_DUP == 1 && (s_ == 0)) nrep = 2;
            if (PROBE_DUP == 2 && ph == 0) nrep = 2;
            if (PROBE_DUP == 3 && (s_ == 3 || s_ == 5) && !(L_ & 1)) nrep = 2;
            if (PROBE_DUP == 4 && s_ == 3 && (L_ & 1)) nrep = 2;
            if (PROBE_DUP == 6 && s_ == 2) nrep = 2;
        }
#pragma nounroll
        for (int rep_ = 0; rep_ < nrep; ++rep_) {
        const __attribute__((address_space(4))) Params* Pk = (const __attribute__((address_space(4))) Params*)__builtin_amdgcn_kernarg_segment_ptr();
        asm volatile("" : "+s"(Pk));
        const Params& P = *(const Params*)Pk;
        unsigned char* ws = P.ws;
        float* ssq = (float*)(ws + WS_SSQ);
        bf16_t* XB = (bf16_t*)(ws + WS_XB); bf16_t* XBALT = (bf16_t*)(ws + WS_MIX); bf16_t* HZ = (bf16_t*)(ws + WS_HZ); bf16_t* MIX = (bf16_t*)(ws + WS_MIX);
        bf16_t* PP = (bf16_t*)(ws + WS_PP);
        bf16_t* XLO = (bf16_t*)P.out;
        if (ph == 0) phase_prepass(P, lds);
        else if (ph == 41) phase_final(P);
        else {
            const int L = (ph - 1) / 10, s = (ph - 1) % 10, even = !(L & 1), eo = L >> 1;
            if (s == 3) {
                if (even) { phase_g1(P, lds, eo); phase_l1(P, lds, eo); } else phase_attn(P, lds, eo);
            } else if (s == 4) {
                if (even) { phase_g2(P); phase_l2(P); } else did = false;
            } else if (s == 5) {
                if (even) { phase_g3(P, lds, eo); phase_l3(P); } else did = false;
            } else {
                const int ng = (s == 7) ? 2 : 1;
#pragma nounroll
                for (int gi = 0; gi < ng; ++gi) {
                    pg8::Epi E; E.mode = 0; E.ssq_in = nullptr; E.ssq_out = nullptr; E.xin = nullptr; E.hin = nullptr; E.lin = nullptr; E.lout = nullptr; E.xb = nullptr; E.ob = nullptr; E.ldo = 0; E.of = nullptr; E.bias = nullptr; E.alpha = 1.0f;
                    const bf16_t* A = XB; const bf16_t* Bt = nullptr; int N = 1024, K = 1024;
                    if (gi == 1) {
                        E.mode = 2; E.ob = PP; A = (const bf16_t*)(ws + WS_PB) + (size_t)L * T * 256; Bt = (const bf16_t*)(ws + WS_WPP) + (size_t)L * 1024 * 256; N = 1024; K = 256;
                    } else if (s == 0 || s == 7) {
                        const int w = (s == 7);
                        E.mode = 0; E.ssq_in = ssq + (size_t)((4 * L + (w ? 2 : 0)) & 1) * T * 16; E.ob = HZ; E.ldo = FF;
                        A = w ? XB : XBALT; Bt = (const bf16_t*)(ws + WS_WUP) + (size_t)(2 * L + w) * 5632 * 1024; N = 5632; K = 1024;
                    } else if (s == 1 || s == 8) {
                        const int w = (s == 8);
                        E.mode = (L == 0 && !w) ? 5 : 3; E.xin = P.in[0]; E.hin = w ? XB : XBALT; E.lin = XLO; E.lout = XLO; E.xb = XB; E.ssq_out = ssq + (size_t)((4 * L + (w ? 3 : 1)) & 1) * T * 16; E.alpha = 0.5f;
                        A = HZ; Bt = (const bf16_t*)(ws + WS_WDN) + (size_t)(2 * L + w) * 1024 * 2816; N = 1024; K = 2816;
                    } else if (s == 2) {
                        E.mode = 1; E.ssq_in = ssq + (size_t)((4 * L + 1) & 1) * T * 16; E.ob = HZ; A = XB; K = 1024;
                        if (even) { E.ldo = ZW; Bt = (const bf16_t*)(ws + WS_WIN) + (size_t)eo * 2816 * 1024; N = 2816; }
                        else { E.ldo = QKVW; E.bias = P.in[29] + eo * 1536; Bt = (const bf16_t*)(ws + WS_WQKV) + (size_t)eo * 1536 * 1024; N = 1536; }
                    } else if (s == 6) {
                        E.mode = 3; E.hin = XB; E.lin = XLO; E.lout = XLO; E.xb = XB; E.ssq_out = ssq + (size_t)((4 * L + 2) & 1) * T * 16; E.alpha = 1.0f;
                        E.bias = even ? nullptr : P.in[31] + eo * 1024;
                        A = MIX; Bt = even ? (const bf16_t*)(ws + WS_WOUT) + (size_t)eo * 1024 * 1024 : (const bf16_t*)(ws + WS_WO) + (size_t)eo * 1024 * 1024; N = 1024; K = 1024;
                    } else {
                        E.mode = 4; E.ssq_in = ssq + (size_t)((4 * L + 3) & 1) * T * 16; E.ssq_out = ssq + (size_t)((4 * L + 4) & 1) * T * 16; E.ob = PP; E.hin = XB; E.lin = XLO; E.lout = (L == 3) ? HZ : XLO; E.xb = XBALT;
                        A = XB; Bt = (const bf16_t*)(ws + WS_WPG) + (size_t)L * 1024 * 1024; N = 1024; K = 1024;
                    }
                    if (PROBE_DUP == 7 && s == 1) { pg8::Epi Ed = E; Ed.mode = 2; Ed.ob = PP; run_gemm(lds, A, Bt, N, K, Ed); }
                    if (PROBE_DUP == 8 && s == 6) { pg8::Epi Ed = E; Ed.mode = 2; Ed.ob = PP; run_gemm(lds, A, Bt, N, K, Ed); }
                    run_gemm(lds, A, Bt, N, K, E, (gi == 1 && gridDim.x == 256) ? 128 : 0);
                    if (s == 0) layer_small_cvt(P, L, gridDim.x == 256 ? 128 : 0);
                    if (s == 2 && even) first_token_qk(P, lds, L, gridDim.x == 256 ? 192 : 0);
                }
            }
        }
        }
        if (did && ph + 1 < P_arg.ph_hi) { if (ph == 99) grid.sync(); else xcd_barrier(xbar); if (PROBE_DUP == 5) xcd_barrier(xbar); }
    }
}

extern "C" void kernel_launch(void* const* d_in, const int* in_sizes, int n_in, void* d_out, int out_size, void* d_ws, size_t ws_size, hipStream_t stream) {
    static int grid = 0;
    if (grid == 0) {
        if (n_in != 33 || out_size != T * D || ws_size < WS_END) { fprintf(stderr, "kernel_launch: unexpected shapes (n_in %d out %d ws %zu need %zu)\n", n_in, out_size, ws_size, (size_t)WS_END); grid = -1; return; }
        int dev = 0, cus = 0, per_cu = 0;
        hipGetDevice(&dev); hipDeviceGetAttribute(&cus, hipDeviceAttributeMultiprocessorCount, dev);
        if (hipFuncSetAttribute((const void*)mk_fwd, hipFuncAttributeMaxDynamicSharedMemorySize, LDS_BYTES) != hipSuccess) { fprintf(stderr, "hipFuncSetAttribute failed\n"); grid = -1; return; }
        if (hipOccupancyMaxActiveBlocksPerMultiprocessor(&per_cu, (const void*)mk_fwd, NTHREADS, LDS_BYTES) != hipSuccess || per_cu < 1) per_cu = 1;
        (void)hipGetLastError();
        grid = cus * 1;
    }
    if (grid < 0) return;
    if (hipMemsetAsync((char*)d_ws + WS_CTL, 0, CTL_BYTES, stream) != hipSuccess) { fprintf(stderr, "memset failed\n"); return; }
    Params p{};
    for (int i = 0; i < 33; ++i) p.in[i] = (const float*)d_in[i];
    p.out = (float*)d_out; p.ws = (unsigned char*)d_ws;
#if COOP
    p.ph_lo = 0; p.ph_hi = 42;
    void* args[] = {&p};
    hipError_t e = hipLaunchCooperativeKernel((const void*)mk_fwd, dim3(grid), dim3(NTHREADS), args, LDS_BYTES, stream);
    if (e != hipSuccess) fprintf(stderr, "cooperative launch failed: %s (grid %d)\n", hipGetErrorString(e), grid);
#else
    for (int ph = 0; ph < 42; ++ph) {
        if (ph >= 1 && ph <= 40) { const int L = (ph - 1) / 10, s = (ph - 1) % 10; if ((L & 1) && (s == 4 || s == 5)) continue; }
        p.ph_lo = ph; p.ph_hi = ph + 1;
        hipLaunchKernelGGL(mk_fwd, dim3(grid), dim3(NTHREADS), LDS_BYTES, stream, p);
    }
#endif
}
```

```cpp
#include <hip/hip_runtime.h>
#include <hip/hip_cooperative_groups.h>
#include <cstdio>
namespace cg = cooperative_groups;

#ifndef COOP
#define COOP 1
#endif

#ifndef PROBE_DUP
#define PROBE_DUP 0
#endif
#define LAS __attribute__((address_space(3)))
typedef unsigned short bf16_t;
typedef short bf16x8 __attribute__((ext_vector_type(8)));
typedef float f32x4 __attribute__((ext_vector_type(4)));
typedef float f32x2 __attribute__((ext_vector_type(2)));
typedef unsigned u32x4 __attribute__((ext_vector_type(4)));
typedef unsigned u32x2 __attribute__((ext_vector_type(2)));

constexpr int T = 16384, D = 1024, FF = 2816, SEQ = 4096;
constexpr int ZW = 2816, QKVW = 1536;
constexpr float EPS = 1e-6f;
constexpr int NTHREADS = 512;
constexpr int LDS_BYTES = 147456;

constexpr size_t WS_SSQ = 0;
constexpr size_t WS_WUP = 2097152;
constexpr size_t WS_WDN = WS_WUP + 8ull * 5632 * 1024 * 2;
constexpr size_t WS_WIN = WS_WDN + 8ull * 1024 * 2816 * 2;
constexpr size_t WS_WOUT = WS_WIN + 2ull * 2816 * 1024 * 2;
constexpr size_t WS_WQKV = WS_WOUT + 2ull * 1024 * 1024 * 2;
constexpr size_t WS_WO = WS_WQKV + 2ull * 1536 * 1024 * 2;
constexpr size_t WS_WPG = WS_WO + 2ull * 1024 * 1024 * 2;
constexpr size_t WS_WPP = WS_WPG + 4ull * 1024 * 1024 * 2;
constexpr size_t WS_XB = WS_WPP + 4ull * 1024 * 256 * 2;
constexpr size_t WS_PB = WS_XB + (size_t)T * 1024 * 2;
constexpr size_t WS_HZ = WS_PB + 4ull * T * 256 * 2;
constexpr size_t WS_MIX = WS_HZ + (size_t)T * 2816 * 2;
constexpr size_t WS_SCR = WS_MIX + (size_t)T * 1024 * 2;
constexpr size_t WS_S = WS_SCR;
constexpr size_t WS_HL = WS_S + 1024ull * 8192 * 4;
constexpr size_t WS_AC = WS_HL + (size_t)T * 512 * 4;
constexpr size_t WS_CARRY = WS_AC + (size_t)T * 512 * 4;
constexpr size_t WS_DECAY = WS_CARRY + 4ull * 64 * 512 * 4;
constexpr size_t WS_CTL = WS_DECAY + 1024ull * 64 * 4;
constexpr size_t CTL_BYTES = 16384;
constexpr size_t WS_QK0 = WS_CTL + CTL_BYTES;
constexpr size_t WS_END = WS_QK0 + 8192;
constexpr size_t WS_PP = WS_SCR;

struct Params {
    const float* in[33];
    float* out;
    unsigned char* ws;
    int ph_lo, ph_hi;
};

__device__ __forceinline__ float bf_lo(unsigned w) { return __uint_as_float(w << 16); }
__device__ __forceinline__ float bf_hi(unsigned w) { return __uint_as_float(w & 0xffff0000u); }
__device__ __forceinline__ unsigned f2bf(float f) { unsigned u = __float_as_uint(f); return (u + 0x7fffu + ((u >> 16) & 1u)) >> 16; }
__device__ __forceinline__ unsigned pk2(float lo, float hi) { unsigned r; asm volatile("v_cvt_pk_bf16_f32 %0, %1, %2" : "=v"(r) : "v"(lo), "v"(hi)); return r; }
__device__ __forceinline__ float sigmoidf_(float x) { return __builtin_amdgcn_rcpf(1.0f + __expf(-x)); }
__device__ __forceinline__ float siluf_(float x) { return x * __builtin_amdgcn_rcpf(1.0f + __expf(-x)); }
__device__ __forceinline__ float gelu_tanh(float x) { const float y = 0.7978845608028654f * (x + 0.044715f * x * x * x); return x / (1.0f + __expf(-2.0f * y)); }
__device__ __forceinline__ float softplusf_(float x) { return fmaxf(x, 0.f) + log1pf(__expf(-fabsf(x))); }
__device__ __forceinline__ float logsigmoidf_(float x) { return fminf(x, 0.f) - __logf(1.0f + __expf(-fabsf(x))); }
__device__ __forceinline__ int otid() { int t = threadIdx.x; asm volatile("" : "+v"(t)); return t; }
__device__ __forceinline__ int obid() { int b = blockIdx.x; asm volatile("" : "+s"(b)); return b; }
__device__ __forceinline__ int ogrid() { int g = gridDim.x; asm volatile("" : "+s"(g)); return g; }
__device__ __forceinline__ int pinv32(int c) { return 16 * ((c >> 2) & 1) + 4 * (c >> 3) + (c & 3); }
__device__ __forceinline__ float wave_sum(float v) {
#pragma unroll
    for (int o = 1; o < 64; o <<= 1) v += __shfl_xor(v, o);
    return v;
}

namespace pg8 {
constexpr int BM = 256, BK = 64, HALF = 128, HTB = HALF * BK * 2, STAGE_BYTES = 8 * HTB, NXCD = 8, WGM = 8;
__host__ __device__ __forceinline__ int lds_byte(int r, int c) { const int st = (r >> 4) * 2 + (c >> 5), rr = r & 15, cc = c & 31, ob = rr * 64 + cc * 2; return st * 1024 + (ob ^ (((ob >> 9) & 1) << 5)); }
__host__ __device__ __forceinline__ void stage_rc(int b, int& R, int& C) { const int st = b / 1024, sb = b % 1024, swz = sb ^ (((sb >> 9) & 1) << 5); R = (st >> 1) * 16 + swz / 64; C = (st & 1) * 32 + (swz % 64) / 2; }
struct Unit { int pm, pn; };
struct Gemm { const bf16_t* A; const bf16_t* Bt; int M, N, K; };
struct StaticOrder {
    int nM, nN, nwg, G, c;
    __device__ void init(int M, int N, int G_, int c_) { nM = M / BM; nN = N / BM; nwg = nM * nN; G = G_; c = c_; }
    __device__ bool next(int i, Unit& u) const {
        const long L = (long)i * G + c; if (L >= nwg) return false;
        int wgid = (int)L; { const int q = nwg / NXCD, r = nwg % NXCD, xcd = wgid % NXCD, off = wgid / NXCD; wgid = (xcd < r ? xcd * (q + 1) : r * (q + 1) + (xcd - r) * q) + off; }
        const int nig = WGM * nN, gid = wgid / nig, fm = gid * WGM, gsz = (nM - fm) < WGM ? (nM - fm) : WGM;
        u.pm = fm + ((wgid % nig) % gsz); u.pn = (wgid % nig) / gsz; return true;
    }
};

__device__ __forceinline__ float row_scale(const float* part, int row) {
    const f32x4* p = (const f32x4*)(part + (size_t)row * 16);
    const f32x4 a = p[0], b = p[1], c = p[2], d = p[3];
    const float s = (((a[0] + a[1]) + (a[2] + a[3])) + ((b[0] + b[1]) + (b[2] + b[3]))) + (((c[0] + c[1]) + (c[2] + c[3])) + ((d[0] + d[1]) + (d[2] + d[3])));
    return rsqrtf(s * (1.0f / 1024.0f) + EPS);
}
struct Epi {
    int mode;
    const float* ssq_in;
    float* ssq_out;
    const float* xin;
    const bf16_t* hin; const bf16_t* lin; bf16_t* xb; bf16_t* lout;
    bf16_t* ob; int ldo;
    float* of;
    const float* bias;
    float alpha;
    __device__ __forceinline__ void scales2(const Unit& u, int wr, int fr, int fq, float& sA, float& sB) const {
        const int rowA = u.pm * BM + wr * 64 + fq * 16 + fr;
        const f32x4* pa = (const f32x4*)(ssq_in + (size_t)rowA * 16); const f32x4* pb = (const f32x4*)(ssq_in + (size_t)(rowA + HALF) * 16);
        const f32x4 a0 = pa[0], a1 = pa[1], a2 = pa[2], a3 = pa[3], b0 = pb[0], b1 = pb[1], b2 = pb[2], b3 = pb[3];
        const float ta = (((a0[0] + a0[1]) + (a0[2] + a0[3])) + ((a1[0] + a1[1]) + (a1[2] + a1[3]))) + (((a2[0] + a2[1]) + (a2[2] + a2[3])) + ((a3[0] + a3[1]) + (a3[2] + a3[3])));
        const float tb = (((b0[0] + b0[1]) + (b0[2] + b0[3])) + ((b1[0] + b1[1]) + (b1[2] + b1[3]))) + (((b2[0] + b2[1]) + (b2[2] + b2[3])) + ((b3[0] + b3[1]) + (b3[2] + b3[3])));
        sA = rsqrtf(ta * (1.0f / 1024.0f) + EPS); sB = rsqrtf(tb * (1.0f / 1024.0f) + EPS);
    }
    template <int mode> __device__ __forceinline__ void run(const f32x4 (&acc)[2][2][4][2], const Unit& u, int wr, int wc, int fr, int fq, const LAS float* sc) const {
        const int row0 = u.pm * BM + wr * 64 + fr;
        if (mode == 0) {
            const int col0 = u.pn * HALF + wc * 32 + 8 * fq;
#pragma unroll
            for (int ai = 0; ai < 2; ++ai)
#pragma unroll
                for (int m = 0; m < 4; ++m) {
                    const int row = row0 + ai * HALF + m * 16;
                    const float s = sc[ai * HALF + wr * 64 + m * 16 + fr];
                    const f32x4 g0 = acc[ai][0][m][0] * s, u0 = acc[ai][1][m][0] * s, g1 = acc[ai][0][m][1] * s, u1 = acc[ai][1][m][1] * s;
                    u32x4 w;
                    w.x = pk2(siluf_(g0[0]) * u0[0], siluf_(g0[1]) * u0[1]); w.y = pk2(siluf_(g0[2]) * u0[2], siluf_(g0[3]) * u0[3]);
                    w.z = pk2(siluf_(g1[0]) * u1[0], siluf_(g1[1]) * u1[1]); w.w = pk2(siluf_(g1[2]) * u1[2], siluf_(g1[3]) * u1[3]);
                    *(u32x4*)(ob + (size_t)row * FF + col0) = w;
                }
        } else if (mode == 1) {
            const int col0 = u.pn * BM + wc * 32 + 8 * fq;
            f32x4 bv[2][2];
#pragma unroll
            for (int bj = 0; bj < 2; ++bj)
#pragma unroll
                for (int n = 0; n < 2; ++n) bv[bj][n] = bias ? *(const f32x4*)(bias + col0 + bj * HALF + 4 * n) : (f32x4){0.f, 0.f, 0.f, 0.f};
#pragma unroll
            for (int ai = 0; ai < 2; ++ai)
#pragma unroll
                for (int m = 0; m < 4; ++m) {
                    const int row = row0 + ai * HALF + m * 16;
                    const float s = sc[ai * HALF + wr * 64 + m * 16 + fr];
                    bf16_t* rowp = ob + (size_t)row * ldo + col0;
#pragma unroll
                    for (int bj = 0; bj < 2; ++bj) {
                        const f32x4 v0 = acc[ai][bj][m][0] * s + bv[bj][0], v1 = acc[ai][bj][m][1] * s + bv[bj][1];
                        u32x4 w; w.x = pk2(v0[0], v0[1]); w.y = pk2(v0[2], v0[3]); w.z = pk2(v1[0], v1[1]); w.w = pk2(v1[2], v1[3]);
                        *(u32x4*)(rowp + bj * HALF) = w;
                    }
                }
        } else if (mode == 2) {
            const int col0 = u.pn * BM + wc * 32 + 8 * fq;
#pragma unroll
            for (int ai = 0; ai < 2; ++ai)
#pragma unroll
                for (int m = 0; m < 4; ++m) {
                    bf16_t* rowp = ob + (size_t)(row0 + ai * HALF + m * 16) * D + col0;
#pragma unroll
                    for (int bj = 0; bj < 2; ++bj) {
                        const f32x4 v0 = acc[ai][bj][m][0], v1 = acc[ai][bj][m][1];
                        u32x4 w; w.x = pk2(v0[0], v0[1]); w.y = pk2(v0[2], v0[3]); w.z = pk2(v1[0], v1[1]); w.w = pk2(v1[2], v1[3]);
                        *(u32x4*)(rowp + bj * HALF) = w;
                    }
                }
        } else {
            const int col0 = u.pn * BM + wc * 32 + 8 * fq;
            float sA = 1.f, sB = 1.f;
            if (mode == 4) scales2(u, wr, fr, fq, sA, sB);
            f32x4 bvv[4];
#pragma unroll
            for (int q = 0; q < 4; ++q) bvv[q] = (mode != 4 && bias) ? *(const f32x4*)(bias + col0 + (q >> 1) * HALF + (q & 1) * 4) : (f32x4){0.f, 0.f, 0.f, 0.f};
            constexpr int DEPTH = (mode == 3) ? 4 : 2;
            f32x4 xi[mode == 5 ? DEPTH : 1][4]; u32x4 pq[mode == 4 ? DEPTH : 1][2]; u32x4 xh[DEPTH][2], xl[DEPTH][2];
#pragma unroll
            for (int g0 = 0; g0 < DEPTH - 1; ++g0) {
                const size_t off = (size_t)(row0 + (g0 >> 2) * HALF + (g0 & 3) * 16) * D + col0;
#pragma unroll
                for (int bj = 0; bj < 2; ++bj) {
                    const size_t o = off + bj * HALF;
                    if (mode == 5) { xi[g0][2 * bj] = *(const f32x4*)(xin + o); xi[g0][2 * bj + 1] = *(const f32x4*)(xin + o + 4); }
                    else { xh[g0][bj] = *(const u32x4*)(hin + o); xl[g0][bj] = *(const u32x4*)(lin + o); }
                    if (mode == 4) pq[g0][bj] = *(const u32x4*)(ob + o);
                }
            }
#pragma unroll
            for (int g = 0; g < 8; ++g) {
                const int ai = g >> 2, m = g & 3, cb = g % DEPTH, nb = (g + DEPTH - 1) % DEPTH;
                const int row = row0 + ai * HALF + m * 16;
                const size_t off = (size_t)row * D + col0;
                if (g + DEPTH - 1 < 8) {
                    const int gn = g + DEPTH - 1;
                    const size_t offn = (size_t)(row0 + (gn >> 2) * HALF + (gn & 3) * 16) * D + col0;
#pragma unroll
                    for (int bj = 0; bj < 2; ++bj) {
                        const size_t o = offn + bj * HALF;
                        if (mode == 5) { xi[nb][2 * bj] = *(const f32x4*)(xin + o); xi[nb][2 * bj + 1] = *(const f32x4*)(xin + o + 4); }
                        else { xh[nb][bj] = *(const u32x4*)(hin + o); xl[nb][bj] = *(const u32x4*)(lin + o); }
                        if (mode == 4) pq[nb][bj] = *(const u32x4*)(ob + o);
                    }
                }
                float s = 1.f;
                if (mode == 4) s = __shfl(ai ? sB : sA, m * 16 + fr);
                float ss = 0.f;
#pragma unroll
                for (int bj = 0; bj < 2; ++bj) {
                    u32x4 wh, wl;
#pragma unroll
                    for (int n = 0; n < 2; ++n) {
                        const int q = 2 * bj + n;
                        const unsigned h0 = n ? xh[cb][bj].z : xh[cb][bj].x, h1 = n ? xh[cb][bj].w : xh[cb][bj].y, l0 = n ? xl[cb][bj].z : xl[cb][bj].x, l1 = n ? xl[cb][bj].w : xl[cb][bj].y;
                        f32x4 xo;
                        if (mode == 5) xo = xi[mode == 5 ? cb : 0][q];
                        else { xo[0] = bf_lo(h0) + bf_lo(l0); xo[1] = bf_hi(h0) + bf_hi(l0); xo[2] = bf_lo(h1) + bf_lo(l1); xo[3] = bf_hi(h1) + bf_hi(l1); }
                        f32x4 v;
                        if (mode != 4) v = xo + acc[ai][bj][m][n] * alpha + bvv[q];
                        else {
                            const f32x4 a = acc[ai][bj][m][n] * s;
                            const int pc = (mode == 4) ? cb : 0; const unsigned p0 = n ? pq[pc][bj].z : pq[pc][bj].x, p1 = n ? pq[pc][bj].w : pq[pc][bj].y;
                            v[0] = xo[0] + sigmoidf_(a[0]) * bf_lo(p0); v[1] = xo[1] + sigmoidf_(a[1]) * bf_hi(p0);
                            v[2] = xo[2] + sigmoidf_(a[2]) * bf_lo(p1); v[3] = xo[3] + sigmoidf_(a[3]) * bf_hi(p1);
                        }
                        const unsigned w0 = pk2(v[0], v[1]), w1 = pk2(v[2], v[3]);
                        const unsigned m0 = pk2(v[0] - bf_lo(w0), v[1] - bf_hi(w0)), m1 = pk2(v[2] - bf_lo(w1), v[3] - bf_hi(w1));
                        if (n == 0) { wh.x = w0; wh.y = w1; wl.x = m0; wl.y = m1; } else { wh.z = w0; wh.w = w1; wl.z = m0; wl.w = m1; }
                        ss += (v[0] * v[0] + v[1] * v[1]) + (v[2] * v[2] + v[3] * v[3]);
                    }
                    *(u32x4*)(xb + off + bj * HALF) = wh;
                    *(u32x4*)(lout + off + bj * HALF) = wl;
                }
                ss += __shfl_xor(ss, 16); ss += __shfl_xor(ss, 32);
                if (fq == 0) ssq_out[(size_t)row * 16 + u.pn * 4 + wc] = ss;
            }
        }
    }
};

template <int MODE, class EpiT, class Sched>
__device__ __forceinline__ void gemm_phase(LAS unsigned char* lds, const Gemm g, const Sched& S, const EpiT& E) {
    const int tid = otid(), wid = __builtin_amdgcn_readfirstlane(tid >> 6), lane = tid & 63, wr = wid >> 2, wc = wid & 3, fr = lane & 15, fq = lane >> 4;
    const int K = g.K, nt = K / BK;
    unsigned voffA[2], voffB[2];
#pragma unroll
    for (int i = 0; i < 2; ++i) { int R, C; stage_rc(tid * 16 + i * 8192, R, C); voffA[i] = (unsigned)(R * K + C) * 2u; voffB[i] = (unsigned)(R * K + C) * 2u; }
    const size_t kstep = (size_t)(BK * 2);
    const size_t hstep = (size_t)HALF * K * 2;
    const size_t tstep = 2 * hstep;
    const unsigned ldsw = (unsigned)wid * 1024u;
    const int aoff = lds_byte(wr * 64 + fr, fq * 8), boff = lds_byte(wc * 32 + fr, fq * 8);
#define PG8_SA(b, h) (((b) * 2 + (h)) * HTB)
#define PG8_SB(b, h) ((4 + (b) * 2 + (h)) * HTB)
#define PG8_STAGE(bufoff, gbase, voff) do { _Pragma("unroll") for (int _i = 0; _i < 2; ++_i) \
        __builtin_amdgcn_global_load_lds((const unsigned*)((const char*)(gbase) + (voff)[_i]), (LAS unsigned*)(lds + (bufoff) + ldsw + _i * 8192), 16, 0, 0); } while (0)
#define PG8_LDA(dst, b, h) do { _Pragma("unroll") for (int m = 0; m < 4; ++m) _Pragma("unroll") for (int k = 0; k < 2; ++k) dst[m][k] = *(const LAS bf16x8*)(lds + PG8_SA(b, h) + aoff + m * 2048 + k * 1024); } while (0)
#define PG8_LDB(dst, b, h) do { _Pragma("unroll") for (int n = 0; n < 2; ++n) _Pragma("unroll") for (int k = 0; k < 2; ++k) dst[n][k] = *(const LAS bf16x8*)(lds + PG8_SB(b, h) + boff + n * 2048 + k * 1024); } while (0)
#define PG8_MMA(ai, bj, At, Bt) do { __builtin_amdgcn_s_setprio(1); _Pragma("unroll") for (int m = 0; m < 4; ++m) _Pragma("unroll") for (int n = 0; n < 2; ++n) _Pragma("unroll") for (int k = 0; k < 2; ++k) \
        acc[ai][bj][m][n] = __builtin_amdgcn_mfma_f32_16x16x32_bf16(Bt[n][k], At[m][k], acc[ai][bj][m][n], 0, 0, 0); __builtin_amdgcn_s_setprio(0); } while (0)
#define PG8_WAIT_V(n) asm volatile("s_waitcnt vmcnt(" #n ")" ::: "memory")
#define PG8_WAIT_L(n) asm volatile("s_waitcnt lgkmcnt(" #n ")" ::: "memory")
#define PG8_BAR __builtin_amdgcn_s_barrier()
#define PG8_SCHED __builtin_amdgcn_sched_barrier(0)
    Unit cur, nxt; int ui = 0;
    if (!S.next(0, cur)) return;
    LAS float* SC = (LAS float*)(lds + STAGE_BYTES);
    if (MODE <= 1) {
        f32x4 pa[6], pb[6]; bool ok[6];
#pragma unroll
        for (int i = 0; i < 6; ++i) {
            Unit uu; ok[i] = S.next(i, uu);
            const int row = (ok[i] ? uu.pm : cur.pm) * BM + (tid >> 1);
            const f32x4* p = (const f32x4*)(E.ssq_in + (size_t)row * 16) + (tid & 1) * 2;
            pa[i] = p[0]; pb[i] = p[1];
        }
#pragma unroll
        for (int i = 0; i < 6; ++i) {
            float s = ((pa[i][0] + pa[i][1]) + (pa[i][2] + pa[i][3])) + ((pb[i][0] + pb[i][1]) + (pb[i][2] + pb[i][3]));
            s += __shfl_xor(s, 1);
            if (!(tid & 1)) SC[i * 256 + (tid >> 1)] = rsqrtf(s * (1.0f / 1024.0f) + EPS);
        }
        __syncthreads();
    }
    f32x4 acc[2][2][4][2];
#pragma unroll
    for (int a = 0; a < 2; ++a)
#pragma unroll
        for (int b = 0; b < 2; ++b)
#pragma unroll
            for (int m = 0; m < 4; ++m)
#pragma unroll
                for (int n = 0; n < 2; ++n) acc[a][b][m][n] = (f32x4){0.f, 0.f, 0.f, 0.f};
    bf16x8 At[4][2], B0[2][2], B1[2][2];
    const char* cA = (const char*)g.A + (size_t)cur.pm * tstep; const char* cB = (const char*)g.Bt + (size_t)cur.pn * tstep;
    PG8_STAGE(PG8_SB(0, 0), cB, voffB); PG8_STAGE(PG8_SA(0, 0), cA, voffA); PG8_STAGE(PG8_SB(0, 1), cB + hstep, voffB); PG8_STAGE(PG8_SA(0, 1), cA + hstep, voffA);
    if (wr == 1) PG8_BAR;
    PG8_WAIT_V(4); PG8_BAR;
    PG8_STAGE(PG8_SB(1, 0), cB + kstep, voffB); PG8_STAGE(PG8_SA(1, 0), cA + kstep, voffA); PG8_STAGE(PG8_SB(1, 1), cB + hstep + kstep, voffB);
    PG8_WAIT_V(6); PG8_BAR;
    for (;;) {
        const bool has_next = S.next(ui + 1, nxt);
        const char* nA = has_next ? (const char*)g.A + (size_t)nxt.pm * tstep : cA; const char* nB = has_next ? (const char*)g.Bt + (size_t)nxt.pn * tstep : cB;
        for (int t = 0; t < nt; t += 2) {
            const bool last = (t == nt - 2);
            const char* a1 = cA + (size_t)(t + 1) * kstep;
            const char* a2 = last ? nA : cA + (size_t)(t + 2) * kstep; const char* b2 = last ? nB : cB + (size_t)(t + 2) * kstep;
            const char* a3 = a2 + kstep; const char* b3 = b2 + kstep;
            PG8_LDB(B0, 0, 0); PG8_SCHED; PG8_LDA(At, 0, 0); PG8_STAGE(PG8_SA(1, 1), a1 + hstep, voffA);
            PG8_WAIT_L(8); PG8_BAR; PG8_WAIT_L(0); PG8_MMA(0, 0, At, B0); PG8_BAR; PG8_SCHED;
            PG8_LDB(B1, 0, 1); PG8_STAGE(PG8_SB(0, 0), b2, voffB);
            PG8_BAR; PG8_WAIT_L(0); PG8_MMA(0, 1, At, B1); PG8_BAR;
            PG8_LDA(At, 0, 1); PG8_STAGE(PG8_SA(0, 0), a2, voffA);
            PG8_BAR; PG8_WAIT_L(0); PG8_MMA(1, 0, At, B0); PG8_BAR; PG8_SCHED;
            PG8_STAGE(PG8_SB(0, 1), b2 + hstep, voffB);
            PG8_WAIT_V(6); PG8_BAR; PG8_MMA(1, 1, At, B1); PG8_BAR;
            PG8_LDB(B0, 1, 0); PG8_SCHED; PG8_LDA(At, 1, 0); PG8_STAGE(PG8_SA(0, 1), a2 + hstep, voffA);
            PG8_WAIT_L(8); PG8_BAR; PG8_WAIT_L(0); PG8_MMA(0, 0, At, B0); PG8_BAR; PG8_SCHED;
            PG8_LDB(B1, 1, 1); PG8_STAGE(PG8_SB(1, 0), b3, voffB);
            PG8_BAR; PG8_WAIT_L(0); PG8_MMA(0, 1, At, B1); PG8_BAR;
            PG8_LDA(At, 1, 1); PG8_STAGE(PG8_SA(1, 0), a3, voffA);
            PG8_BAR; PG8_WAIT_L(0); PG8_MMA(1, 0, At, B0); PG8_BAR; PG8_SCHED;
            PG8_STAGE(PG8_SB(1, 1), b3 + hstep, voffB);
            PG8_WAIT_V(6); PG8_BAR; PG8_MMA(1, 1, At, B1); PG8_BAR;
        }
        E.template run<MODE>(acc, cur, wr, wc, fr, fq, SC + ui * 256);
        if (!has_next) break;
#pragma unroll
        for (int a = 0; a < 2; ++a)
#pragma unroll
            for (int b = 0; b < 2; ++b)
#pragma unroll
                for (int m = 0; m < 4; ++m)
#pragma unroll
                    for (int n = 0; n < 2; ++n) acc[a][b][m][n] = (f32x4){0.f, 0.f, 0.f, 0.f};
        cur = nxt; cA = nA; cB = nB; ++ui;
    }
    PG8_WAIT_V(0);
    if (wr == 0) PG8_BAR;
    PG8_BAR;
#undef PG8_SA
#undef PG8_SB
#undef PG8_STAGE
#undef PG8_LDA
#undef PG8_LDB
#undef PG8_MMA
#undef PG8_WAIT_V
#undef PG8_WAIT_L
#undef PG8_BAR
#undef PG8_SCHED
}
}

__device__ __forceinline__ void run_gemm(LAS unsigned char* lds, const bf16_t* A, const bf16_t* Bt, int N, int K, const pg8::Epi& E, int c0 = 0) {
    const int G_ = ogrid() - c0, c_ = obid() - c0;
    if (c_ < 0) return;
    pg8::Gemm g{A, Bt, T, N, K}; pg8::StaticOrder S; S.init(T, N, G_, c_);
    switch (E.mode) {
    case 0: pg8::gemm_phase<0, pg8::Epi, pg8::StaticOrder>(lds, g, S, E); break;
    case 1: pg8::gemm_phase<1, pg8::Epi, pg8::StaticOrder>(lds, g, S, E); break;
    case 2: pg8::gemm_phase<2, pg8::Epi, pg8::StaticOrder>(lds, g, S, E); break;
    case 3: pg8::gemm_phase<3, pg8::Epi, pg8::StaticOrder>(lds, g, S, E); break;
    case 4: pg8::gemm_phase<4, pg8::Epi, pg8::StaticOrder>(lds, g, S, E); break;
    default: pg8::gemm_phase<5, pg8::Epi, pg8::StaticOrder>(lds, g, S, E); break;
    }
}

struct CvtJob { const float* W; const float* gain; bf16_t* dst; int K, ldw, col0, ncols, mode; };

__device__ __forceinline__ CvtJob get_job(const Params& P, int j) {
    CvtJob J; J.gain = nullptr; J.col0 = 0; J.mode = 0;
    unsigned char* ws = P.ws;
    if (j < 16) {
        const int f = j >> 1, part = j & 1, L = f >> 1, w = f & 1;
        const float* src = w ? (part ? P.in[11] : P.in[10]) : (part ? P.in[6] : P.in[5]);
        J.W = src + (size_t)L * 1024 * 2816; J.gain = (w ? P.in[9] : P.in[4]) + L * 1024;
        J.dst = (bf16_t*)(ws + WS_WUP) + (size_t)f * 5632 * 1024 + (size_t)part * 128 * 1024;
        J.K = 1024; J.ldw = 2816; J.ncols = 2816; J.mode = 1;
    } else if (j < 24) {
        const int f = j - 16, L = f >> 1, w = f & 1;
        J.W = (w ? P.in[12] : P.in[7]) + (size_t)L * 2816 * 1024;
        J.dst = (bf16_t*)(ws + WS_WDN) + (size_t)f * 1024 * 2816;
        J.K = 2816; J.ldw = 1024; J.ncols = 1024;
    } else if (j < 28) {
        const int e = (j - 24) >> 1, part = (j - 24) & 1;
        J.W = P.in[16] + (size_t)e * 1024 * 2576; J.gain = P.in[8] + (2 * e) * 1024;
        J.dst = (bf16_t*)(ws + WS_WIN) + (size_t)e * 2816 * 1024 + (part ? (size_t)1536 * 1024 : 0);
        J.K = 1024; J.ldw = 2576; J.col0 = part ? 1552 : 0; J.ncols = part ? 1024 : 1536;
    } else if (j < 30) {
        const int e = j - 28;
        J.W = P.in[17] + (size_t)e * 1024 * 1024; J.dst = (bf16_t*)(ws + WS_WOUT) + (size_t)e * 1024 * 1024;
        J.K = 1024; J.ldw = 1024; J.ncols = 1024;
    } else if (j < 32) {
        const int o = j - 30;
        J.W = P.in[28] + (size_t)o * 1024 * 1536; J.gain = P.in[8] + (2 * o + 1) * 1024;
        J.dst = (bf16_t*)(ws + WS_WQKV) + (size_t)o * 1536 * 1024;
        J.K = 1024; J.ldw = 1536; J.ncols = 1536;
    } else if (j < 34) {
        const int o = j - 32;
        J.W = P.in[30] + (size_t)o * 1024 * 1024; J.dst = (bf16_t*)(ws + WS_WO) + (size_t)o * 1024 * 1024;
        J.K = 1024; J.ldw = 1024; J.ncols = 1024;
    } else if (j < 38) {
        const int L = j - 34;
        J.W = P.in[15] + (size_t)L * 1024 * 1024; J.gain = P.in[13] + L * 1024;
        J.dst = (bf16_t*)(ws + WS_WPG) + (size_t)L * 1024 * 1024;
        J.K = 1024; J.ldw = 1024; J.ncols = 1024;
    } else {
        const int L = j - 38;
        J.W = P.in[14] + (size_t)L * 256 * 1024; J.dst = (bf16_t*)(ws + WS_WPP) + (size_t)L * 1024 * 256;
        J.K = 256; J.ldw = 1024; J.ncols = 1024;
    }
    return J;
}

__device__ __forceinline__ void cvt_item64(const CvtJob& J, int item, LAS float* scr, int lane) {
    const int nblk = J.ncols / 64, kb = item / nblk, nb = item - kb * nblk, k0 = 64 * kb, n0 = 64 * nb;
    const int r4 = lane >> 4, c4 = (lane & 15) * 4;
    f32x4 w[16];
#pragma unroll
    for (int i = 0; i < 16; ++i) w[i] = *(const f32x4*)(J.W + (size_t)(k0 + 4 * i + r4) * J.ldw + J.col0 + n0 + c4);
    if (J.gain) {
#pragma unroll
        for (int i = 0; i < 16; ++i) w[i] = w[i] * J.gain[k0 + 4 * i + r4];
    }
#pragma unroll
    for (int i = 0; i < 16; ++i) { LAS float* d = scr + (4 * i + r4) * 65 + c4; d[0] = w[i][0]; d[1] = w[i][1]; d[2] = w[i][2]; d[3] = w[i][3]; }
    asm volatile("s_waitcnt lgkmcnt(0)" ::: "memory");
    const int c = lane & 7;
#pragma unroll
    for (int j = 0; j < 8; ++j) {
        const int n = (lane >> 3) + 8 * j; const LAS float* s = scr + (8 * c) * 65 + n;
        u32x4 o; o.x = pk2(s[0 * 65], s[1 * 65]); o.y = pk2(s[2 * 65], s[3 * 65]); o.z = pk2(s[4 * 65], s[5 * 65]); o.w = pk2(s[6 * 65], s[7 * 65]);
        const int nn = n0 + n; const int row_ = J.mode ? ((nn >> 7) * 256 + (nn & 127)) : nn;
        const int row = (row_ & ~31) + pinv32(row_ & 31);
        *(u32x4*)(J.dst + (size_t)row * J.K + k0 + 8 * c) = o;
    }
    asm volatile("s_waitcnt lgkmcnt(0)" ::: "memory");
}
__device__ __forceinline__ void cvt_map(int it, int& job, int& local) {
    if (it < 16896) { job = it / 704; local = it - job * 704; }
    else {
        int r = it - 16896;
        if (r < 1280) { const int e = r / 640, rr = r - e * 640, part = rr >= 384; local = part ? rr - 384 : rr; job = 24 + 2 * e + part; }
        else { r -= 1280;
            if (r < 512) { job = 28 + (r >> 8); local = r & 255; }
            else { r -= 512;
                if (r < 768) { const int o = r / 384; job = 30 + o; local = r - o * 384; }
                else { r -= 768;
                    if (r < 1536) { job = 32 + (r >> 8); local = r & 255; }
                    else { r -= 1536; job = 38 + (r >> 6); local = r & 63; } } } }
    }
}

__device__ __forceinline__ void first_token_qk(const Params& P, LAS unsigned char* lds, int L, int c0) {
    const int j = obid() - c0;
    if (j < 0 || j >= 64) return;
    const int e = L >> 1, tid = otid(), col = tid & 7, dg = tid >> 3;
    const float* W = P.in[16] + (size_t)e * 1024 * 2576 + 8 * j + col;
    float w[16];
#pragma unroll
    for (int q = 0; q < 16; ++q) w[q] = W[(size_t)(dg * 16 + q) * 2576];
    LAS float* X = (LAS float*)lds;
    {
        const int b = tid >> 7, d0 = (tid & 127) * 8;
        const size_t o = (size_t)(b * SEQ) * D + d0;
        const u32x4 h8 = *(const u32x4*)((const bf16_t*)(P.ws + WS_XB) + o), l8 = *(const u32x4*)((const bf16_t*)P.out + o);
        const f32x4 g0 = *(const f32x4*)(P.in[8] + L * 1024 + d0), g1 = *(const f32x4*)(P.in[8] + L * 1024 + d0 + 4);
        f32x4 a, c;
        a[0] = (bf_lo(h8.x) + bf_lo(l8.x)) * g0[0]; a[1] = (bf_hi(h8.x) + bf_hi(l8.x)) * g0[1]; a[2] = (bf_lo(h8.y) + bf_lo(l8.y)) * g0[2]; a[3] = (bf_hi(h8.y) + bf_hi(l8.y)) * g0[3];
        c[0] = (bf_lo(h8.z) + bf_lo(l8.z)) * g1[0]; c[1] = (bf_hi(h8.z) + bf_hi(l8.z)) * g1[1]; c[2] = (bf_lo(h8.w) + bf_lo(l8.w)) * g1[2]; c[3] = (bf_hi(h8.w) + bf_hi(l8.w)) * g1[3];
        *(LAS f32x4*)(X + b * 1024 + d0) = a; *(LAS f32x4*)(X + b * 1024 + d0 + 4) = c;
    }
    __syncthreads();
    float acc[4] = {0.f, 0.f, 0.f, 0.f};
#pragma unroll
    for (int b = 0; b < 4; ++b)
#pragma unroll
        for (int q4 = 0; q4 < 4; ++q4) {
            const f32x4 xv = *(const LAS f32x4*)(X + b * 1024 + dg * 16 + 4 * q4);
            acc[b] += xv[0] * w[4 * q4] + xv[1] * w[4 * q4 + 1] + xv[2] * w[4 * q4 + 2] + xv[3] * w[4 * q4 + 3];
        }
    LAS float* R = X + 4096;
#pragma unroll
    for (int b = 0; b < 4; ++b) R[(dg * 8 + col) * 4 + b] = acc[b];
    __syncthreads();
    if (tid < 32) {
        const int c = tid & 7, b = tid >> 3;
        float s = 0.f;
        for (int g = 0; g < 64; ++g) s += R[(g * 8 + c) * 4 + b];
        const float* ssq = (const float*)(P.ws + WS_SSQ) + (size_t)((4 * L + 1) & 1) * T * 16;
        ((float*)(P.ws + WS_QK0))[b * 512 + 8 * j + c] = s * pg8::row_scale(ssq, b * SEQ);
    }
    __syncthreads();
}

__device__ __forceinline__ void layer_small_cvt(const Params& P, int L, int c0) {
    const int nb = ogrid() - c0, bi = obid() - c0;
    if (bi < 0) return;
    const int gt = bi * NTHREADS + otid(), NGT = nb * NTHREADS;
    unsigned char* ws = P.ws;
    const f32x4* p4 = (const f32x4*)P.in[1] + (size_t)L * (T * 256 / 4); u32x2* pb = (u32x2*)(ws + WS_PB) + (size_t)L * (T * 256 / 4);
#pragma unroll 8
    for (int i = gt; i < T * 256 / 4; i += NGT) { const f32x4 v = p4[i]; u32x2 w; w.x = pk2(v[0], v[1]); w.y = pk2(v[2], v[3]); pb[i] = w; }
    if (!(L & 1)) {
        const int e = L >> 1;
        for (int idx = gt; idx < 256 * 1024; idx += NGT) {
            const int n = idx >> 10, k = idx & 1023;
            const float* wi = P.in[16] + (size_t)e * 1024 * 2576 + (size_t)k * 2576 + 1536;
            const float* wf = P.in[18] + e * 16 * 256 + n;
            float s = 0.f;
#pragma unroll
            for (int r = 0; r < 16; ++r) s += wi[r] * wf[r * 256];
            s *= P.in[8][(2 * e) * 1024 + k];
            ((bf16_t*)(ws + WS_WIN))[(size_t)e * 2816 * 1024 + (size_t)(2560 + (n & ~31) + pinv32(n & 31)) * 1024 + k] = (bf16_t)f2bf(s);
        }
    }
}

__device__ __forceinline__ void phase_prepass(const Params& P, LAS unsigned char* lds) {
    const int tid = otid(), lane = tid & 63, wave = tid >> 6;
    const int gw = obid() * 8 + wave, NGW = ogrid() * 8;
    const int gt = obid() * NTHREADS + tid, NGT = ogrid() * NTHREADS;
    unsigned char* ws = P.ws;
    LAS float* scr = (LAS float*)(lds + wave * 16640);
    for (int rp_ = 0; rp_ < (PROBE_DUP == 9 ? 2 : 1); ++rp_)
    for (int it = gw; it < 21248; it += NGW) {
        int job, local; cvt_map(it, job, local);
        const CvtJob J = get_job(P, job);
        cvt_item64(J, local, scr, lane);
    }
    float* ssq = (float*)(ws + WS_SSQ);
    bf16_t* xb = (bf16_t*)(ws + WS_MIX);
    for (int m = gw; m < T; m += NGW) {
        const f32x4* xr = (const f32x4*)(P.in[0] + (size_t)m * D) + lane;
        f32x4 v[4]; float s = 0.f;
#pragma unroll
        for (int j = 0; j < 4; ++j) { v[j] = xr[64 * j]; s += (v[j][0] * v[j][0] + v[j][1] * v[j][1]) + (v[j][2] * v[j][2] + v[j][3] * v[j][3]); }
        s = wave_sum(s);
        u32x2* o8 = (u32x2*)(xb + (size_t)m * D) + lane;
#pragma unroll
        for (int j = 0; j < 4; ++j) { u32x2 w; w.x = pk2(v[j][0], v[j][1]); w.y = pk2(v[j][2], v[j][3]); o8[64 * j] = w; }
        if (lane < 16) ssq[(size_t)m * 16 + lane] = (lane == 0) ? s : 0.f;
    }
}

constexpr int LDT = 68;
constexpr int GO_BT = 0, GO_SEG = 4352, GO_QDT = 4864, GO_KDNT = 9216, GO_ATT = 13568, GO_V = 17920, GO_S = 26112;

template <bool WITH_Q>
__device__ __forceinline__ void gla_prolog(LAS float* L, const u32x4 k8, const u32x4 f8, const u32x4 q8, const f32x4 bf0, const f32x4 bf1, float (&kv)[8], float (&qv)[8]) {
    const int tid = otid(), lane = tid & 63, wave = tid >> 6;
    kv[0] = bf_lo(k8.x); kv[1] = bf_hi(k8.x); kv[2] = bf_lo(k8.y); kv[3] = bf_hi(k8.y); kv[4] = bf_lo(k8.z); kv[5] = bf_hi(k8.z); kv[6] = bf_lo(k8.w); kv[7] = bf_hi(k8.w);
    if (WITH_Q) {
        qv[0] = bf_lo(q8.x); qv[1] = bf_hi(q8.x); qv[2] = bf_lo(q8.y); qv[3] = bf_hi(q8.y); qv[4] = bf_lo(q8.z); qv[5] = bf_hi(q8.z); qv[6] = bf_lo(q8.w); qv[7] = bf_hi(q8.w);
    }
    float fv[8];
    fv[0] = bf_lo(f8.x); fv[1] = bf_hi(f8.x); fv[2] = bf_lo(f8.y); fv[3] = bf_hi(f8.y); fv[4] = bf_lo(f8.z); fv[5] = bf_hi(f8.z); fv[6] = bf_lo(f8.w); fv[7] = bf_hi(f8.w);
#pragma unroll
    for (int j = 0; j < 8; ++j) L[GO_BT + (8 * wave + j) * LDT + lane] = logsigmoidf_(fv[j] + (j < 4 ? bf0[j & 3] : bf1[j & 3])) * (1.0f / 16.0f);
    __syncthreads();
    float pr[8];
    {
        const f32x4 a = *(const LAS f32x4*)(L + GO_BT + lane * LDT + 8 * wave), b = *(const LAS f32x4*)(L + GO_BT + lane * LDT + 8 * wave + 4);
        pr[0] = a[0]; pr[1] = pr[0] + a[1]; pr[2] = pr[1] + a[2]; pr[3] = pr[2] + a[3]; pr[4] = pr[3] + b[0]; pr[5] = pr[4] + b[1]; pr[6] = pr[5] + b[2]; pr[7] = pr[6] + b[3];
        L[GO_SEG + wave * 64 + lane] = pr[7];
    }
    __syncthreads();
    {
        float off = 0.f;
        for (int s = 0; s < wave; ++s) off += L[GO_SEG + s * 64 + lane];
        f32x4 a, b; a[0] = pr[0] + off; a[1] = pr[1] + off; a[2] = pr[2] + off; a[3] = pr[3] + off; b[0] = pr[4] + off; b[1] = pr[5] + off; b[2] = pr[6] + off; b[3] = pr[7] + off;
        *(LAS f32x4*)(L + GO_BT + lane * LDT + 8 * wave) = a; *(LAS f32x4*)(L + GO_BT + lane * LDT + 8 * wave + 4) = b;
    }
    __syncthreads();
}

constexpr int MLD = 72;
constexpr int GB_QDB = 19456, GB_KDB = 28672, GB_VT = 37888, GB_STB = 56320, GB_RED = 74752;

__device__ __forceinline__ void stage_vT(LAS unsigned char* lds, int tid, const u32x4 (&vv)[2]) {
    LAS bf16_t* VT = (LAS bf16_t*)(lds + GB_VT);
#pragma unroll
    for (int r = 0; r < 2; ++r) {
        const int c = r * 512 + tid, j = c & 63, vc = c >> 6;
        const u32x4 v = vv[r];
        LAS bf16_t* d = VT + (32 * (vc >> 2) + 4 * (vc & 3)) * MLD + j;
        d[0 * MLD] = (bf16_t)(v.x & 0xffffu); d[1 * MLD] = (bf16_t)(v.x >> 16); d[2 * MLD] = (bf16_t)(v.y & 0xffffu); d[3 * MLD] = (bf16_t)(v.y >> 16);
        d[16 * MLD] = (bf16_t)(v.z & 0xffffu); d[17 * MLD] = (bf16_t)(v.z >> 16); d[18 * MLD] = (bf16_t)(v.w & 0xffffu); d[19 * MLD] = (bf16_t)(v.w >> 16);
    }
}

#define GLA_LOAD(ITEM, WITHQ) do { const int h_ = (ITEM) & 3, bn_ = (ITEM) >> 2, t0_ = (bn_ >> 6) * SEQ + (bn_ & 63) * 64; \
        const bf16_t* z_ = (const bf16_t*)(P.ws + WS_HZ) + (size_t)(t0_ + lane) * ZW; \
        k8 = *(const u32x4*)(z_ + 256 + h_ * 64 + 8 * wave); f8 = *(const u32x4*)(z_ + 2560 + h_ * 64 + 8 * wave); \
        if (WITHQ) q8 = *(const u32x4*)(z_ + h_ * 64 + 8 * wave); \
        _Pragma("unroll") for (int r_ = 0; r_ < 2; ++r_) { const int c_ = r_ * 512 + tid; \
            vv[r_] = *(const u32x4*)((const bf16_t*)(P.ws + WS_HZ) + (size_t)(t0_ + (c_ & 63)) * ZW + 512 + h_ * 128 + (c_ >> 6) * 8); } \
        const float* bfp_ = P.in[19] + e * 256 + h_ * 64 + 8 * wave; bf0 = *(const f32x4*)bfp_; bf1 = *(const f32x4*)(bfp_ + 4); } while (0)

__device__ __forceinline__ void phase_g1(const Params& P, LAS unsigned char* lds, int e) {
    LAS float* L = (LAS float*)lds;
    const int tid = otid(), lane = tid & 63, wave = tid >> 6, l15 = lane & 15, quad = lane >> 4;
    float* Sbuf = (float*)(P.ws + WS_S); float* decay = (float*)(P.ws + WS_DECAY);
    LAS bf16_t* KDB = (LAS bf16_t*)(lds + GB_KDB); LAS bf16_t* VT = (LAS bf16_t*)(lds + GB_VT);
    u32x4 k8, f8, q8 = (u32x4){0u, 0u, 0u, 0u}, vv[2]; f32x4 bf0, bf1;
    const int gstep = ogrid(), item0 = obid();
    if (item0 < 1024) GLA_LOAD(item0, false);
    for (int item = item0; item < 1024; item += gstep) {
        float kv[8], qv[8];
        gla_prolog<false>(L, k8, f8, q8, bf0, bf1, kv, qv);
#pragma unroll
        for (int j = 0; j < 8; ++j) {
            const float bv = L[GO_BT + (8 * wave + j) * LDT + lane], bl = L[GO_BT + (8 * wave + j) * LDT + 63];
            KDB[(8 * wave + j) * MLD + lane] = (bf16_t)f2bf(kv[j] * __expf(bl - bv));
        }
        stage_vT(lds, tid, vv);
        if (item + gstep < 1024) GLA_LOAD(item + gstep, false);
        if (tid < 64) decay[item * 64 + tid] = __expf(L[GO_BT + tid * LDT + 63]);
        __syncthreads();
        const int dk0 = 16 * (wave & 3);
        const bf16x8 bk0 = *(const LAS bf16x8*)(KDB + (dk0 + l15) * MLD + 8 * quad), bk1 = *(const LAS bf16x8*)(KDB + (dk0 + l15) * MLD + 32 + 8 * quad);
#pragma unroll
        for (int t = 0; t < 4; ++t) {
            const int dv0 = 16 * ((wave >> 2) * 4 + t);
            const bf16x8 a0 = *(const LAS bf16x8*)(VT + (dv0 + l15) * MLD + 8 * quad), a1 = *(const LAS bf16x8*)(VT + (dv0 + l15) * MLD + 32 + 8 * quad);
            f32x4 acc = (f32x4){0.f, 0.f, 0.f, 0.f};
            acc = __builtin_amdgcn_mfma_f32_16x16x32_bf16(a0, bk0, acc, 0, 0, 0);
            acc = __builtin_amdgcn_mfma_f32_16x16x32_bf16(a1, bk1, acc, 0, 0, 0);
            const int tp = (wave >> 2) * 4 + t;
            float* o = Sbuf + (size_t)item * 8192 + (32 * (tp >> 1) + 8 * quad + 4 * (tp & 1)) * 64 + dk0 + l15;
            o[0] = acc[0]; o[64] = acc[1]; o[128] = acc[2]; o[192] = acc[3];
        }
        __syncthreads();
    }
}

__device__ __forceinline__ void phase_g2(const Params& P) {
    float* Sbuf = (float*)(P.ws + WS_S); const float* decay = (const float*)(P.ws + WS_DECAY);
    for (int idx = obid() * NTHREADS + otid(); idx < 16 * 8192; idx += ogrid() * NTHREADS) {
        const int bh = idx >> 13, el = idx & 8191, b = bh >> 2, h = bh & 3, dk = el & 63;
        float run = 0.f;
        for (int n0 = 0; n0 < 64; n0 += 32) {
            float kvn[32], dc[32];
#pragma unroll
            for (int j = 0; j < 32; ++j) { const int item = ((b * 64 + n0 + j) << 2) + h; kvn[j] = Sbuf[(size_t)item * 8192 + el]; dc[j] = decay[item * 64 + dk]; }
#pragma unroll
            for (int j = 0; j < 32; ++j) { const int item = ((b * 64 + n0 + j) << 2) + h; Sbuf[(size_t)item * 8192 + el] = run; run = dc[j] * run + kvn[j]; }
        }
    }
}

__device__ __forceinline__ void phase_g3(const Params& P, LAS unsigned char* lds, int e) {
    LAS float* L = (LAS float*)lds;
    const int tid = otid(), lane = tid & 63, wave = tid >> 6, l15 = lane & 15, quad = lane >> 4;
    const float* Sbuf = (const float*)(P.ws + WS_S);
    const bf16_t* zb = (const bf16_t*)(P.ws + WS_HZ);
    bf16_t* mix = (bf16_t*)(P.ws + WS_MIX);
    LAS bf16_t* QDB = (LAS bf16_t*)(lds + GB_QDB); LAS bf16_t* KDB = (LAS bf16_t*)(lds + GB_KDB); LAS bf16_t* VT = (LAS bf16_t*)(lds + GB_VT); LAS bf16_t* STB = (LAS bf16_t*)(lds + GB_STB);
    LAS float* RED = (LAS float*)(lds + GB_RED);
    u32x4 k8, f8, q8, vv[2]; f32x4 bf0, bf1, sv[4];
    const int gstep = ogrid(), item0 = obid();
#define G3_LOADS(ITEM) do { _Pragma("unroll") for (int r_ = 0; r_ < 4; ++r_) sv[r_] = *(const f32x4*)(Sbuf + (size_t)(ITEM) * 8192 + 4 * (r_ * 512 + tid)); } while (0)
    if (item0 < 1024) { GLA_LOAD(item0, true); G3_LOADS(item0); }
    for (int item = item0; item < 1024; item += gstep) {
        const int h = item & 3, bn = item >> 2, b = bn >> 6, n = bn & 63;
        const int t0 = b * SEQ + n * 64;
        float kv[8], qv[8];
        gla_prolog<true>(L, k8, f8, q8, bf0, bf1, kv, qv);
        {
            float qd[8], kd[8];
#pragma unroll
            for (int j = 0; j < 8; ++j) {
                const float bv = L[GO_BT + (8 * wave + j) * LDT + lane];
                qd[j] = qv[j] * 0.125f * __expf(bv); kd[j] = kv[j] * __expf(-bv);
            }
            u32x4 wq, wk;
            wq.x = pk2(qd[0], qd[1]); wq.y = pk2(qd[2], qd[3]); wq.z = pk2(qd[4], qd[5]); wq.w = pk2(qd[6], qd[7]);
            wk.x = pk2(kd[0], kd[1]); wk.y = pk2(kd[2], kd[3]); wk.z = pk2(kd[4], kd[5]); wk.w = pk2(kd[6], kd[7]);
            *(LAS u32x4*)(QDB + lane * MLD + 8 * wave) = wq; *(LAS u32x4*)(KDB + lane * MLD + 8 * wave) = wk;
        }
        stage_vT(lds, tid, vv);
#pragma unroll
        for (int r = 0; r < 4; ++r) {
            const int c = r * 512 + tid, v = c >> 4, k4 = (c & 15) * 4;
            u32x2 w; w.x = pk2(sv[r][0], sv[r][1]); w.y = pk2(sv[r][2], sv[r][3]);
            *(LAS u32x2*)(STB + ((v & ~31) + pinv32(v & 31)) * MLD + k4) = w;
        }
        if (item + gstep < 1024) { GLA_LOAD(item + gstep, true); G3_LOADS(item + gstep); }
        __syncthreads();
        const int it = wave & 3, i0 = 16 * it, vh = wave >> 2;
        const bf16x8 bq0 = *(const LAS bf16x8*)(QDB + (i0 + l15) * MLD + 8 * quad), bq1 = *(const LAS bf16x8*)(QDB + (i0 + l15) * MLD + 32 + 8 * quad);
        f32x4 s[4];
#pragma unroll
        for (int jt = 0; jt < 4; ++jt) {
            const bf16x8 a0 = *(const LAS bf16x8*)(KDB + (16 * jt + l15) * MLD + 8 * quad), a1 = *(const LAS bf16x8*)(KDB + (16 * jt + l15) * MLD + 32 + 8 * quad);
            f32x4 z = (f32x4){0.f, 0.f, 0.f, 0.f};
            z = __builtin_amdgcn_mfma_f32_16x16x32_bf16(a0, bq0, z, 0, 0, 0);
            z = __builtin_amdgcn_mfma_f32_16x16x32_bf16(a1, bq1, z, 0, 0, 0);
#pragma unroll
            for (int r = 0; r < 4; ++r) z[r] = (16 * jt + 4 * quad + r <= i0 + l15) ? z[r] : 0.f;
            s[jt] = z;
            if (jt == 0 && n == 0 && it == 0) {
                const float* qk = (const float*)(P.ws + WS_QK0) + b * 512 + h * 64 + lane;
                const float c0v = wave_sum(qk[0] * qk[256]) * 0.125f;
                if (lane == 0) s[0][0] = c0v;
            }
        }
        bf16x8 pf[2];
#pragma unroll
        for (int jp = 0; jp < 2; ++jp) {
            u32x4 pw; pw.x = pk2(s[2 * jp][0], s[2 * jp][1]); pw.y = pk2(s[2 * jp][2], s[2 * jp][3]); pw.z = pk2(s[2 * jp + 1][0], s[2 * jp + 1][1]); pw.w = pk2(s[2 * jp + 1][2], s[2 * jp + 1][3]);
            pf[jp] = __builtin_bit_cast(bf16x8, pw);
        }
        f32x4 o[4]; float ss = 0.f;
#pragma unroll
        for (int t = 0; t < 4; ++t) {
            const int v0 = 16 * (vh * 4 + t);
            f32x4 acc = (f32x4){0.f, 0.f, 0.f, 0.f};
#pragma unroll
            for (int jp = 0; jp < 2; ++jp) {
                const LAS bf16_t* vp = VT + (v0 + l15) * MLD + 32 * jp + 4 * quad;
                const u32x2 va = *(const LAS u32x2*)vp, vb = *(const LAS u32x2*)(vp + 16);
                u32x4 vw; vw.x = va.x; vw.y = va.y; vw.z = vb.x; vw.w = vb.y;
                acc = __builtin_amdgcn_mfma_f32_16x16x32_bf16(__builtin_bit_cast(bf16x8, vw), pf[jp], acc, 0, 0, 0);
            }
            const bf16x8 s0 = *(const LAS bf16x8*)(STB + (v0 + l15) * MLD + 8 * quad), s1 = *(const LAS bf16x8*)(STB + (v0 + l15) * MLD + 32 + 8 * quad);
            acc = __builtin_amdgcn_mfma_f32_16x16x32_bf16(s0, bq0, acc, 0, 0, 0);
            acc = __builtin_amdgcn_mfma_f32_16x16x32_bf16(s1, bq1, acc, 0, 0, 0);
            o[t] = acc;
            ss += (acc[0] * acc[0] + acc[1] * acc[1]) + (acc[2] * acc[2] + acc[3] * acc[3]);
        }
        ss += __shfl_xor(ss, 16); ss += __shfl_xor(ss, 32);
        if (quad == 0) RED[vh * 64 + i0 + l15] = ss;
        __syncthreads();
        const float rs = rsqrtf((RED[i0 + l15] + RED[64 + i0 + l15]) * (1.0f / 128.0f) + EPS);
        const size_t tok = (size_t)(t0 + i0 + l15);
#pragma unroll
        for (int a = 0; a < 2; ++a) {
            const int v = 32 * (vh * 2 + a) + 8 * quad;
            const f32x4 ng0 = *(const f32x4*)(P.in[20] + e * 512 + h * 128 + v), ng1 = *(const f32x4*)(P.in[20] + e * 512 + h * 128 + v + 4);
            const u32x4 r4 = *(const u32x4*)(zb + tok * ZW + 1024 + h * 128 + v);
            u32x4 w;
            w.x = pk2(o[2 * a][0] * rs * ng0[0] * siluf_(bf_lo(r4.x)), o[2 * a][1] * rs * ng0[1] * siluf_(bf_hi(r4.x)));
            w.y = pk2(o[2 * a][2] * rs * ng0[2] * siluf_(bf_lo(r4.y)), o[2 * a][3] * rs * ng0[3] * siluf_(bf_hi(r4.y)));
            w.z = pk2(o[2 * a + 1][0] * rs * ng1[0] * siluf_(bf_lo(r4.z)), o[2 * a + 1][1] * rs * ng1[1] * siluf_(bf_hi(r4.z)));
            w.w = pk2(o[2 * a + 1][2] * rs * ng1[2] * siluf_(bf_lo(r4.w)), o[2 * a + 1][3] * rs * ng1[3] * siluf_(bf_hi(r4.w)));
            *(u32x4*)(mix + tok * D + h * 128 + v) = w;
        }
        __syncthreads();
    }
#undef G3_LOADS
}
#undef GLA_LOAD

constexpr int LO_XR = 0, LO_XCT = 4288;
constexpr int LB_XCB = 34560, LB_WAT = 43776, LB_WXT = 52992;
constexpr int LO_RT = 15552, LO_IT = 19904, LO_SEGA = 24256, LO_SEGH = 24768;

__device__ __forceinline__ void phase_l1(const Params& P, LAS unsigned char* lds, int e) {
    LAS float* L = (LAS float*)lds;
    const int tid = otid(), lane = tid & 63, wave = tid >> 6, l15 = lane & 15, quad = lane >> 4;
    const bf16_t* zb = (const bf16_t*)(P.ws + WS_HZ);
    float* HL = (float*)(P.ws + WS_HL); float* AC = (float*)(P.ws + WS_AC);
    LAS bf16_t* XCB = (LAS bf16_t*)(lds + LB_XCB); LAS bf16_t* WAT = (LAS bf16_t*)(lds + LB_WAT); LAS bf16_t* WXT = (LAS bf16_t*)(lds + LB_WXT);
    const int gstep = ogrid(), item0 = obid();
    const bool wconst = (gstep & 7) == 0;
    u32x4 xq0 = (u32x4){0u, 0u, 0u, 0u}, xq1 = (u32x4){0u, 0u, 0u, 0u};
#define L1_LOADXR(ITEM) do { const int g_ = (ITEM) & 7, bc_ = (ITEM) >> 3, c_ = bc_ & 63, t0_ = (bc_ >> 6) * SEQ + c_ * 64; \
        { const int row = tid >> 3, c8 = (tid & 7) * 8; xq0 = (u32x4){0u, 0u, 0u, 0u}; if (c_ > 0 || row >= 3) xq0 = *(const u32x4*)(zb + (size_t)(t0_ + row - 3) * ZW + 1536 + g_ * 64 + c8); } \
        if (tid < 24) { const int row = 64 + (tid >> 3), c8 = (tid & 7) * 8; xq1 = *(const u32x4*)(zb + (size_t)(t0_ + row - 3) * ZW + 1536 + g_ * 64 + c8); } } while (0)
    if (item0 < 2048) L1_LOADXR(item0);
    for (int item = item0; item < 2048; item += gstep) {
        const int g = item & 7, bc = item >> 3, b = bc >> 6, c = bc & 63;
        const int t0 = b * SEQ + c * 64, ch0 = g * 64;
        {
            const int row = tid >> 3, c8 = (tid & 7) * 8;
            f32x4 a, bq; a[0] = bf_lo(xq0.x); a[1] = bf_hi(xq0.x); a[2] = bf_lo(xq0.y); a[3] = bf_hi(xq0.y); bq[0] = bf_lo(xq0.z); bq[1] = bf_hi(xq0.z); bq[2] = bf_lo(xq0.w); bq[3] = bf_hi(xq0.w);
            *(LAS f32x4*)(L + LO_XR + row * 64 + c8) = a; *(LAS f32x4*)(L + LO_XR + row * 64 + c8 + 4) = bq;
            if (tid < 24) {
                const int row1 = 64 + (tid >> 3);
                a[0] = bf_lo(xq1.x); a[1] = bf_hi(xq1.x); a[2] = bf_lo(xq1.y); a[3] = bf_hi(xq1.y); bq[0] = bf_lo(xq1.z); bq[1] = bf_hi(xq1.z); bq[2] = bf_lo(xq1.w); bq[3] = bf_hi(xq1.w);
                *(LAS f32x4*)(L + LO_XR + row1 * 64 + c8) = a; *(LAS f32x4*)(L + LO_XR + row1 * 64 + c8 + 4) = bq;
            }
        }
        if (item + gstep < 2048) L1_LOADXR(item + gstep);
        if (!wconst || item == item0) {
            const f32x4* wa = (const f32x4*)(P.in[23] + (size_t)(e * 8 + g) * 4096); const f32x4* wx = (const f32x4*)(P.in[25] + (size_t)(e * 8 + g) * 4096);
#pragma unroll
            for (int r = 0; r < 2; ++r) {
                const int i4 = tid + 512 * r, i = i4 >> 4, j4 = (i4 & 15) * 4;
                const f32x4 va = wa[i4], vx = wx[i4];
#pragma unroll
                for (int q = 0; q < 4; ++q) { WAT[(j4 + q) * MLD + i] = (bf16_t)f2bf(va[q]); WXT[(j4 + q) * MLD + i] = (bf16_t)f2bf(vx[q]); }
            }
        }
        __syncthreads();
        {
            const float* cw = P.in[21] + e * 4 * 512 + ch0 + lane;
            const float w0 = cw[0], w1 = cw[512], w2 = cw[1024], w3 = cw[1536], cb = P.in[22][e * 512 + ch0 + lane];
            f32x4 a, bq;
#pragma unroll
            for (int j = 0; j < 8; ++j) {
                const int t = 8 * wave + j;
                const float v = L[LO_XR + (t + 0) * 64 + lane] * w0 + L[LO_XR + (t + 1) * 64 + lane] * w1 + L[LO_XR + (t + 2) * 64 + lane] * w2 + L[LO_XR + (t + 3) * 64 + lane] * w3 + cb;
                if (j < 4) a[j] = v; else bq[j - 4] = v;
                XCB[t * MLD + lane] = (bf16_t)f2bf(v);
            }
            *(LAS f32x4*)(L + LO_XCT + lane * LDT + 8 * wave) = a; *(LAS f32x4*)(L + LO_XCT + lane * LDT + 8 * wave + 4) = bq;
        }
        __syncthreads();
        {
            const int gate = wave >> 2, tt0 = 16 * (wave & 3);
            const LAS bf16_t* WT = gate ? WXT : WAT;
            const bf16x8 a0 = *(const LAS bf16x8*)(XCB + (tt0 + l15) * MLD + 8 * quad), a1 = *(const LAS bf16x8*)(XCB + (tt0 + l15) * MLD + 32 + 8 * quad);
            LAS float* O = L + (gate ? LO_IT : LO_RT);
            const float* bp = (gate ? P.in[26] : P.in[24]) + e * 512 + ch0;
#pragma unroll
            for (int jt = 0; jt < 4; ++jt) {
                const bf16x8 b0 = *(const LAS bf16x8*)(WT + (16 * jt + l15) * MLD + 8 * quad), b1 = *(const LAS bf16x8*)(WT + (16 * jt + l15) * MLD + 32 + 8 * quad);
                f32x4 acc = (f32x4){0.f, 0.f, 0.f, 0.f};
                acc = __builtin_amdgcn_mfma_f32_16x16x32_bf16(a0, b0, acc, 0, 0, 0);
                acc = __builtin_amdgcn_mfma_f32_16x16x32_bf16(a1, b1, acc, 0, 0, 0);
                const float bias = bp[16 * jt + l15];
                f32x4 w;
#pragma unroll
                for (int r = 0; r < 4; ++r) w[r] = sigmoidf_(acc[r] + bias);
                *(LAS f32x4*)(O + (16 * jt + l15) * LDT + tt0 + 4 * quad) = w;
            }
        }
        __syncthreads();
        {
            const float sp = softplusf_(-P.in[27][e * 512 + ch0 + lane]);
            const f32x4 r0 = *(const LAS f32x4*)(L + LO_RT + lane * LDT + 8 * wave), r1 = *(const LAS f32x4*)(L + LO_RT + lane * LDT + 8 * wave + 4);
            const f32x4 i0 = *(const LAS f32x4*)(L + LO_IT + lane * LDT + 8 * wave), i1 = *(const LAS f32x4*)(L + LO_IT + lane * LDT + 8 * wave + 4);
            const f32x4 x0 = *(const LAS f32x4*)(L + LO_XCT + lane * LDT + 8 * wave), x1 = *(const LAS f32x4*)(L + LO_XCT + lane * LDT + 8 * wave + 4);
            float Hl[8], Al[8]; float Hr = 0.f, Ar = 1.f;
#pragma unroll
            for (int j = 0; j < 8; ++j) {
                const float rr = j < 4 ? r0[j & 3] : r1[j & 3], ii = j < 4 ? i0[j & 3] : i1[j & 3], xx = j < 4 ? x0[j & 3] : x1[j & 3];
                const float la = -8.0f * rr * sp; const float a = __expf(la);
                const float u = __builtin_amdgcn_sqrtf(fmaxf(__builtin_fmaf(-a, a, 1.0f), 0.f)) * (ii * xx);
                Hr = a * Hr + u; Ar *= a; Hl[j] = Hr; Al[j] = Ar;
            }
            L[LO_SEGA + wave * 64 + lane] = Ar; L[LO_SEGH + wave * 64 + lane] = Hr;
            __syncthreads();
            float Hin = 0.f, Ain = 1.f;
            for (int s = 0; s < wave; ++s) { const float sa = L[LO_SEGA + s * 64 + lane], sh = L[LO_SEGH + s * 64 + lane]; Hin = sa * Hin + sh; Ain *= sa; }
#pragma unroll
            for (int j = 0; j < 8; ++j) {
                const size_t o = (size_t)(t0 + 8 * wave + j) * 512 + ch0 + lane;
                HL[o] = Hl[j] + Al[j] * Hin; AC[o] = Al[j] * Ain;
            }
        }
        __syncthreads();
    }
#undef L1_LOADXR
}

__device__ __forceinline__ void phase_l2(const Params& P) {
    const float* HL = (const float*)(P.ws + WS_HL); const float* AC = (const float*)(P.ws + WS_AC); float* carry = (float*)(P.ws + WS_CARRY);
    const int tid = otid(), lane = tid & 63, wave = tid >> 6;
    for (int seq = obid() * 8 + wave, sstep = ogrid() * 8; seq < 4 * 512; seq += sstep) {
        const int b = seq >> 9, ch = seq & 511;
        const size_t o = (size_t)(b * SEQ + lane * 64 + 63) * 512 + ch;
        float a = AC[o], h = HL[o];
#pragma unroll
        for (int d = 1; d < 64; d <<= 1) {
            const float ap = __shfl_up(a, d), hp = __shfl_up(h, d);
            if (lane >= d) { h = a * hp + h; a = ap * a; }
        }
        const float hin = __shfl_up(h, 1);
        carry[(b * 64 + lane) * 512 + ch] = lane == 0 ? 0.f : hin;
    }
}

__device__ __forceinline__ void phase_l3(const Params& P) {
    const float* HL = (const float*)(P.ws + WS_HL); const float* AC = (const float*)(P.ws + WS_AC); const float* carry = (const float*)(P.ws + WS_CARRY);
    const bf16_t* zb = (const bf16_t*)(P.ws + WS_HZ); bf16_t* mix = (bf16_t*)(P.ws + WS_MIX);
#pragma unroll 4
    for (int idx = obid() * NTHREADS + otid(); idx < T * 128; idx += ogrid() * NTHREADS) {
        const int tok = idx >> 7, ch = (idx & 127) * 4;
        const int b = tok >> 12, c = (tok & 4095) >> 6;
        const f32x4 hl = *(const f32x4*)(HL + (size_t)tok * 512 + ch), ac = *(const f32x4*)(AC + (size_t)tok * 512 + ch), cr = *(const f32x4*)(carry + (b * 64 + c) * 512 + ch);
        const u32x2 g2 = *(const u32x2*)(zb + (size_t)tok * ZW + 2048 + ch);
        const f32x4 hh = hl + ac * cr;
        u32x2 w; w.x = pk2(hh[0] * gelu_tanh(bf_lo(g2.x)), hh[1] * gelu_tanh(bf_hi(g2.x))); w.y = pk2(hh[2] * gelu_tanh(bf_lo(g2.y)), hh[3] * gelu_tanh(bf_hi(g2.y)));
        *(u32x2*)(mix + (size_t)tok * D + 512 + ch) = w;
    }
}

constexpr int AK_LD = 72, AV_LD = 264;
constexpr int AO_K = 0, AO_VT = 256 * AK_LD * 2, AO_BIAS = AO_VT + 64 * AV_LD * 2;

__device__ __forceinline__ void phase_attn(const Params& P, LAS unsigned char* lds, int o) {
    const int tid = otid(), lane = tid & 63, wave = tid >> 6, l15 = lane & 15, quad = lane >> 4;
    const bf16_t* qkv = (const bf16_t*)(P.ws + WS_HZ);
    bf16_t* mix = (bf16_t*)(P.ws + WS_MIX);
    LAS bf16_t* KS = (LAS bf16_t*)(lds + AO_K); LAS bf16_t* VT = (LAS bf16_t*)(lds + AO_VT); LAS float* BIAS = (LAS float*)(lds + AO_BIAS);
    const int gstep = ogrid(), item0 = obid();
    const bool hkconst = (gstep & 3) == 0;
    for (int item = item0; item < 512; item += gstep) {
        const int hk = item & 3, n = (item >> 2) & 31, b = item >> 7;
        const int tok0 = b * SEQ + n * 128 - 128;
#pragma unroll
        for (int r = 0; r < 4; ++r) {
            const int c = r * 512 + tid, key = c >> 3, dc = c & 7;
            u32x4 v = (u32x4){0u, 0u, 0u, 0u};
            if (n > 0 || key >= 128) v = *(const u32x4*)(qkv + (size_t)(tok0 + key) * QKVW + 1024 + hk * 64 + dc * 8);
            *(LAS u32x4*)(KS + key * AK_LD + dc * 8) = v;
        }
#pragma unroll
        for (int r = 0; r < 4; ++r) {
            const int c = r * 512 + tid, key = c & 255, dvc = c >> 8;
            u32x4 v = (u32x4){0u, 0u, 0u, 0u};
            if (n > 0 || key >= 128) v = *(const u32x4*)(qkv + (size_t)(tok0 + key) * QKVW + 1280 + hk * 64 + dvc * 8);
            LAS bf16_t* d = VT + (32 * (dvc >> 2) + 4 * (dvc & 3)) * AV_LD + key;
            d[0 * AV_LD] = (bf16_t)(v.x & 0xffffu); d[1 * AV_LD] = (bf16_t)(v.x >> 16); d[2 * AV_LD] = (bf16_t)(v.y & 0xffffu); d[3 * AV_LD] = (bf16_t)(v.y >> 16);
            d[16 * AV_LD] = (bf16_t)(v.z & 0xffffu); d[17 * AV_LD] = (bf16_t)(v.z >> 16); d[18 * AV_LD] = (bf16_t)(v.w & 0xffffu); d[19 * AV_LD] = (bf16_t)(v.w >> 16);
        }
        if (!hkconst || item == item0) {
            for (int idx = tid; idx < 4 * 192; idx += NTHREADS) {
                const int g = idx / 192, j = idx - g * 192, dist = (191 - j) - 32;
                float val = -1e30f;
                if (dist >= 0 && dist < 128) {
                    int bucket = dist;
                    if (dist >= 16) { int lg = 16 + (int)(__logf((float)dist * 0.0625f) / 2.0794415416798357f * 16.0f); bucket = lg < 31 ? lg : 31; }
                    val = P.in[2][bucket * 16 + hk * 4 + g] * 1.4426950408889634f;
                }
                BIAS[idx] = val;
            }
        }
        __syncthreads();
        const int g = wave >> 1, half = wave & 1, head = hk * 4 + g;
        const float sink2 = P.in[32][o * 16 + head] * 1.4426950408889634f;
        bf16x8 qn0, qn1;
        {
            const size_t qt = (size_t)(b * SEQ + n * 128 + 64 * half + l15);
            qn0 = *(const bf16x8*)(qkv + qt * QKVW + head * 64 + 8 * quad); qn1 = *(const bf16x8*)(qkv + qt * QKVW + head * 64 + 32 + 8 * quad);
        }
#pragma nounroll
        for (int rt = 0; rt < 4; ++rt) {
            const int q0 = 64 * half + 16 * rt, qi = q0 + l15;
            const size_t qtok = (size_t)(b * SEQ + n * 128 + qi);
            bf16x8 qf[2]; qf[0] = qn0; qf[1] = qn1;
            if (rt < 3) {
                const size_t qt = qtok + 16;
                qn0 = *(const bf16x8*)(qkv + qt * QKVW + head * 64 + 8 * quad); qn1 = *(const bf16x8*)(qkv + qt * QKVW + head * 64 + 32 + 8 * quad);
            }
            const int grp0 = q0 >> 5, tile0 = 2 * grp0;
            f32x4 s[10];
#pragma unroll
            for (int tt = 0; tt < 10; ++tt) {
                const int key = 16 * (tile0 + tt) + l15;
                const bf16x8 k0 = *(const LAS bf16x8*)(KS + key * AK_LD + 8 * quad), k1 = *(const LAS bf16x8*)(KS + key * AK_LD + 32 + 8 * quad);
                f32x4 z = (f32x4){0.f, 0.f, 0.f, 0.f};
                z = __builtin_amdgcn_mfma_f32_16x16x32_bf16(k0, qf[0], z, 0, 0, 0);
                z = __builtin_amdgcn_mfma_f32_16x16x32_bf16(k1, qf[1], z, 0, 0, 0);
                s[tt] = z;
            }
            float mx = sink2;
            {
                const LAS float* tb = BIAS + g * 192 + (31 - (q0 & 31) - l15 + 4 * quad);
#pragma unroll
                for (int tt = 0; tt < 10; ++tt)
#pragma unroll
                    for (int r = 0; r < 4; ++r) {
                        const float sc = __builtin_fmaf(s[tt][r], 0.125f * 1.4426950408889634f, tb[16 * tt + r]);
                        s[tt][r] = sc;
                    }
                if (n == 0) {
#pragma unroll
                    for (int tt = 0; tt < 10; ++tt)
#pragma unroll
                        for (int r = 0; r < 4; ++r) { const int kj = 16 * (tile0 + tt) + 4 * quad + r; if (kj < 128) s[tt][r] = -1e30f; }
                }
#pragma unroll
                for (int tt = 0; tt < 10; ++tt)
#pragma unroll
                    for (int r = 0; r < 4; ++r) mx = fmaxf(mx, s[tt][r]);
            }
            mx = fmaxf(mx, __shfl_xor(mx, 16)); mx = fmaxf(mx, __shfl_xor(mx, 32));
            float l = 0.f;
#pragma unroll
            for (int tt = 0; tt < 10; ++tt)
#pragma unroll
                for (int r = 0; r < 4; ++r) { const float p = __builtin_amdgcn_exp2f(s[tt][r] - mx); s[tt][r] = p; l += p; }
            l += __shfl_xor(l, 16); l += __shfl_xor(l, 32);
            l += __builtin_amdgcn_exp2f(sink2 - mx);
            f32x4 oacc[4];
#pragma unroll
            for (int t = 0; t < 4; ++t) oacc[t] = (f32x4){0.f, 0.f, 0.f, 0.f};
#pragma unroll
            for (int jp = 0; jp < 5; ++jp) {
                u32x4 pw; pw.x = pk2(s[2 * jp][0], s[2 * jp][1]); pw.y = pk2(s[2 * jp][2], s[2 * jp][3]); pw.z = pk2(s[2 * jp + 1][0], s[2 * jp + 1][1]); pw.w = pk2(s[2 * jp + 1][2], s[2 * jp + 1][3]);
                const bf16x8 pf = __builtin_bit_cast(bf16x8, pw);
                const int keybase = 32 * (grp0 + jp);
#pragma unroll
                for (int t = 0; t < 4; ++t) {
                    const LAS bf16_t* vp = VT + (16 * t + l15) * AV_LD + keybase + 4 * quad;
                    const u32x2 va = *(const LAS u32x2*)vp, vb = *(const LAS u32x2*)(vp + 16);
                    u32x4 vw; vw.x = va.x; vw.y = va.y; vw.z = vb.x; vw.w = vb.y;
                    oacc[t] = __builtin_amdgcn_mfma_f32_16x16x32_bf16(__builtin_bit_cast(bf16x8, vw), pf, oacc[t], 0, 0, 0);
                }
            }
            const float inv = 1.0f / l;
#pragma unroll
            for (int a = 0; a < 2; ++a) {
                u32x4 w; w.x = pk2(oacc[2 * a][0] * inv, oacc[2 * a][1] * inv); w.y = pk2(oacc[2 * a][2] * inv, oacc[2 * a][3] * inv);
                w.z = pk2(oacc[2 * a + 1][0] * inv, oacc[2 * a + 1][1] * inv); w.w = pk2(oacc[2 * a + 1][2] * inv, oacc[2 * a + 1][3] * inv);
                *(u32x4*)(mix + qtok * D + head * 64 + 32 * a + 8 * quad) = w;
            }
        }
        __syncthreads();
    }
}

__device__ __forceinline__ void phase_final(const Params& P) {
    const int tid_ = otid(); const int lane = tid_ & 63, wave = tid_ >> 6;
    const float* ssq = (const float*)(P.ws + WS_SSQ);
    const bf16_t* hi = (const bf16_t*)(P.ws + WS_MIX); const bf16_t* lo = (const bf16_t*)(P.ws + WS_HZ);
    for (int m = obid() * 8 + wave, mstep = ogrid() * 8; m < T; m += mstep) {
        const float s = pg8::row_scale(ssq, m);
        f32x4* xr = (f32x4*)(P.out + (size_t)m * D) + lane; const f32x4* gp = (const f32x4*)P.in[3] + lane;
        const u32x2* hp = (const u32x2*)(hi + (size_t)m * D) + lane; const u32x2* lp = (const u32x2*)(lo + (size_t)m * D) + lane;
#pragma unroll
        for (int j = 0; j < 4; ++j) {
            const u32x2 h2 = hp[64 * j], l2 = lp[64 * j]; const f32x4 g4 = gp[64 * j];
            f32x4 o; o[0] = (bf_lo(h2.x) + bf_lo(l2.x)) * s * g4[0]; o[1] = (bf_hi(h2.x) + bf_hi(l2.x)) * s * g4[1]; o[2] = (bf_lo(h2.y) + bf_lo(l2.y)) * s * g4[2]; o[3] = (bf_hi(h2.y) + bf_hi(l2.y)) * s * g4[3];
            xr[64 * j] = o;
        }
    }
}

#define XB_TMO      128
#define XB_XCNT(j)  (256  + 64 * (j))
#define XB_XSUB(j)  (1280 + 64 * (j))
#define XB_XGEN(j)  (2304 + 64 * (j))
#define XB_TOP      3328
#define XB_TOPGEN   3392
#define XCD_BAR_WORDS 3456
#define XB_SPIN_CAP (1u << 18)
__device__ __forceinline__ unsigned xb_ld(unsigned* p)              { return __hip_atomic_load(p, __ATOMIC_RELAXED, __HIP_MEMORY_SCOPE_AGENT); }
__device__ __forceinline__ unsigned xb_add(unsigned* p, unsigned v) { return __hip_atomic_fetch_add(p, v, __ATOMIC_RELAXED, __HIP_MEMORY_SCOPE_AGENT); }
__device__ __forceinline__ unsigned xb_xcc_id() { return (unsigned)__builtin_amdgcn_s_getreg((3 << 11) | 20) & 0xFu; }
#define XB_SPIN(cond, bar) do { unsigned _sp = 0; while (cond) { __builtin_amdgcn_s_sleep(1); \
    if ((++_sp & 255u) == 0u) { if (xb_ld(&(bar)[XB_TMO])) break; if (_sp > XB_SPIN_CAP) { atomicAdd(&(bar)[XB_TMO], 1u); break; } } } } while (0)
struct XcdBarrier { unsigned* bar; unsigned x; volatile LAS unsigned* st; };
__device__ __forceinline__ XcdBarrier xcd_barrier_post(unsigned* bar, volatile LAS unsigned* st) {
    XcdBarrier b; b.bar = bar; b.x = xb_xcc_id(); b.st = st;
    if (threadIdx.x == 0) (void)xb_add(&bar[XB_XCNT(b.x)], 1u);
    return b;
}
__device__ __forceinline__ void xcd_barrier_complete(unsigned* bar, unsigned x, unsigned& nloc, unsigned& nx) {
    const unsigned G = gridDim.x * gridDim.y * gridDim.z;
    unsigned sum, cnt, mine, sp = 0u;
    for (;;) {
        sum = 0u; cnt = 0u; mine = 0u;
#pragma unroll
        for (unsigned j = 0; j < 16; ++j) { const unsigned c = xb_ld(&bar[XB_XCNT(j)]); sum += c; cnt += (c > 0u) ? 1u : 0u; mine = (j == x) ? c : mine; }
        if (sum == G) break;
        __builtin_amdgcn_s_sleep(1);
        if ((++sp & 255u) == 0u) { if (xb_ld(&bar[XB_TMO])) break; if (sp > XB_SPIN_CAP) { atomicAdd(&bar[XB_TMO], 1u); break; } }
    }
    nloc = mine > 0u ? mine : 1u; nx = cnt > 0u ? cnt : 1u;
}
__device__ __forceinline__ void xcd_barrier(const XcdBarrier& b) {
    asm volatile("s_waitcnt vmcnt(0)" ::: "memory");
    __syncthreads();
    if (threadIdx.x == 0) {
        unsigned* bar = b.bar;
        __builtin_amdgcn_s_waitcnt(0);
        unsigned nloc = b.st[0], nx = b.st[1];
        if (nloc == 0u) { xcd_barrier_complete(bar, b.x, nloc, nx); b.st[0] = nloc; b.st[1] = nx; }
        const unsigned old = xb_add(&bar[XB_XSUB(b.x)], 1u);
        const unsigned gen = old / nloc;
        if (old + 1u == (gen + 1u) * nloc) {
            __builtin_amdgcn_fence(__ATOMIC_RELEASE, "agent");
            asm volatile("s_waitcnt vmcnt(0)" ::: "memory");
            const unsigned og = xb_add(&bar[XB_TOP], 1u);
            const unsigned tg = og / nx;
            if (og + 1u == (tg + 1u) * nx) xb_add(&bar[XB_TOPGEN], 1u);
            else XB_SPIN(xb_ld(&bar[XB_TOPGEN]) == tg, bar);
            __builtin_amdgcn_fence(__ATOMIC_ACQUIRE, "agent");
            xb_add(&bar[XB_XGEN(b.x)], 1u);
            asm volatile("s_waitcnt vmcnt(0)" ::: "memory");
        } else {
            XB_SPIN(xb_ld(&bar[XB_XGEN(b.x)]) == gen, bar);
            __builtin_amdgcn_fence(__ATOMIC_ACQUIRE, "agent");
            asm volatile("s_waitcnt vmcnt(0)" ::: "memory");
        }
    }
    __syncthreads();
}

__global__ void __launch_bounds__(NTHREADS, 2) mk_fwd(Params P_arg) {
    extern __shared__ __attribute__((aligned(16))) unsigned char lds_raw[];
    LAS unsigned char* lds = (LAS unsigned char*)lds_raw;
    cg::grid_group grid = cg::this_grid();
    volatile LAS unsigned* bar_st = (volatile LAS unsigned*)(lds + LDS_BYTES - 64);
    if (threadIdx.x == 0) { bar_st[0] = 0u; bar_st[1] = 0u; }
    __syncthreads();
    const XcdBarrier xbar = xcd_barrier_post((unsigned*)(P_arg.ws + WS_CTL), bar_st);
    for (int ph = P_arg.ph_lo; ph < P_arg.ph_hi; ++ph) {
        bool did = true;
        int nrep = 1;
        {
            const int s_ = (ph >= 1 && ph <= 40) ? (ph - 1) % 10 : -1, L_ = (ph - 1) / 10;
            if (PROBE_DUP == 1 && (s_ == 0)) nrep = 2;
            if (PROBE_DUP == 2 && ph == 0) nrep = 2;
            if (PROBE_DUP == 3 && (s_ == 3 || s_ == 5) && !(L_ & 1)) nrep = 2;
            if (PROBE_DUP == 4 && s_ == 3 && (L_ & 1)) nrep = 2;
            if (PROBE_DUP == 6 && s_ == 2) nrep = 2;
        }
#pragma nounroll
        for (int rep_ = 0; rep_ < nrep; ++rep_) {
        const __attribute__((address_space(4))) Params* Pk = (const __attribute__((address_space(4))) Params*)__builtin_amdgcn_kernarg_segment_ptr();
        asm volatile("" : "+s"(Pk));
        const Params& P = *(const Params*)Pk;
        unsigned char* ws = P.ws;
        float* ssq = (float*)(ws + WS_SSQ);
        bf16_t* XB = (bf16_t*)(ws + WS_XB); bf16_t* XBALT = (bf16_t*)(ws + WS_MIX); bf16_t* HZ = (bf16_t*)(ws + WS_HZ); bf16_t* MIX = (bf16_t*)(ws + WS_MIX);
        bf16_t* PP = (bf16_t*)(ws + WS_PP);
        bf16_t* XLO = (bf16_t*)P.out;
        if (ph == 0) phase_prepass(P, lds);
        else if (ph == 41) phase_final(P);
        else {
            const int L = (ph - 1) / 10, s = (ph - 1) % 10, even = !(L & 1), eo = L >> 1;
            if (s == 3) {
                if (even) { phase_g1(P, lds, eo); phase_l1(P, lds, eo); } else phase_attn(P, lds, eo);
            } else if (s == 4) {
                if (even) { phase_g2(P); phase_l2(P); } else did = false;
            } else if (s == 5) {
                if (even) { phase_g3(P, lds, eo); phase_l3(P); } else did = false;
            } else {
                const int ng = (s == 7) ? 2 : 1;
#pragma nounroll
                for (int gi = 0; gi < ng; ++gi) {
                    pg8::Epi E; E.mode = 0; E.ssq_in = nullptr; E.ssq_out = nullptr; E.xin = nullptr; E.hin = nullptr; E.lin = nullptr; E.lout = nullptr; E.xb = nullptr; E.ob = nullptr; E.ldo = 0; E.of = nullptr; E.bias = nullptr; E.alpha = 1.0f;
                    const bf16_t* A = XB; const bf16_t* Bt = nullptr; int N = 1024, K = 1024;
                    if (gi == 1) {
                        E.mode = 2; E.ob = PP; A = (const bf16_t*)(ws + WS_PB) + (size_t)L * T * 256; Bt = (const bf16_t*)(ws + WS_WPP) + (size_t)L * 1024 * 256; N = 1024; K = 256;
                    } else if (s == 0 || s == 7) {
                        const int w = (s == 7);
                        E.mode = 0; E.ssq_in = ssq + (size_t)((4 * L + (w ? 2 : 0)) & 1) * T * 16; E.ob = HZ; E.ldo = FF;
                        A = w ? XB : XBALT; Bt = (const bf16_t*)(ws + WS_WUP) + (size_t)(2 * L + w) * 5632 * 1024; N = 5632; K = 1024;
                    } else if (s == 1 || s == 8) {
                        const int w = (s == 8);
                        E.mode = (L == 0 && !w) ? 5 : 3; E.xin = P.in[0]; E.hin = w ? XB : XBALT; E.lin = XLO; E.lout = XLO; E.xb = XB; E.ssq_out = ssq + (size_t)((4 * L + (w ? 3 : 1)) & 1) * T * 16; E.alpha = 0.5f;
                        A = HZ; Bt = (const bf16_t*)(ws + WS_WDN) + (size_t)(2 * L + w) * 1024 * 2816; N = 1024; K = 2816;
                    } else if (s == 2) {
                        E.mode = 1; E.ssq_in = ssq + (size_t)((4 * L + 1) & 1) * T * 16; E.ob = HZ; A = XB; K = 1024;
                        if (even) { E.ldo = ZW; Bt = (const bf16_t*)(ws + WS_WIN) + (size_t)eo * 2816 * 1024; N = 2816; }
                        else { E.ldo = QKVW; E.bias = P.in[29] + eo * 1536; Bt = (const bf16_t*)(ws + WS_WQKV) + (size_t)eo * 1536 * 1024; N = 1536; }
                    } else if (s == 6) {
                        E.mode = 3; E.hin = XB; E.lin = XLO; E.lout = XLO; E.xb = XB; E.ssq_out = ssq + (size_t)((4 * L + 2) & 1) * T * 16; E.alpha = 1.0f;
                        E.bias = even ? nullptr : P.in[31] + eo * 1024;
                        A = MIX; Bt = even ? (const bf16_t*)(ws + WS_WOUT) + (size_t)eo * 1024 * 1024 : (const bf16_t*)(ws + WS_WO) + (size_t)eo * 1024 * 1024; N = 1024; K = 1024;
                    } else {
                        E.mode = 4; E.ssq_in = ssq + (size_t)((4 * L + 3) & 1) * T * 16; E.ssq_out = ssq + (size_t)((4 * L + 4) & 1) * T * 16; E.ob = PP; E.hin = XB; E.lin = XLO; E.lout = (L == 3) ? HZ : XLO; E.xb = XBALT;
                        A = XB; Bt = (const bf16_t*)(ws + WS_WPG) + (size_t)L * 1024 * 1024; N = 1024; K = 1024;
                    }
                    if (PROBE_DUP == 7 && s == 1) { pg8::Epi Ed = E; Ed.mode = 2; Ed.ob = PP; run_gemm(lds, A, Bt, N, K, Ed); }
                    if (PROBE_DUP == 8 && s == 6) { pg8::Epi Ed = E; Ed.mode = 2; Ed.ob = PP; run_gemm(lds, A, Bt, N, K, Ed); }
                    run_gemm(lds, A, Bt, N, K, E, (gi == 1 && gridDim.x == 256) ? 128 : 0);
                    if (s == 0) layer_small_cvt(P, L, gridDim.x == 256 ? 128 : 0);
                    if (s == 2 && even) first_token_qk(P, lds, L, gridDim.x == 256 ? 192 : 0);
                }
            }
        }
        }
        if (did && ph + 1 < P_arg.ph_hi) { if (ph == 99) grid.sync(); else xcd_barrier(xbar); if (PROBE_DUP == 5) xcd_barrier(xbar); }
    }
}

extern "C" void kernel_launch(void* const* d_in, const int* in_sizes, int n_in, void* d_out, int out_size, void* d_ws, size_t ws_size, hipStream_t stream) {
    static int grid = 0;
    if (grid == 0) {
        if (n_in != 33 || out_size != T * D || ws_size < WS_END) { fprintf(stderr, "kernel_launch: unexpected shapes (n_in %d out %d ws %zu need %zu)\n", n_in, out_size, ws_size, (size_t)WS_END); grid = -1; return; }
        int dev = 0, cus = 0, per_cu = 0;
        hipGetDevice(&dev); hipDeviceGetAttribute(&cus, hipDeviceAttributeMultiprocessorCount, dev);
        if (hipFuncSetAttribute((const void*)mk_fwd, hipFuncAttributeMaxDynamicSharedMemorySize, LDS_BYTES) != hipSuccess) { fprintf(stderr, "hipFuncSetAttribute failed\n"); grid = -1; return; }
        if (hipOccupancyMaxActiveBlocksPerMultiprocessor(&per_cu, (const void*)mk_fwd, NTHREADS, LDS_BYTES) != hipSuccess || per_cu < 1) per_cu = 1;
        (void)hipGetLastError();
        grid = cus * 1;
    }
    if (grid < 0) return;
    if (hipMemsetAsync((char*)d_ws + WS_CTL, 0, CTL_BYTES, stream) != hipSuccess) { fprintf(stderr, "memset failed\n"); return; }
    Params p{};
    for (int i = 0; i < 33; ++i) p.in[i] = (const float*)d_in[i];
    p.out = (float*)d_out; p.ws = (unsigned char*)d_ws;
#if COOP
    p.ph_lo = 0; p.ph_hi = 42;
    void* args[] = {&p};
    hipError_t e = hipLaunchCooperativeKernel((const void*)mk_fwd, dim3(grid), dim3(NTHREADS), args, LDS_BYTES, stream);
    if (e != hipSuccess) fprintf(stderr, "cooperative launch failed: %s (grid %d)\n", hipGetErrorString(e), grid);
#else
    for (int ph = 0; ph < 42; ++ph) {
        if (ph >= 1 && ph <= 40) { const int L = (ph - 1) / 10, s = (ph - 1) % 10; if ((L & 1) && (s == 4 || s == 5)) continue; }
        p.ph_lo = ph; p.ph_hi = ph + 1;
        hipLaunchKernelGGL(mk_fwd, dim3(grid), dim3(NTHREADS), LDS_BYTES, stream, p);
    }
#endif
}
```

```cpp
#include <hip/hip_runtime.h>
#include <hip/hip_cooperative_groups.h>
#include <cstdio>
namespace cg = cooperative_groups;

#ifndef COOP
#define COOP 1
#endif

#ifndef PROBE_DUP
#define PROBE_DUP 0
#endif
#define LAS __attribute__((address_space(3)))
typedef unsigned short bf16_t;
typedef short bf16x8 __attribute__((ext_vector_type(8)));
typedef float f32x4 __attribute__((ext_vector_type(4)));
typedef float f32x2 __attribute__((ext_vector_type(2)));
typedef unsigned u32x4 __attribute__((ext_vector_type(4)));
typedef unsigned u32x2 __attribute__((ext_vector_type(2)));

constexpr int T = 16384, D = 1024, FF = 2816, SEQ = 4096;
constexpr int ZW = 2816, QKVW = 1536;
constexpr float EPS = 1e-6f;
constexpr int NTHREADS = 512;
constexpr int LDS_BYTES = 147456;

constexpr size_t WS_SSQ = 0;
constexpr size_t WS_WUP = 2097152;
constexpr size_t WS_WDN = WS_WUP + 8ull * 5632 * 1024 * 2;
constexpr size_t WS_WIN = WS_WDN + 8ull * 1024 * 2816 * 2;
constexpr size_t WS_WOUT = WS_WIN + 2ull * 2816 * 1024 * 2;
constexpr size_t WS_WQKV = WS_WOUT + 2ull * 1024 * 1024 * 2;
constexpr size_t WS_WO = WS_WQKV + 2ull * 1536 * 1024 * 2;
constexpr size_t WS_WPG = WS_WO + 2ull * 1024 * 1024 * 2;
constexpr size_t WS_WPP = WS_WPG + 4ull * 1024 * 1024 * 2;
constexpr size_t WS_XB = WS_WPP + 4ull * 1024 * 256 * 2;
constexpr size_t WS_PB = WS_XB + (size_t)T * 1024 * 2;
constexpr size_t WS_HZ = WS_PB + 4ull * T * 256 * 2;
constexpr size_t WS_MIX = WS_HZ + (size_t)T * 2816 * 2;
constexpr size_t WS_SCR = WS_MIX + (size_t)T * 1024 * 2;
constexpr size_t WS_S = WS_SCR;
constexpr size_t WS_HL = WS_S + 1024ull * 8192 * 4;
constexpr size_t WS_AC = WS_HL + (size_t)T * 512 * 4;
constexpr size_t WS_CARRY = WS_AC + (size_t)T * 512 * 4;
constexpr size_t WS_DECAY = WS_CARRY + 4ull * 64 * 512 * 4;
constexpr size_t WS_CTL = WS_DECAY + 1024ull * 64 * 4;
constexpr size_t CTL_BYTES = 16384;
constexpr size_t WS_QK0 = WS_CTL + CTL_BYTES;
constexpr size_t WS_END = WS_QK0 + 8192;
constexpr size_t WS_PP = WS_SCR;

struct Params {
    const float* in[33];
    float* out;
    unsigned char* ws;
    int ph_lo, ph_hi;
};

__device__ __forceinline__ float bf_lo(unsigned w) { return __uint_as_float(w << 16); }
__device__ __forceinline__ float bf_hi(unsigned w) { return __uint_as_float(w & 0xffff0000u); }
__device__ __forceinline__ unsigned f2bf(float f) { unsigned u = __float_as_uint(f); return (u + 0x7fffu + ((u >> 16) & 1u)) >> 16; }
__device__ __forceinline__ unsigned pk2(float lo, float hi) { unsigned r; asm volatile("v_cvt_pk_bf16_f32 %0, %1, %2" : "=v"(r) : "v"(lo), "v"(hi)); return r; }
__device__ __forceinline__ float sigmoidf_(float x) { return __builtin_amdgcn_rcpf(1.0f + __expf(-x)); }
__device__ __forceinline__ float siluf_(float x) { return x * __builtin_amdgcn_rcpf(1.0f + __expf(-x)); }
__device__ __forceinline__ float gelu_tanh(float x) { const float y = 0.7978845608028654f * (x + 0.044715f * x * x * x); return x / (1.0f + __expf(-2.0f * y)); }
__device__ __forceinline__ float softplusf_(float x) { return fmaxf(x, 0.f) + log1pf(__expf(-fabsf(x))); }
__device__ __forceinline__ float logsigmoidf_(float x) { return fminf(x, 0.f) - __logf(1.0f + __expf(-fabsf(x))); }
__device__ __forceinline__ int otid() { int t = threadIdx.x; asm volatile("" : "+v"(t)); return t; }
__device__ __forceinline__ int obid() { int b = blockIdx.x; asm volatile("" : "+s"(b)); return b; }
__device__ __forceinline__ int ogrid() { int g = gridDim.x; asm volatile("" : "+s"(g)); return g; }
__device__ __forceinline__ int pinv32(int c) { return 16 * ((c >> 2) & 1) + 4 * (c >> 3) + (c & 3); }
__device__ __forceinline__ float wave_sum(float v) {
#pragma unroll
    for (int o = 1; o < 64; o <<= 1) v += __shfl_xor(v, o);
    return v;
}

namespace pg8 {
constexpr int BM = 256, BK = 64, HALF = 128, HTB = HALF * BK * 2, STAGE_BYTES = 8 * HTB, NXCD = 8, WGM = 8;
__host__ __device__ __forceinline__ int lds_byte(int r, int c) { const int st = (r >> 4) * 2 + (c >> 5), rr = r & 15, cc = c & 31, ob = rr * 64 + cc * 2; return st * 1024 + (ob ^ (((ob >> 9) & 1) << 5)); }
__host__ __device__ __forceinline__ void stage_rc(int b, int& R, int& C) { const int st = b / 1024, sb = b % 1024, swz = sb ^ (((sb >> 9) & 1) << 5); R = (st >> 1) * 16 + swz / 64; C = (st & 1) * 32 + (swz % 64) / 2; }
struct Unit { int pm, pn; };
struct Gemm { const bf16_t* A; const bf16_t* Bt; int M, N, K; };
struct StaticOrder {
    int nM, nN, nwg, G, c;
    __device__ void init(int M, int N, int G_, int c_) { nM = M / BM; nN = N / BM; nwg = nM * nN; G = G_; c = c_; }
    __device__ bool next(int i, Unit& u) const {
        const long L = (long)i * G + c; if (L >= nwg) return false;
        int wgid = (int)L; { const int q = nwg / NXCD, r = nwg % NXCD, xcd = wgid % NXCD, off = wgid / NXCD; wgid = (xcd < r ? xcd * (q + 1) : r * (q + 1) + (xcd - r) * q) + off; }
        const int nig = WGM * nN, gid = wgid / nig, fm = gid * WGM, gsz = (nM - fm) < WGM ? (nM - fm) : WGM;
        u.pm = fm + ((wgid % nig) % gsz); u.pn = (wgid % nig) / gsz; return true;
    }
};

__device__ __forceinline__ float row_scale(const float* part, int row) {
    const f32x4* p = (const f32x4*)(part + (size_t)row * 16);
    const f32x4 a = p[0], b = p[1], c = p[2], d = p[3];
    const float s = (((a[0] + a[1]) + (a[2] + a[3])) + ((b[0] + b[1]) + (b[2] + b[3]))) + (((c[0] + c[1]) + (c[2] + c[3])) + ((d[0] + d[1]) + (d[2] + d[3])));
    return rsqrtf(s * (1.0f / 1024.0f) + EPS);
}
struct Epi {
    int mode;
    const float* ssq_in;
    float* ssq_out;
    const float* xin;
    const bf16_t* hin; const bf16_t* lin; bf16_t* xb; bf16_t* lout;
    bf16_t* ob; int ldo;
    float* of;
    const float* bias;
    float alpha;
    __device__ __forceinline__ void scales2(const Unit& u, int wr, int fr, int fq, float& sA, float& sB) const {
        const int rowA = u.pm * BM + wr * 64 + fq * 16 + fr;
        const f32x4* pa = (const f32x4*)(ssq_in + (size_t)rowA * 16); const f32x4* pb = (const f32x4*)(ssq_in + (size_t)(rowA + HALF) * 16);
        const f32x4 a0 = pa[0], a1 = pa[1], a2 = pa[2], a3 = pa[3], b0 = pb[0], b1 = pb[1], b2 = pb[2], b3 = pb[3];
        const float ta = (((a0[0] + a0[1]) + (a0[2] + a0[3])) + ((a1[0] + a1[1]) + (a1[2] + a1[3]))) + (((a2[0] + a2[1]) + (a2[2] + a2[3])) + ((a3[0] + a3[1]) + (a3[2] + a3[3])));
        const float tb = (((b0[0] + b0[1]) + (b0[2] + b0[3])) + ((b1[0] + b1[1]) + (b1[2] + b1[3]))) + (((b2[0] + b2[1]) + (b2[2] + b2[3])) + ((b3[0] + b3[1]) + (b3[2] + b3[3])));
        sA = rsqrtf(ta * (1.0f / 1024.0f) + EPS); sB = rsqrtf(tb * (1.0f / 1024.0f) + EPS);
    }
    template <int mode> __device__ __forceinline__ void run(const f32x4 (&acc)[2][2][4][2], const Unit& u, int wr, int wc, int fr, int fq, const LAS float* sc) const {
        const int row0 = u.pm * BM + wr * 64 + fr;
        if (mode == 0) {
            const int col0 = u.pn * HALF + wc * 32 + 8 * fq;
#pragma unroll
            for (int ai = 0; ai < 2; ++ai)
#pragma unroll
                for (int m = 0; m < 4; ++m) {
                    const int row = row0 + ai * HALF + m * 16;
                    const float s = sc[ai * HALF + wr * 64 + m * 16 + fr];
                    const f32x4 g0 = acc[ai][0][m][0] * s, u0 = acc[ai][1][m][0] * s, g1 = acc[ai][0][m][1] * s, u1 = acc[ai][1][m][1] * s;
                    u32x4 w;
                    w.x = pk2(siluf_(g0[0]) * u0[0], siluf_(g0[1]) * u0[1]); w.y = pk2(siluf_(g0[2]) * u0[2], siluf_(g0[3]) * u0[3]);
                    w.z = pk2(siluf_(g1[0]) * u1[0], siluf_(g1[1]) * u1[1]); w.w = pk2(siluf_(g1[2]) * u1[2], siluf_(g1[3]) * u1[3]);
                    *(u32x4*)(ob + (size_t)row * FF + col0) = w;
                }
        } else if (mode == 1) {
            const int col0 = u.pn * BM + wc * 32 + 8 * fq;
            f32x4 bv[2][2];
#pragma unroll
            for (int bj = 0; bj < 2; ++bj)
#pragma unroll
                for (int n = 0; n < 2; ++n) bv[bj][n] = bias ? *(const f32x4*)(bias + col0 + bj * HALF + 4 * n) : (f32x4){0.f, 0.f, 0.f, 0.f};
#pragma unroll
            for (int ai = 0; ai < 2; ++ai)
#pragma unroll
                for (int m = 0; m < 4; ++m) {
                    const int row = row0 + ai * HALF + m * 16;
                    const float s = sc[ai * HALF + wr * 64 + m * 16 + fr];
                    bf16_t* rowp = ob + (size_t)row * ldo + col0;
#pragma unroll
                    for (int bj = 0; bj < 2; ++bj) {
                        const f32x4 v0 = acc[ai][bj][m][0] * s + bv[bj][0], v1 = acc[ai][bj][m][1] * s + bv[bj][1];
                        u32x4 w; w.x = pk2(v0[0], v0[1]); w.y = pk2(v0[2], v0[3]); w.z = pk2(v1[0], v1[1]); w.w = pk2(v1[2], v1[3]);
                        *(u32x4*)(rowp + bj * HALF) = w;
                    }
                }
        } else if (mode == 2) {
            const int col0 = u.pn * BM + wc * 32 + 8 * fq;
#pragma unroll
            for (int ai = 0; ai < 2; ++ai)
#pragma unroll
                for (int m = 0; m < 4; ++m) {
                    bf16_t* rowp = ob + (size_t)(row0 + ai * HALF + m * 16) * D + col0;
#pragma unroll
                    for (int bj = 0; bj < 2; ++bj) {
                        const f32x4 v0 = acc[ai][bj][m][0], v1 = acc[ai][bj][m][1];
                        u32x4 w; w.x = pk2(v0[0], v0[1]); w.y = pk2(v0[2], v0[3]); w.z = pk2(v1[0], v1[1]); w.w = pk2(v1[2], v1[3]);
                        *(u32x4*)(rowp + bj * HALF) = w;
                    }
                }
        } else {
            const int col0 = u.pn * BM + wc * 32 + 8 * fq;
            float sA = 1.f, sB = 1.f;
            if (mode == 4) scales2(u, wr, fr, fq, sA, sB);
            f32x4 bvv[4];
#pragma unroll
            for (int q = 0; q < 4; ++q) bvv[q] = (mode != 4 && bias) ? *(const f32x4*)(bias + col0 + (q >> 1) * HALF + (q & 1) * 4) : (f32x4){0.f, 0.f, 0.f, 0.f};
            f32x4 xi[2][4]; u32x4 pq[2][2]; u32x4 xh[2][2], xl[2][2];
            {
                const size_t off = (size_t)row0 * D + col0;
#pragma unroll
                for (int bj = 0; bj < 2; ++bj) {
                    const size_t o = off + bj * HALF;
                    if (mode == 5) { xi[0][2 * bj] = *(const f32x4*)(xin + o); xi[0][2 * bj + 1] = *(const f32x4*)(xin + o + 4); }
                    else { xh[0][bj] = *(const u32x4*)(hin + o); xl[0][bj] = *(const u32x4*)(lin + o); }
                    if (mode == 4) pq[0][bj] = *(const u32x4*)(ob + o);
                }
            }
#pragma unroll
            for (int g = 0; g < 8; ++g) {
                const int ai = g >> 2, m = g & 3, cb = g & 1, nb = cb ^ 1;
                const int row = row0 + ai * HALF + m * 16;
                const size_t off = (size_t)row * D + col0;
                if (g < 7) {
                    const size_t offn = (size_t)(row0 + ((g + 1) >> 2) * HALF + ((g + 1) & 3) * 16) * D + col0;
#pragma unroll
                    for (int bj = 0; bj < 2; ++bj) {
                        const size_t o = offn + bj * HALF;
                        if (mode == 5) { xi[nb][2 * bj] = *(const f32x4*)(xin + o); xi[nb][2 * bj + 1] = *(const f32x4*)(xin + o + 4); }
                        else { xh[nb][bj] = *(const u32x4*)(hin + o); xl[nb][bj] = *(const u32x4*)(lin + o); }
                        if (mode == 4) pq[nb][bj] = *(const u32x4*)(ob + o);
                    }
                }
                float s = 1.f;
                if (mode == 4) s = __shfl(ai ? sB : sA, m * 16 + fr);
                float ss = 0.f;
#pragma unroll
                for (int bj = 0; bj < 2; ++bj) {
                    u32x4 wh, wl;
#pragma unroll
                    for (int n = 0; n < 2; ++n) {
                        const int q = 2 * bj + n;
                        const unsigned h0 = n ? xh[cb][bj].z : xh[cb][bj].x, h1 = n ? xh[cb][bj].w : xh[cb][bj].y, l0 = n ? xl[cb][bj].z : xl[cb][bj].x, l1 = n ? xl[cb][bj].w : xl[cb][bj].y;
                        f32x4 xo;
                        if (mode == 5) xo = xi[cb][q];
                        else { xo[0] = bf_lo(h0) + bf_lo(l0); xo[1] = bf_hi(h0) + bf_hi(l0); xo[2] = bf_lo(h1) + bf_lo(l1); xo[3] = bf_hi(h1) + bf_hi(l1); }
                        f32x4 v;
                        if (mode != 4) v = xo + acc[ai][bj][m][n] * alpha + bvv[q];
                        else {
                            const f32x4 a = acc[ai][bj][m][n] * s;
                            const unsigned p0 = n ? pq[cb][bj].z : pq[cb][bj].x, p1 = n ? pq[cb][bj].w : pq[cb][bj].y;
                            v[0] = xo[0] + sigmoidf_(a[0]) * bf_lo(p0); v[1] = xo[1] + sigmoidf_(a[1]) * bf_hi(p0);
                            v[2] = xo[2] + sigmoidf_(a[2]) * bf_lo(p1); v[3] = xo[3] + sigmoidf_(a[3]) * bf_hi(p1);
                        }
                        const unsigned w0 = pk2(v[0], v[1]), w1 = pk2(v[2], v[3]);
                        const unsigned m0 = pk2(v[0] - bf_lo(w0), v[1] - bf_hi(w0)), m1 = pk2(v[2] - bf_lo(w1), v[3] - bf_hi(w1));
                        if (n == 0) { wh.x = w0; wh.y = w1; wl.x = m0; wl.y = m1; } else { wh.z = w0; wh.w = w1; wl.z = m0; wl.w = m1; }
                        ss += (v[0] * v[0] + v[1] * v[1]) + (v[2] * v[2] + v[3] * v[3]);
                    }
                    *(u32x4*)(xb + off + bj * HALF) = wh;
                    *(u32x4*)(lout + off + bj * HALF) = wl;
                }
                ss += __shfl_xor(ss, 16); ss += __shfl_xor(ss, 32);
                if (fq == 0) ssq_out[(size_t)row * 16 + u.pn * 4 + wc] = ss;
            }
        }
    }
};

template <int MODE, class EpiT, class Sched>
__device__ __forceinline__ void gemm_phase(LAS unsigned char* lds, const Gemm g, const Sched& S, const EpiT& E) {
    const int tid = otid(), wid = __builtin_amdgcn_readfirstlane(tid >> 6), lane = tid & 63, wr = wid >> 2, wc = wid & 3, fr = lane & 15, fq = lane >> 4;
    const int K = g.K, nt = K / BK;
    unsigned voffA[2], voffB[2];
#pragma unroll
    for (int i = 0; i < 2; ++i) { int R, C; stage_rc(tid * 16 + i * 8192, R, C); voffA[i] = (unsigned)(R * K + C) * 2u; voffB[i] = (unsigned)(R * K + C) * 2u; }
    const size_t kstep = (size_t)(BK * 2);
    const size_t hstep = (size_t)HALF * K * 2;
    const size_t tstep = 2 * hstep;
    const unsigned ldsw = (unsigned)wid * 1024u;
    const int aoff = lds_byte(wr * 64 + fr, fq * 8), boff = lds_byte(wc * 32 + fr, fq * 8);
#define PG8_SA(b, h) (((b) * 2 + (h)) * HTB)
#define PG8_SB(b, h) ((4 + (b) * 2 + (h)) * HTB)
#define PG8_STAGE(bufoff, gbase, voff) do { _Pragma("unroll") for (int _i = 0; _i < 2; ++_i) \
        __builtin_amdgcn_global_load_lds((const unsigned*)((const char*)(gbase) + (voff)[_i]), (LAS unsigned*)(lds + (bufoff) + ldsw + _i * 8192), 16, 0, 0); } while (0)
#define PG8_LDA(dst, b, h) do { _Pragma("unroll") for (int m = 0; m < 4; ++m) _Pragma("unroll") for (int k = 0; k < 2; ++k) dst[m][k] = *(const LAS bf16x8*)(lds + PG8_SA(b, h) + aoff + m * 2048 + k * 1024); } while (0)
#define PG8_LDB(dst, b, h) do { _Pragma("unroll") for (int n = 0; n < 2; ++n) _Pragma("unroll") for (int k = 0; k < 2; ++k) dst[n][k] = *(const LAS bf16x8*)(lds + PG8_SB(b, h) + boff + n * 2048 + k * 1024); } while (0)
#define PG8_MMA(ai, bj, At, Bt) do { __builtin_amdgcn_s_setprio(1); _Pragma("unroll") for (int m = 0; m < 4; ++m) _Pragma("unroll") for (int n = 0; n < 2; ++n) _Pragma("unroll") for (int k = 0; k < 2; ++k) \
        acc[ai][bj][m][n] = __builtin_amdgcn_mfma_f32_16x16x32_bf16(Bt[n][k], At[m][k], acc[ai][bj][m][n], 0, 0, 0); __builtin_amdgcn_s_setprio(0); } while (0)
#define PG8_WAIT_V(n) asm volatile("s_waitcnt vmcnt(" #n ")" ::: "memory")
#define PG8_WAIT_L(n) asm volatile("s_waitcnt lgkmcnt(" #n ")" ::: "memory")
#define PG8_BAR __builtin_amdgcn_s_barrier()
#define PG8_SCHED __builtin_amdgcn_sched_barrier(0)
    Unit cur, nxt; int ui = 0;
    if (!S.next(0, cur)) return;
    LAS float* SC = (LAS float*)(lds + STAGE_BYTES);
    if (MODE <= 1) {
        f32x4 pa[6], pb[6]; bool ok[6];
#pragma unroll
        for (int i = 0; i < 6; ++i) {
            Unit uu; ok[i] = S.next(i, uu);
            const int row = (ok[i] ? uu.pm : cur.pm) * BM + (tid >> 1);
            const f32x4* p = (const f32x4*)(E.ssq_in + (size_t)row * 16) + (tid & 1) * 2;
            pa[i] = p[0]; pb[i] = p[1];
        }
#pragma unroll
        for (int i = 0; i < 6; ++i) {
            float s = ((pa[i][0] + pa[i][1]) + (pa[i][2] + pa[i][3])) + ((pb[i][0] + pb[i][1]) + (pb[i][2] + pb[i][3]));
            s += __shfl_xor(s, 1);
            if (!(tid & 1)) SC[i * 256 + (tid >> 1)] = rsqrtf(s * (1.0f / 1024.0f) + EPS);
        }
        __syncthreads();
    }
    f32x4 acc[2][2][4][2];
#pragma unroll
    for (int a = 0; a < 2; ++a)
#pragma unroll
        for (int b = 0; b < 2; ++b)
#pragma unroll
            for (int m = 0; m < 4; ++m)
#pragma unroll
                for (int n = 0; n < 2; ++n) acc[a][b][m][n] = (f32x4){0.f, 0.f, 0.f, 0.f};
    bf16x8 At[4][2], B0[2][2], B1[2][2];
    const char* cA = (const char*)g.A + (size_t)cur.pm * tstep; const char* cB = (const char*)g.Bt + (size_t)cur.pn * tstep;
    PG8_STAGE(PG8_SB(0, 0), cB, voffB); PG8_STAGE(PG8_SA(0, 0), cA, voffA); PG8_STAGE(PG8_SB(0, 1), cB + hstep, voffB); PG8_STAGE(PG8_SA(0, 1), cA + hstep, voffA);
    if (wr == 1) PG8_BAR;
    PG8_WAIT_V(4); PG8_BAR;
    PG8_STAGE(PG8_SB(1, 0), cB + kstep, voffB); PG8_STAGE(PG8_SA(1, 0), cA + kstep, voffA); PG8_STAGE(PG8_SB(1, 1), cB + hstep + kstep, voffB);
    PG8_WAIT_V(6); PG8_BAR;
    for (;;) {
        const bool has_next = S.next(ui + 1, nxt);
        const char* nA = has_next ? (const char*)g.A + (size_t)nxt.pm * tstep : cA; const char* nB = has_next ? (const char*)g.Bt + (size_t)nxt.pn * tstep : cB;
        for (int t = 0; t < nt; t += 2) {
            const bool last = (t == nt - 2);
            const char* a1 = cA + (size_t)(t + 1) * kstep;
            const char* a2 = last ? nA : cA + (size_t)(t + 2) * kstep; const char* b2 = last ? nB : cB + (size_t)(t + 2) * kstep;
            const char* a3 = a2 + kstep; const char* b3 = b2 + kstep;
            PG8_LDB(B0, 0, 0); PG8_SCHED; PG8_LDA(At, 0, 0); PG8_STAGE(PG8_SA(1, 1), a1 + hstep, voffA);
            PG8_WAIT_L(8); PG8_BAR; PG8_WAIT_L(0); PG8_MMA(0, 0, At, B0); PG8_BAR; PG8_SCHED;
            PG8_LDB(B1, 0, 1); PG8_STAGE(PG8_SB(0, 0), b2, voffB);
            PG8_BAR; PG8_WAIT_L(0); PG8_MMA(0, 1, At, B1); PG8_BAR;
            PG8_LDA(At, 0, 1); PG8_STAGE(PG8_SA(0, 0), a2, voffA);
            PG8_BAR; PG8_WAIT_L(0); PG8_MMA(1, 0, At, B0); PG8_BAR; PG8_SCHED;
            PG8_STAGE(PG8_SB(0, 1), b2 + hstep, voffB);
            PG8_WAIT_V(6); PG8_BAR; PG8_MMA(1, 1, At, B1); PG8_BAR;
            PG8_LDB(B0, 1, 0); PG8_SCHED; PG8_LDA(At, 1, 0); PG8_STAGE(PG8_SA(0, 1), a2 + hstep, voffA);
            PG8_WAIT_L(8); PG8_BAR; PG8_WAIT_L(0); PG8_MMA(0, 0, At, B0); PG8_BAR; PG8_SCHED;
            PG8_LDB(B1, 1, 1); PG8_STAGE(PG8_SB(1, 0), b3, voffB);
            PG8_BAR; PG8_WAIT_L(0); PG8_MMA(0, 1, At, B1); PG8_BAR;
            PG8_LDA(At, 1, 1); PG8_STAGE(PG8_SA(1, 0), a3, voffA);
            PG8_BAR; PG8_WAIT_L(0); PG8_MMA(1, 0, At, B0); PG8_BAR; PG8_SCHED;
            PG8_STAGE(PG8_SB(1, 1), b3 + hstep, voffB);
            PG8_WAIT_V(6); PG8_BAR; PG8_MMA(1, 1, At, B1); PG8_BAR;
        }
        E.template run<MODE>(acc, cur, wr, wc, fr, fq, SC + ui * 256);
        if (!has_next) break;
#pragma unroll
        for (int a = 0; a < 2; ++a)
#pragma unroll
            for (int b = 0; b < 2; ++b)
#pragma unroll
                for (int m = 0; m < 4; ++m)
#pragma unroll
                    for (int n = 0; n < 2; ++n) acc[a][b][m][n] = (f32x4){0.f, 0.f, 0.f, 0.f};
        cur = nxt; cA = nA; cB = nB; ++ui;
    }
    PG8_WAIT_V(0);
    if (wr == 0) PG8_BAR;
    PG8_BAR;
#undef PG8_SA
#undef PG8_SB
#undef PG8_STAGE
#undef PG8_LDA
#undef PG8_LDB
#undef PG8_MMA
#undef PG8_WAIT_V
#undef PG8_WAIT_L
#undef PG8_BAR
#undef PG8_SCHED
}
}

__device__ __forceinline__ void run_gemm(LAS unsigned char* lds, const bf16_t* A, const bf16_t* Bt, int N, int K, const pg8::Epi& E, int c0 = 0) {
    const int G_ = ogrid() - c0, c_ = obid() - c0;
    if (c_ < 0) return;
    pg8::Gemm g{A, Bt, T, N, K}; pg8::StaticOrder S; S.init(T, N, G_, c_);
    switch (E.mode) {
    case 0: pg8::gemm_phase<0, pg8::Epi, pg8::StaticOrder>(lds, g, S, E); break;
    case 1: pg8::gemm_phase<1, pg8::Epi, pg8::StaticOrder>(lds, g, S, E); break;
    case 2: pg8::gemm_phase<2, pg8::Epi, pg8::StaticOrder>(lds, g, S, E); break;
    case 3: pg8::gemm_phase<3, pg8::Epi, pg8::StaticOrder>(lds, g, S, E); break;
    case 4: pg8::gemm_phase<4, pg8::Epi, pg8::StaticOrder>(lds, g, S, E); break;
    default: pg8::gemm_phase<5, pg8::Epi, pg8::StaticOrder>(lds, g, S, E); break;
    }
}

struct CvtJob { const float* W; const float* gain; bf16_t* dst; int K, ldw, col0, ncols, mode; };

__device__ __forceinline__ CvtJob get_job(const Params& P, int j) {
    CvtJob J; J.gain = nullptr; J.col0 = 0; J.mode = 0;
    unsigned char* ws = P.ws;
    if (j < 16) {
        const int f = j >> 1, part = j & 1, L = f >> 1, w = f & 1;
        const float* src = w ? (part ? P.in[11] : P.in[10]) : (part ? P.in[6] : P.in[5]);
        J.W = src + (size_t)L * 1024 * 2816; J.gain = (w ? P.in[9] : P.in[4]) + L * 1024;
        J.dst = (bf16_t*)(ws + WS_WUP) + (size_t)f * 5632 * 1024 + (size_t)part * 128 * 1024;
        J.K = 1024; J.ldw = 2816; J.ncols = 2816; J.mode = 1;
    } else if (j < 24) {
        const int f = j - 16, L = f >> 1, w = f & 1;
        J.W = (w ? P.in[12] : P.in[7]) + (size_t)L * 2816 * 1024;
        J.dst = (bf16_t*)(ws + WS_WDN) + (size_t)f * 1024 * 2816;
        J.K = 2816; J.ldw = 1024; J.ncols = 1024;
    } else if (j < 28) {
        const int e = (j - 24) >> 1, part = (j - 24) & 1;
        J.W = P.in[16] + (size_t)e * 1024 * 2576; J.gain = P.in[8] + (2 * e) * 1024;
        J.dst = (bf16_t*)(ws + WS_WIN) + (size_t)e * 2816 * 1024 + (part ? (size_t)1536 * 1024 : 0);
        J.K = 1024; J.ldw = 2576; J.col0 = part ? 1552 : 0; J.ncols = part ? 1024 : 1536;
    } else if (j < 30) {
        const int e = j - 28;
        J.W = P.in[17] + (size_t)e * 1024 * 1024; J.dst = (bf16_t*)(ws + WS_WOUT) + (size_t)e * 1024 * 1024;
        J.K = 1024; J.ldw = 1024; J.ncols = 1024;
    } else if (j < 32) {
        const int o = j - 30;
        J.W = P.in[28] + (size_t)o * 1024 * 1536; J.gain = P.in[8] + (2 * o + 1) * 1024;
        J.dst = (bf16_t*)(ws + WS_WQKV) + (size_t)o * 1536 * 1024;
        J.K = 1024; J.ldw = 1536; J.ncols = 1536;
    } else if (j < 34) {
        const int o = j - 32;
        J.W = P.in[30] + (size_t)o * 1024 * 1024; J.dst = (bf16_t*)(ws + WS_WO) + (size_t)o * 1024 * 1024;
        J.K = 1024; J.ldw = 1024; J.ncols = 1024;
    } else if (j < 38) {
        const int L = j - 34;
        J.W = P.in[15] + (size_t)L * 1024 * 1024; J.gain = P.in[13] + L * 1024;
        J.dst = (bf16_t*)(ws + WS_WPG) + (size_t)L * 1024 * 1024;
        J.K = 1024; J.ldw = 1024; J.ncols = 1024;
    } else {
        const int L = j - 38;
        J.W = P.in[14] + (size_t)L * 256 * 1024; J.dst = (bf16_t*)(ws + WS_WPP) + (size_t)L * 1024 * 256;
        J.K = 256; J.ldw = 1024; J.ncols = 1024;
    }
    return J;
}

__device__ __forceinline__ void cvt_item64(const CvtJob& J, int item, LAS float* scr, int lane) {
    const int nblk = J.ncols / 64, kb = item / nblk, nb = item - kb * nblk, k0 = 64 * kb, n0 = 64 * nb;
    const int r4 = lane >> 4, c4 = (lane & 15) * 4;
    f32x4 w[16];
#pragma unroll
    for (int i = 0; i < 16; ++i) w[i] = *(const f32x4*)(J.W + (size_t)(k0 + 4 * i + r4) * J.ldw + J.col0 + n0 + c4);
    if (J.gain) {
#pragma unroll
        for (int i = 0; i < 16; ++i) w[i] = w[i] * J.gain[k0 + 4 * i + r4];
    }
#pragma unroll
    for (int i = 0; i < 16; ++i) { LAS float* d = scr + (4 * i + r4) * 65 + c4; d[0] = w[i][0]; d[1] = w[i][1]; d[2] = w[i][2]; d[3] = w[i][3]; }
    asm volatile("s_waitcnt lgkmcnt(0)" ::: "memory");
    const int c = lane & 7;
#pragma unroll
    for (int j = 0; j < 8; ++j) {
        const int n = (lane >> 3) + 8 * j; const LAS float* s = scr + (8 * c) * 65 + n;
        u32x4 o; o.x = pk2(s[0 * 65], s[1 * 65]); o.y = pk2(s[2 * 65], s[3 * 65]); o.z = pk2(s[4 * 65], s[5 * 65]); o.w = pk2(s[6 * 65], s[7 * 65]);
        const int nn = n0 + n; const int row_ = J.mode ? ((nn >> 7) * 256 + (nn & 127)) : nn;
        const int row = (row_ & ~31) + pinv32(row_ & 31);
        *(u32x4*)(J.dst + (size_t)row * J.K + k0 + 8 * c) = o;
    }
    asm volatile("s_waitcnt lgkmcnt(0)" ::: "memory");
}
__device__ __forceinline__ void cvt_map(int it, int& job, int& local) {
    if (it < 16896) { job = it / 704; local = it - job * 704; }
    else {
        int r = it - 16896;
        if (r < 1280) { const int e = r / 640, rr = r - e * 640, part = rr >= 384; local = part ? rr - 384 : rr; job = 24 + 2 * e + part; }
        else { r -= 1280;
            if (r < 512) { job = 28 + (r >> 8); local = r & 255; }
            else { r -= 512;
                if (r < 768) { const int o = r / 384; job = 30 + o; local = r - o * 384; }
                else { r -= 768;
                    if (r < 1536) { job = 32 + (r >> 8); local = r & 255; }
                    else { r -= 1536; job = 38 + (r >> 6); local = r & 63; } } } }
    }
}

__device__ __forceinline__ void first_token_qk(const Params& P, LAS unsigned char* lds, int L, int c0) {
    const int j = obid() - c0;
    if (j < 0 || j >= 64) return;
    const int e = L >> 1, tid = otid(), col = tid & 7, dg = tid >> 3;
    const float* W = P.in[16] + (size_t)e * 1024 * 2576 + 8 * j + col;
    float w[16];
#pragma unroll
    for (int q = 0; q < 16; ++q) w[q] = W[(size_t)(dg * 16 + q) * 2576];
    LAS float* X = (LAS float*)lds;
    {
        const int b = tid >> 7, d0 = (tid & 127) * 8;
        const size_t o = (size_t)(b * SEQ) * D + d0;
        const u32x4 h8 = *(const u32x4*)((const bf16_t*)(P.ws + WS_XB) + o), l8 = *(const u32x4*)((const bf16_t*)P.out + o);
        const f32x4 g0 = *(const f32x4*)(P.in[8] + L * 1024 + d0), g1 = *(const f32x4*)(P.in[8] + L * 1024 + d0 + 4);
        f32x4 a, c;
        a[0] = (bf_lo(h8.x) + bf_lo(l8.x)) * g0[0]; a[1] = (bf_hi(h8.x) + bf_hi(l8.x)) * g0[1]; a[2] = (bf_lo(h8.y) + bf_lo(l8.y)) * g0[2]; a[3] = (bf_hi(h8.y) + bf_hi(l8.y)) * g0[3];
        c[0] = (bf_lo(h8.z) + bf_lo(l8.z)) * g1[0]; c[1] = (bf_hi(h8.z) + bf_hi(l8.z)) * g1[1]; c[2] = (bf_lo(h8.w) + bf_lo(l8.w)) * g1[2]; c[3] = (bf_hi(h8.w) + bf_hi(l8.w)) * g1[3];
        *(LAS f32x4*)(X + b * 1024 + d0) = a; *(LAS f32x4*)(X + b * 1024 + d0 + 4) = c;
    }
    __syncthreads();
    float acc[4] = {0.f, 0.f, 0.f, 0.f};
#pragma unroll
    for (int b = 0; b < 4; ++b)
#pragma unroll
        for (int q4 = 0; q4 < 4; ++q4) {
            const f32x4 xv = *(const LAS f32x4*)(X + b * 1024 + dg * 16 + 4 * q4);
            acc[b] += xv[0] * w[4 * q4] + xv[1] * w[4 * q4 + 1] + xv[2] * w[4 * q4 + 2] + xv[3] * w[4 * q4 + 3];
        }
    LAS float* R = X + 4096;
#pragma unroll
    for (int b = 0; b < 4; ++b) R[(dg * 8 + col) * 4 + b] = acc[b];
    __syncthreads();
    if (tid < 32) {
        const int c = tid & 7, b = tid >> 3;
        float s = 0.f;
        for (int g = 0; g < 64; ++g) s += R[(g * 8 + c) * 4 + b];
        const float* ssq = (const float*)(P.ws + WS_SSQ) + (size_t)((4 * L + 1) & 1) * T * 16;
        ((float*)(P.ws + WS_QK0))[b * 512 + 8 * j + c] = s * pg8::row_scale(ssq, b * SEQ);
    }
    __syncthreads();
}

__device__ __forceinline__ void layer_small_cvt(const Params& P, int L, int c0) {
    const int nb = ogrid() - c0, bi = obid() - c0;
    if (bi < 0) return;
    const int gt = bi * NTHREADS + otid(), NGT = nb * NTHREADS;
    unsigned char* ws = P.ws;
    const f32x4* p4 = (const f32x4*)P.in[1] + (size_t)L * (T * 256 / 4); u32x2* pb = (u32x2*)(ws + WS_PB) + (size_t)L * (T * 256 / 4);
#pragma unroll 8
    for (int i = gt; i < T * 256 / 4; i += NGT) { const f32x4 v = p4[i]; u32x2 w; w.x = pk2(v[0], v[1]); w.y = pk2(v[2], v[3]); pb[i] = w; }
    if (!(L & 1)) {
        const int e = L >> 1;
        for (int idx = gt; idx < 256 * 1024; idx += NGT) {
            const int n = idx >> 10, k = idx & 1023;
            const float* wi = P.in[16] + (size_t)e * 1024 * 2576 + (size_t)k * 2576 + 1536;
            const float* wf = P.in[18] + e * 16 * 256 + n;
            float s = 0.f;
#pragma unroll
            for (int r = 0; r < 16; ++r) s += wi[r] * wf[r * 256];
            s *= P.in[8][(2 * e) * 1024 + k];
            ((bf16_t*)(ws + WS_WIN))[(size_t)e * 2816 * 1024 + (size_t)(2560 + (n & ~31) + pinv32(n & 31)) * 1024 + k] = (bf16_t)f2bf(s);
        }
    }
}

__device__ __forceinline__ void phase_prepass(const Params& P, LAS unsigned char* lds) {
    const int tid = otid(), lane = tid & 63, wave = tid >> 6;
    const int gw = obid() * 8 + wave, NGW = ogrid() * 8;
    const int gt = obid() * NTHREADS + tid, NGT = ogrid() * NTHREADS;
    unsigned char* ws = P.ws;
    LAS float* scr = (LAS float*)(lds + wave * 16640);
    for (int rp_ = 0; rp_ < (PROBE_DUP == 9 ? 2 : 1); ++rp_)
    for (int it = gw; it < 21248; it += NGW) {
        int job, local; cvt_map(it, job, local);
        const CvtJob J = get_job(P, job);
        cvt_item64(J, local, scr, lane);
    }
    float* ssq = (float*)(ws + WS_SSQ);
    bf16_t* xb = (bf16_t*)(ws + WS_MIX);
    for (int m = gw; m < T; m += NGW) {
        const f32x4* xr = (const f32x4*)(P.in[0] + (size_t)m * D) + lane;
        f32x4 v[4]; float s = 0.f;
#pragma unroll
        for (int j = 0; j < 4; ++j) { v[j] = xr[64 * j]; s += (v[j][0] * v[j][0] + v[j][1] * v[j][1]) + (v[j][2] * v[j][2] + v[j][3] * v[j][3]); }
        s = wave_sum(s);
        u32x2* o8 = (u32x2*)(xb + (size_t)m * D) + lane;
#pragma unroll
        for (int j = 0; j < 4; ++j) { u32x2 w; w.x = pk2(v[j][0], v[j][1]); w.y = pk2(v[j][2], v[j][3]); o8[64 * j] = w; }
        if (lane < 16) ssq[(size_t)m * 16 + lane] = (lane == 0) ? s : 0.f;
    }
}

constexpr int LDT = 68;
constexpr int GO_BT = 0, GO_SEG = 4352, GO_QDT = 4864, GO_KDNT = 9216, GO_ATT = 13568, GO_V = 17920, GO_S = 26112;

template <bool WITH_Q>
__device__ __forceinline__ void gla_prolog(LAS float* L, const u32x4 k8, const u32x4 f8, const u32x4 q8, const f32x4 bf0, const f32x4 bf1, float (&kv)[8], float (&qv)[8]) {
    const int tid = otid(), lane = tid & 63, wave = tid >> 6;
    kv[0] = bf_lo(k8.x); kv[1] = bf_hi(k8.x); kv[2] = bf_lo(k8.y); kv[3] = bf_hi(k8.y); kv[4] = bf_lo(k8.z); kv[5] = bf_hi(k8.z); kv[6] = bf_lo(k8.w); kv[7] = bf_hi(k8.w);
    if (WITH_Q) {
        qv[0] = bf_lo(q8.x); qv[1] = bf_hi(q8.x); qv[2] = bf_lo(q8.y); qv[3] = bf_hi(q8.y); qv[4] = bf_lo(q8.z); qv[5] = bf_hi(q8.z); qv[6] = bf_lo(q8.w); qv[7] = bf_hi(q8.w);
    }
    float fv[8];
    fv[0] = bf_lo(f8.x); fv[1] = bf_hi(f8.x); fv[2] = bf_lo(f8.y); fv[3] = bf_hi(f8.y); fv[4] = bf_lo(f8.z); fv[5] = bf_hi(f8.z); fv[6] = bf_lo(f8.w); fv[7] = bf_hi(f8.w);
#pragma unroll
    for (int j = 0; j < 8; ++j) L[GO_BT + (8 * wave + j) * LDT + lane] = logsigmoidf_(fv[j] + (j < 4 ? bf0[j & 3] : bf1[j & 3])) * (1.0f / 16.0f);
    __syncthreads();
    float pr[8];
    {
        const f32x4 a = *(const LAS f32x4*)(L + GO_BT + lane * LDT + 8 * wave), b = *(const LAS f32x4*)(L + GO_BT + lane * LDT + 8 * wave + 4);
        pr[0] = a[0]; pr[1] = pr[0] + a[1]; pr[2] = pr[1] + a[2]; pr[3] = pr[2] + a[3]; pr[4] = pr[3] + b[0]; pr[5] = pr[4] + b[1]; pr[6] = pr[5] + b[2]; pr[7] = pr[6] + b[3];
        L[GO_SEG + wave * 64 + lane] = pr[7];
    }
    __syncthreads();
    {
        float off = 0.f;
        for (int s = 0; s < wave; ++s) off += L[GO_SEG + s * 64 + lane];
        f32x4 a, b; a[0] = pr[0] + off; a[1] = pr[1] + off; a[2] = pr[2] + off; a[3] = pr[3] + off; b[0] = pr[4] + off; b[1] = pr[5] + off; b[2] = pr[6] + off; b[3] = pr[7] + off;
        *(LAS f32x4*)(L + GO_BT + lane * LDT + 8 * wave) = a; *(LAS f32x4*)(L + GO_BT + lane * LDT + 8 * wave + 4) = b;
    }
    __syncthreads();
}

constexpr int MLD = 72;
constexpr int GB_QDB = 19456, GB_KDB = 28672, GB_VT = 37888, GB_STB = 56320, GB_RED = 74752;

__device__ __forceinline__ void stage_vT(LAS unsigned char* lds, int tid, const u32x4 (&vv)[2]) {
    LAS bf16_t* VT = (LAS bf16_t*)(lds + GB_VT);
#pragma unroll
    for (int r = 0; r < 2; ++r) {
        const int c = r * 512 + tid, j = c & 63, vc = c >> 6;
        const u32x4 v = vv[r];
        LAS bf16_t* d = VT + (32 * (vc >> 2) + 4 * (vc & 3)) * MLD + j;
        d[0 * MLD] = (bf16_t)(v.x & 0xffffu); d[1 * MLD] = (bf16_t)(v.x >> 16); d[2 * MLD] = (bf16_t)(v.y & 0xffffu); d[3 * MLD] = (bf16_t)(v.y >> 16);
        d[16 * MLD] = (bf16_t)(v.z & 0xffffu); d[17 * MLD] = (bf16_t)(v.z >> 16); d[18 * MLD] = (bf16_t)(v.w & 0xffffu); d[19 * MLD] = (bf16_t)(v.w >> 16);
    }
}

#define GLA_LOAD(ITEM, WITHQ) do { const int h_ = (ITEM) & 3, bn_ = (ITEM) >> 2, t0_ = (bn_ >> 6) * SEQ + (bn_ & 63) * 64; \
        const bf16_t* z_ = (const bf16_t*)(P.ws + WS_HZ) + (size_t)(t0_ + lane) * ZW; \
        k8 = *(const u32x4*)(z_ + 256 + h_ * 64 + 8 * wave); f8 = *(const u32x4*)(z_ + 2560 + h_ * 64 + 8 * wave); \
        if (WITHQ) q8 = *(const u32x4*)(z_ + h_ * 64 + 8 * wave); \
        _Pragma("unroll") for (int r_ = 0; r_ < 2; ++r_) { const int c_ = r_ * 512 + tid; \
            vv[r_] = *(const u32x4*)((const bf16_t*)(P.ws + WS_HZ) + (size_t)(t0_ + (c_ & 63)) * ZW + 512 + h_ * 128 + (c_ >> 6) * 8); } \
        const float* bfp_ = P.in[19] + e * 256 + h_ * 64 + 8 * wave; bf0 = *(const f32x4*)bfp_; bf1 = *(const f32x4*)(bfp_ + 4); } while (0)

__device__ __forceinline__ void phase_g1(const Params& P, LAS unsigned char* lds, int e) {
    LAS float* L = (LAS float*)lds;
    const int tid = otid(), lane = tid & 63, wave = tid >> 6, l15 = lane & 15, quad = lane >> 4;
    float* Sbuf = (float*)(P.ws + WS_S); float* decay = (float*)(P.ws + WS_DECAY);
    LAS bf16_t* KDB = (LAS bf16_t*)(lds + GB_KDB); LAS bf16_t* VT = (LAS bf16_t*)(lds + GB_VT);
    u32x4 k8, f8, q8 = (u32x4){0u, 0u, 0u, 0u}, vv[2]; f32x4 bf0, bf1;
    const int gstep = ogrid(), item0 = obid();
    if (item0 < 1024) GLA_LOAD(item0, false);
    for (int item = item0; item < 1024; item += gstep) {
        float kv[8], qv[8];
        gla_prolog<false>(L, k8, f8, q8, bf0, bf1, kv, qv);
#pragma unroll
        for (int j = 0; j < 8; ++j) {
            const float bv = L[GO_BT + (8 * wave + j) * LDT + lane], bl = L[GO_BT + (8 * wave + j) * LDT + 63];
            KDB[(8 * wave + j) * MLD + lane] = (bf16_t)f2bf(kv[j] * __expf(bl - bv));
        }
        stage_vT(lds, tid, vv);
        if (item + gstep < 1024) GLA_LOAD(item + gstep, false);
        if (tid < 64) decay[item * 64 + tid] = __expf(L[GO_BT + tid * LDT + 63]);
        __syncthreads();
        const int dk0 = 16 * (wave & 3);
        const bf16x8 bk0 = *(const LAS bf16x8*)(KDB + (dk0 + l15) * MLD + 8 * quad), bk1 = *(const LAS bf16x8*)(KDB + (dk0 + l15) * MLD + 32 + 8 * quad);
#pragma unroll
        for (int t = 0; t < 4; ++t) {
            const int dv0 = 16 * ((wave >> 2) * 4 + t);
            const bf16x8 a0 = *(const LAS bf16x8*)(VT + (dv0 + l15) * MLD + 8 * quad), a1 = *(const LAS bf16x8*)(VT + (dv0 + l15) * MLD + 32 + 8 * quad);
            f32x4 acc = (f32x4){0.f, 0.f, 0.f, 0.f};
            acc = __builtin_amdgcn_mfma_f32_16x16x32_bf16(a0, bk0, acc, 0, 0, 0);
            acc = __builtin_amdgcn_mfma_f32_16x16x32_bf16(a1, bk1, acc, 0, 0, 0);
            const int tp = (wave >> 2) * 4 + t;
            float* o = Sbuf + (size_t)item * 8192 + (32 * (tp >> 1) + 8 * quad + 4 * (tp & 1)) * 64 + dk0 + l15;
            o[0] = acc[0]; o[64] = acc[1]; o[128] = acc[2]; o[192] = acc[3];
        }
        __syncthreads();
    }
}

__device__ __forceinline__ void phase_g2(const Params& P) {
    const float* Sbuf = (const float*)(P.ws + WS_S); const float* decay = (const float*)(P.ws + WS_DECAY);
    bf16_t* Sb = (bf16_t*)P.out + (size_t)T * D;
    for (int idx = obid() * NTHREADS + otid(); idx < 16 * 8192; idx += ogrid() * NTHREADS) {
        const int bh = idx >> 13, el = idx & 8191, b = bh >> 2, h = bh & 3, dk = el & 63;
        float run = 0.f;
        for (int n0 = 0; n0 < 64; n0 += 32) {
            float kvn[32], dc[32];
#pragma unroll
            for (int j = 0; j < 32; ++j) { const int item = ((b * 64 + n0 + j) << 2) + h; kvn[j] = Sbuf[(size_t)item * 8192 + el]; dc[j] = decay[item * 64 + dk]; }
#pragma unroll
            for (int j = 0; j < 32; ++j) { const int item = ((b * 64 + n0 + j) << 2) + h; Sb[(size_t)item * 8192 + el] = (bf16_t)f2bf(run); run = dc[j] * run + kvn[j]; }
        }
    }
}

__device__ __forceinline__ void phase_g3(const Params& P, LAS unsigned char* lds, int e) {
    LAS float* L = (LAS float*)lds;
    const int tid = otid(), lane = tid & 63, wave = tid >> 6, l15 = lane & 15, quad = lane >> 4;
    const bf16_t* Sb = (const bf16_t*)P.out + (size_t)T * D;
    const bf16_t* zb = (const bf16_t*)(P.ws + WS_HZ);
    bf16_t* mix = (bf16_t*)(P.ws + WS_MIX);
    LAS bf16_t* QDB = (LAS bf16_t*)(lds + GB_QDB); LAS bf16_t* KDB = (LAS bf16_t*)(lds + GB_KDB); LAS bf16_t* VT = (LAS bf16_t*)(lds + GB_VT); LAS bf16_t* STB = (LAS bf16_t*)(lds + GB_STB);
    LAS float* RED = (LAS float*)(lds + GB_RED);
    u32x4 k8, f8, q8, vv[2], sv[2]; f32x4 bf0, bf1;
    const int gstep = ogrid(), item0 = obid();
#define G3_LOADS(ITEM) do { _Pragma("unroll") for (int r_ = 0; r_ < 2; ++r_) sv[r_] = *(const u32x4*)(Sb + (size_t)(ITEM) * 8192 + 8 * (r_ * 512 + tid)); } while (0)
    if (item0 < 1024) { GLA_LOAD(item0, true); G3_LOADS(item0); }
    for (int item = item0; item < 1024; item += gstep) {
        const int h = item & 3, bn = item >> 2, b = bn >> 6, n = bn & 63;
        const int t0 = b * SEQ + n * 64;
        float kv[8], qv[8];
        gla_prolog<true>(L, k8, f8, q8, bf0, bf1, kv, qv);
        {
            float qd[8], kd[8];
#pragma unroll
            for (int j = 0; j < 8; ++j) {
                const float bv = L[GO_BT + (8 * wave + j) * LDT + lane];
                qd[j] = qv[j] * 0.125f * __expf(bv); kd[j] = kv[j] * __expf(-bv);
            }
            u32x4 wq, wk;
            wq.x = pk2(qd[0], qd[1]); wq.y = pk2(qd[2], qd[3]); wq.z = pk2(qd[4], qd[5]); wq.w = pk2(qd[6], qd[7]);
            wk.x = pk2(kd[0], kd[1]); wk.y = pk2(kd[2], kd[3]); wk.z = pk2(kd[4], kd[5]); wk.w = pk2(kd[6], kd[7]);
            *(LAS u32x4*)(QDB + lane * MLD + 8 * wave) = wq; *(LAS u32x4*)(KDB + lane * MLD + 8 * wave) = wk;
        }
        stage_vT(lds, tid, vv);
#pragma unroll
        for (int r = 0; r < 2; ++r) {
            const int c = r * 512 + tid, v = c >> 3, k8i = (c & 7) * 8;
            *(LAS u32x4*)(STB + ((v & ~31) + pinv32(v & 31)) * MLD + k8i) = sv[r];
        }
        if (item + gstep < 1024) { GLA_LOAD(item + gstep, true); G3_LOADS(item + gstep); }
        __syncthreads();
        const int it = wave & 3, i0 = 16 * it, vh = wave >> 2;
        const bf16x8 bq0 = *(const LAS bf16x8*)(QDB + (i0 + l15) * MLD + 8 * quad), bq1 = *(const LAS bf16x8*)(QDB + (i0 + l15) * MLD + 32 + 8 * quad);
        f32x4 s[4];
#pragma unroll
        for (int jt = 0; jt < 4; ++jt) {
            const bf16x8 a0 = *(const LAS bf16x8*)(KDB + (16 * jt + l15) * MLD + 8 * quad), a1 = *(const LAS bf16x8*)(KDB + (16 * jt + l15) * MLD + 32 + 8 * quad);
            f32x4 z = (f32x4){0.f, 0.f, 0.f, 0.f};
            z = __builtin_amdgcn_mfma_f32_16x16x32_bf16(a0, bq0, z, 0, 0, 0);
            z = __builtin_amdgcn_mfma_f32_16x16x32_bf16(a1, bq1, z, 0, 0, 0);
#pragma unroll
            for (int r = 0; r < 4; ++r) z[r] = (16 * jt + 4 * quad + r <= i0 + l15) ? z[r] : 0.f;
            s[jt] = z;
            if (jt == 0 && n == 0 && it == 0) {
                const float* qk = (const float*)(P.ws + WS_QK0) + b * 512 + h * 64 + lane;
                const float c0v = wave_sum(qk[0] * qk[256]) * 0.125f;
                if (lane == 0) s[0][0] = c0v;
            }
        }
        bf16x8 pf[2];
#pragma unroll
        for (int jp = 0; jp < 2; ++jp) {
            u32x4 pw; pw.x = pk2(s[2 * jp][0], s[2 * jp][1]); pw.y = pk2(s[2 * jp][2], s[2 * jp][3]); pw.z = pk2(s[2 * jp + 1][0], s[2 * jp + 1][1]); pw.w = pk2(s[2 * jp + 1][2], s[2 * jp + 1][3]);
            pf[jp] = __builtin_bit_cast(bf16x8, pw);
        }
        f32x4 o[4]; float ss = 0.f;
#pragma unroll
        for (int t = 0; t < 4; ++t) {
            const int v0 = 16 * (vh * 4 + t);
            f32x4 acc = (f32x4){0.f, 0.f, 0.f, 0.f};
#pragma unroll
            for (int jp = 0; jp < 2; ++jp) {
                const LAS bf16_t* vp = VT + (v0 + l15) * MLD + 32 * jp + 4 * quad;
                const u32x2 va = *(const LAS u32x2*)vp, vb = *(const LAS u32x2*)(vp + 16);
                u32x4 vw; vw.x = va.x; vw.y = va.y; vw.z = vb.x; vw.w = vb.y;
                acc = __builtin_amdgcn_mfma_f32_16x16x32_bf16(__builtin_bit_cast(bf16x8, vw), pf[jp], acc, 0, 0, 0);
            }
            const bf16x8 s0 = *(const LAS bf16x8*)(STB + (v0 + l15) * MLD + 8 * quad), s1 = *(const LAS bf16x8*)(STB + (v0 + l15) * MLD + 32 + 8 * quad);
            acc = __builtin_amdgcn_mfma_f32_16x16x32_bf16(s0, bq0, acc, 0, 0, 0);
            acc = __builtin_amdgcn_mfma_f32_16x16x32_bf16(s1, bq1, acc, 0, 0, 0);
            o[t] = acc;
            ss += (acc[0] * acc[0] + acc[1] * acc[1]) + (acc[2] * acc[2] + acc[3] * acc[3]);
        }
        ss += __shfl_xor(ss, 16); ss += __shfl_xor(ss, 32);
        if (quad == 0) RED[vh * 64 + i0 + l15] = ss;
        __syncthreads();
        const float rs = rsqrtf((RED[i0 + l15] + RED[64 + i0 + l15]) * (1.0f / 128.0f) + EPS);
        const size_t tok = (size_t)(t0 + i0 + l15);
#pragma unroll
        for (int a = 0; a < 2; ++a) {
            const int v = 32 * (vh * 2 + a) + 8 * quad;
            const f32x4 ng0 = *(const f32x4*)(P.in[20] + e * 512 + h * 128 + v), ng1 = *(const f32x4*)(P.in[20] + e * 512 + h * 128 + v + 4);
            const u32x4 r4 = *(const u32x4*)(zb + tok * ZW + 1024 + h * 128 + v);
            u32x4 w;
            w.x = pk2(o[2 * a][0] * rs * ng0[0] * siluf_(bf_lo(r4.x)), o[2 * a][1] * rs * ng0[1] * siluf_(bf_hi(r4.x)));
            w.y = pk2(o[2 * a][2] * rs * ng0[2] * siluf_(bf_lo(r4.y)), o[2 * a][3] * rs * ng0[3] * siluf_(bf_hi(r4.y)));
            w.z = pk2(o[2 * a + 1][0] * rs * ng1[0] * siluf_(bf_lo(r4.z)), o[2 * a + 1][1] * rs * ng1[1] * siluf_(bf_hi(r4.z)));
            w.w = pk2(o[2 * a + 1][2] * rs * ng1[2] * siluf_(bf_lo(r4.w)), o[2 * a + 1][3] * rs * ng1[3] * siluf_(bf_hi(r4.w)));
            *(u32x4*)(mix + tok * D + h * 128 + v) = w;
        }
        __syncthreads();
    }
#undef G3_LOADS
}
#undef GLA_LOAD

constexpr int LO_XR = 0, LO_XCT = 4288;
constexpr int LB_XCB = 34560, LB_WAT = 43776, LB_WXT = 52992;
constexpr int LO_RT = 15552, LO_IT = 19904, LO_SEGA = 24256, LO_SEGH = 24768;

__device__ __forceinline__ void phase_l1(const Params& P, LAS unsigned char* lds, int e) {
    LAS float* L = (LAS float*)lds;
    const int tid = otid(), lane = tid & 63, wave = tid >> 6, l15 = lane & 15, quad = lane >> 4;
    const bf16_t* zb = (const bf16_t*)(P.ws + WS_HZ);
    float* HL = (float*)(P.ws + WS_HL); float* AC = (float*)(P.ws + WS_AC);
    LAS bf16_t* XCB = (LAS bf16_t*)(lds + LB_XCB); LAS bf16_t* WAT = (LAS bf16_t*)(lds + LB_WAT); LAS bf16_t* WXT = (LAS bf16_t*)(lds + LB_WXT);
    const int gstep = ogrid(), item0 = obid();
    const bool wconst = (gstep & 7) == 0;
    u32x4 xq0 = (u32x4){0u, 0u, 0u, 0u}, xq1 = (u32x4){0u, 0u, 0u, 0u};
#define L1_LOADXR(ITEM) do { const int g_ = (ITEM) & 7, bc_ = (ITEM) >> 3, c_ = bc_ & 63, t0_ = (bc_ >> 6) * SEQ + c_ * 64; \
        { const int row = tid >> 3, c8 = (tid & 7) * 8; xq0 = (u32x4){0u, 0u, 0u, 0u}; if (c_ > 0 || row >= 3) xq0 = *(const u32x4*)(zb + (size_t)(t0_ + row - 3) * ZW + 1536 + g_ * 64 + c8); } \
        if (tid < 24) { const int row = 64 + (tid >> 3), c8 = (tid & 7) * 8; xq1 = *(const u32x4*)(zb + (size_t)(t0_ + row - 3) * ZW + 1536 + g_ * 64 + c8); } } while (0)
    if (item0 < 2048) L1_LOADXR(item0);
    for (int item = item0; item < 2048; item += gstep) {
        const int g = item & 7, bc = item >> 3, b = bc >> 6, c = bc & 63;
        const int t0 = b * SEQ + c * 64, ch0 = g * 64;
        {
            const int row = tid >> 3, c8 = (tid & 7) * 8;
            f32x4 a, bq; a[0] = bf_lo(xq0.x); a[1] = bf_hi(xq0.x); a[2] = bf_lo(xq0.y); a[3] = bf_hi(xq0.y); bq[0] = bf_lo(xq0.z); bq[1] = bf_hi(xq0.z); bq[2] = bf_lo(xq0.w); bq[3] = bf_hi(xq0.w);
            *(LAS f32x4*)(L + LO_XR + row * 64 + c8) = a; *(LAS f32x4*)(L + LO_XR + row * 64 + c8 + 4) = bq;
            if (tid < 24) {
                const int row1 = 64 + (tid >> 3);
                a[0] = bf_lo(xq1.x); a[1] = bf_hi(xq1.x); a[2] = bf_lo(xq1.y); a[3] = bf_hi(xq1.y); bq[0] = bf_lo(xq1.z); bq[1] = bf_hi(xq1.z); bq[2] = bf_lo(xq1.w); bq[3] = bf_hi(xq1.w);
                *(LAS f32x4*)(L + LO_XR + row1 * 64 + c8) = a; *(LAS f32x4*)(L + LO_XR + row1 * 64 + c8 + 4) = bq;
            }
        }
        if (item + gstep < 2048) L1_LOADXR(item + gstep);
        if (!wconst || item == item0) {
            const f32x4* wa = (const f32x4*)(P.in[23] + (size_t)(e * 8 + g) * 4096); const f32x4* wx = (const f32x4*)(P.in[25] + (size_t)(e * 8 + g) * 4096);
#pragma unroll
            for (int r = 0; r < 2; ++r) {
                const int i4 = tid + 512 * r, i = i4 >> 4, j4 = (i4 & 15) * 4;
                const f32x4 va = wa[i4], vx = wx[i4];
#pragma unroll
                for (int q = 0; q < 4; ++q) { WAT[(j4 + q) * MLD + i] = (bf16_t)f2bf(va[q]); WXT[(j4 + q) * MLD + i] = (bf16_t)f2bf(vx[q]); }
            }
        }
        __syncthreads();
        {
            const float* cw = P.in[21] + e * 4 * 512 + ch0 + lane;
            const float w0 = cw[0], w1 = cw[512], w2 = cw[1024], w3 = cw[1536], cb = P.in[22][e * 512 + ch0 + lane];
            f32x4 a, bq;
#pragma unroll
            for (int j = 0; j < 8; ++j) {
                const int t = 8 * wave + j;
                const float v = L[LO_XR + (t + 0) * 64 + lane] * w0 + L[LO_XR + (t + 1) * 64 + lane] * w1 + L[LO_XR + (t + 2) * 64 + lane] * w2 + L[LO_XR + (t + 3) * 64 + lane] * w3 + cb;
                if (j < 4) a[j] = v; else bq[j - 4] = v;
                XCB[t * MLD + lane] = (bf16_t)f2bf(v);
            }
            *(LAS f32x4*)(L + LO_XCT + lane * LDT + 8 * wave) = a; *(LAS f32x4*)(L + LO_XCT + lane * LDT + 8 * wave + 4) = bq;
        }
        __syncthreads();
        {
            const int gate = wave >> 2, tt0 = 16 * (wave & 3);
            const LAS bf16_t* WT = gate ? WXT : WAT;
            const bf16x8 a0 = *(const LAS bf16x8*)(XCB + (tt0 + l15) * MLD + 8 * quad), a1 = *(const LAS bf16x8*)(XCB + (tt0 + l15) * MLD + 32 + 8 * quad);
            LAS float* O = L + (gate ? LO_IT : LO_RT);
            const float* bp = (gate ? P.in[26] : P.in[24]) + e * 512 + ch0;
#pragma unroll
            for (int jt = 0; jt < 4; ++jt) {
                const bf16x8 b0 = *(const LAS bf16x8*)(WT + (16 * jt + l15) * MLD + 8 * quad), b1 = *(const LAS bf16x8*)(WT + (16 * jt + l15) * MLD + 32 + 8 * quad);
                f32x4 acc = (f32x4){0.f, 0.f, 0.f, 0.f};
                acc = __builtin_amdgcn_mfma_f32_16x16x32_bf16(a0, b0, acc, 0, 0, 0);
                acc = __builtin_amdgcn_mfma_f32_16x16x32_bf16(a1, b1, acc, 0, 0, 0);
                const float bias = bp[16 * jt + l15];
                f32x4 w;
#pragma unroll
                for (int r = 0; r < 4; ++r) w[r] = sigmoidf_(acc[r] + bias);
                *(LAS f32x4*)(O + (16 * jt + l15) * LDT + tt0 + 4 * quad) = w;
            }
        }
        __syncthreads();
        {
            const float sp = softplusf_(-P.in[27][e * 512 + ch0 + lane]);
            const f32x4 r0 = *(const LAS f32x4*)(L + LO_RT + lane * LDT + 8 * wave), r1 = *(const LAS f32x4*)(L + LO_RT + lane * LDT + 8 * wave + 4);
            const f32x4 i0 = *(const LAS f32x4*)(L + LO_IT + lane * LDT + 8 * wave), i1 = *(const LAS f32x4*)(L + LO_IT + lane * LDT + 8 * wave + 4);
            const f32x4 x0 = *(const LAS f32x4*)(L + LO_XCT + lane * LDT + 8 * wave), x1 = *(const LAS f32x4*)(L + LO_XCT + lane * LDT + 8 * wave + 4);
            float Hl[8], Al[8]; float Hr = 0.f, Ar = 1.f;
#pragma unroll
            for (int j = 0; j < 8; ++j) {
                const float rr = j < 4 ? r0[j & 3] : r1[j & 3], ii = j < 4 ? i0[j & 3] : i1[j & 3], xx = j < 4 ? x0[j & 3] : x1[j & 3];
                const float la = -8.0f * rr * sp; const float a = __expf(la);
                const float u = __builtin_amdgcn_sqrtf(fmaxf(__builtin_fmaf(-a, a, 1.0f), 0.f)) * (ii * xx);
                Hr = a * Hr + u; Ar *= a; Hl[j] = Hr; Al[j] = Ar;
            }
            L[LO_SEGA + wave * 64 + lane] = Ar; L[LO_SEGH + wave * 64 + lane] = Hr;
            __syncthreads();
            float Hin = 0.f, Ain = 1.f;
            for (int s = 0; s < wave; ++s) { const float sa = L[LO_SEGA + s * 64 + lane], sh = L[LO_SEGH + s * 64 + lane]; Hin = sa * Hin + sh; Ain *= sa; }
#pragma unroll
            for (int j = 0; j < 8; ++j) {
                const size_t o = (size_t)(t0 + 8 * wave + j) * 512 + ch0 + lane;
                HL[o] = Hl[j] + Al[j] * Hin; AC[o] = Al[j] * Ain;
            }
        }
        __syncthreads();
    }
#undef L1_LOADXR
}

__device__ __forceinline__ void phase_l2(const Params& P) {
    const float* HL = (const float*)(P.ws + WS_HL); const float* AC = (const float*)(P.ws + WS_AC); float* carry = (float*)(P.ws + WS_CARRY);
    const int tid = otid(), lane = tid & 63, wave = tid >> 6;
    for (int seq = obid() * 8 + wave, sstep = ogrid() * 8; seq < 4 * 512; seq += sstep) {
        const int b = seq >> 9, ch = seq & 511;
        const size_t o = (size_t)(b * SEQ + lane * 64 + 63) * 512 + ch;
        float a = AC[o], h = HL[o];
#pragma unroll
        for (int d = 1; d < 64; d <<= 1) {
            const float ap = __shfl_up(a, d), hp = __shfl_up(h, d);
            if (lane >= d) { h = a * hp + h; a = ap * a; }
        }
        const float hin = __shfl_up(h, 1);
        carry[(b * 64 + lane) * 512 + ch] = lane == 0 ? 0.f : hin;
    }
}

__device__ __forceinline__ void phase_l3(const Params& P) {
    const float* HL = (const float*)(P.ws + WS_HL); const float* AC = (const float*)(P.ws + WS_AC); const float* carry = (const float*)(P.ws + WS_CARRY);
    const bf16_t* zb = (const bf16_t*)(P.ws + WS_HZ); bf16_t* mix = (bf16_t*)(P.ws + WS_MIX);
#pragma unroll 4
    for (int idx = obid() * NTHREADS + otid(); idx < T * 128; idx += ogrid() * NTHREADS) {
        const int tok = idx >> 7, ch = (idx & 127) * 4;
        const int b = tok >> 12, c = (tok & 4095) >> 6;
        const f32x4 hl = *(const f32x4*)(HL + (size_t)tok * 512 + ch), ac = *(const f32x4*)(AC + (size_t)tok * 512 + ch), cr = *(const f32x4*)(carry + (b * 64 + c) * 512 + ch);
        const u32x2 g2 = *(const u32x2*)(zb + (size_t)tok * ZW + 2048 + ch);
        const f32x4 hh = hl + ac * cr;
        u32x2 w; w.x = pk2(hh[0] * gelu_tanh(bf_lo(g2.x)), hh[1] * gelu_tanh(bf_hi(g2.x))); w.y = pk2(hh[2] * gelu_tanh(bf_lo(g2.y)), hh[3] * gelu_tanh(bf_hi(g2.y)));
        *(u32x2*)(mix + (size_t)tok * D + 512 + ch) = w;
    }
}

constexpr int AK_LD = 72, AV_LD = 264;
constexpr int AO_K = 0, AO_VT = 256 * AK_LD * 2, AO_BIAS = AO_VT + 64 * AV_LD * 2;

__device__ __forceinline__ void phase_attn(const Params& P, LAS unsigned char* lds, int o) {
    const int tid = otid(), lane = tid & 63, wave = tid >> 6, l15 = lane & 15, quad = lane >> 4;
    const bf16_t* qkv = (const bf16_t*)(P.ws + WS_HZ);
    bf16_t* mix = (bf16_t*)(P.ws + WS_MIX);
    LAS bf16_t* KS = (LAS bf16_t*)(lds + AO_K); LAS bf16_t* VT = (LAS bf16_t*)(lds + AO_VT); LAS float* BIAS = (LAS float*)(lds + AO_BIAS);
    const int gstep = ogrid(), item0 = obid();
    const bool hkconst = (gstep & 3) == 0;
    for (int item = item0; item < 512; item += gstep) {
        const int hk = item & 3, n = (item >> 2) & 31, b = item >> 7;
        const int tok0 = b * SEQ + n * 128 - 128;
#pragma unroll
        for (int r = 0; r < 4; ++r) {
            const int c = r * 512 + tid, key = c >> 3, dc = c & 7;
            u32x4 v = (u32x4){0u, 0u, 0u, 0u};
            if (n > 0 || key >= 128) v = *(const u32x4*)(qkv + (size_t)(tok0 + key) * QKVW + 1024 + hk * 64 + dc * 8);
            *(LAS u32x4*)(KS + key * AK_LD + dc * 8) = v;
        }
#pragma unroll
        for (int r = 0; r < 4; ++r) {
            const int c = r * 512 + tid, key = c & 255, dvc = c >> 8;
            u32x4 v = (u32x4){0u, 0u, 0u, 0u};
            if (n > 0 || key >= 128) v = *(const u32x4*)(qkv + (size_t)(tok0 + key) * QKVW + 1280 + hk * 64 + dvc * 8);
            LAS bf16_t* d = VT + (32 * (dvc >> 2) + 4 * (dvc & 3)) * AV_LD + key;
            d[0 * AV_LD] = (bf16_t)(v.x & 0xffffu); d[1 * AV_LD] = (bf16_t)(v.x >> 16); d[2 * AV_LD] = (bf16_t)(v.y & 0xffffu); d[3 * AV_LD] = (bf16_t)(v.y >> 16);
            d[16 * AV_LD] = (bf16_t)(v.z & 0xffffu); d[17 * AV_LD] = (bf16_t)(v.z >> 16); d[18 * AV_LD] = (bf16_t)(v.w & 0xffffu); d[19 * AV_LD] = (bf16_t)(v.w >> 16);
        }
        if (!hkconst || item == item0) {
            for (int idx = tid; idx < 4 * 192; idx += NTHREADS) {
                const int g = idx / 192, j = idx - g * 192, dist = (191 - j) - 32;
                float val = -1e30f;
                if (dist >= 0 && dist < 128) {
                    int bucket = dist;
                    if (dist >= 16) { int lg = 16 + (int)(__logf((float)dist * 0.0625f) / 2.0794415416798357f * 16.0f); bucket = lg < 31 ? lg : 31; }
                    val = P.in[2][bucket * 16 + hk * 4 + g] * 1.4426950408889634f;
                }
                BIAS[idx] = val;
            }
        }
        __syncthreads();
        const int g = wave >> 1, half = wave & 1, head = hk * 4 + g;
        const float sink2 = P.in[32][o * 16 + head] * 1.4426950408889634f;
        bf16x8 qn0, qn1;
        {
            const size_t qt = (size_t)(b * SEQ + n * 128 + 64 * half + l15);
            qn0 = *(const bf16x8*)(qkv + qt * QKVW + head * 64 + 8 * quad); qn1 = *(const bf16x8*)(qkv + qt * QKVW + head * 64 + 32 + 8 * quad);
        }
#pragma nounroll
        for (int rt = 0; rt < 4; ++rt) {
            const int q0 = 64 * half + 16 * rt, qi = q0 + l15;
            const size_t qtok = (size_t)(b * SEQ + n * 128 + qi);
            bf16x8 qf[2]; qf[0] = qn0; qf[1] = qn1;
            if (rt < 3) {
                const size_t qt = qtok + 16;
                qn0 = *(const bf16x8*)(qkv + qt * QKVW + head * 64 + 8 * quad); qn1 = *(const bf16x8*)(qkv + qt * QKVW + head * 64 + 32 + 8 * quad);
            }
            const int grp0 = q0 >> 5, tile0 = 2 * grp0;
            f32x4 s[10];
#pragma unroll
            for (int tt = 0; tt < 10; ++tt) {
                const int key = 16 * (tile0 + tt) + l15;
                const bf16x8 k0 = *(const LAS bf16x8*)(KS + key * AK_LD + 8 * quad), k1 = *(const LAS bf16x8*)(KS + key * AK_LD + 32 + 8 * quad);
                f32x4 z = (f32x4){0.f, 0.f, 0.f, 0.f};
                z = __builtin_amdgcn_mfma_f32_16x16x32_bf16(k0, qf[0], z, 0, 0, 0);
                z = __builtin_amdgcn_mfma_f32_16x16x32_bf16(k1, qf[1], z, 0, 0, 0);
                s[tt] = z;
            }
            float mx = sink2;
            {
                const LAS float* tb = BIAS + g * 192 + (31 - (q0 & 31) - l15 + 4 * quad);
#pragma unroll
                for (int tt = 0; tt < 10; ++tt)
#pragma unroll
                    for (int r = 0; r < 4; ++r) {
                        const float sc = __builtin_fmaf(s[tt][r], 0.125f * 1.4426950408889634f, tb[16 * tt + r]);
                        s[tt][r] = sc;
                    }
                if (n == 0) {
#pragma unroll
                    for (int tt = 0; tt < 10; ++tt)
#pragma unroll
                        for (int r = 0; r < 4; ++r) { const int kj = 16 * (tile0 + tt) + 4 * quad + r; if (kj < 128) s[tt][r] = -1e30f; }
                }
#pragma unroll
                for (int tt = 0; tt < 10; ++tt)
#pragma unroll
                    for (int r = 0; r < 4; ++r) mx = fmaxf(mx, s[tt][r]);
            }
            mx = fmaxf(mx, __shfl_xor(mx, 16)); mx = fmaxf(mx, __shfl_xor(mx, 32));
            float l = 0.f;
#pragma unroll
            for (int tt = 0; tt < 10; ++tt)
#pragma unroll
                for (int r = 0; r < 4; ++r) { const float p = __builtin_amdgcn_exp2f(s[tt][r] - mx); s[tt][r] = p; l += p; }
            l += __shfl_xor(l, 16); l += __shfl_xor(l, 32);
            l += __builtin_amdgcn_exp2f(sink2 - mx);
            f32x4 oacc[4];
#pragma unroll
            for (int t = 0; t < 4; ++t) oacc[t] = (f32x4){0.f, 0.f, 0.f, 0.f};
#pragma unroll
            for (int jp = 0; jp < 5; ++jp) {
                u32x4 pw; pw.x = pk2(s[2 * jp][0], s[2 * jp][1]); pw.y = pk2(s[2 * jp][2], s[2 * jp][3]); pw.z = pk2(s[2 * jp + 1][0], s[2 * jp + 1][1]); pw.w = pk2(s[2 * jp + 1][2], s[2 * jp + 1][3]);
                const bf16x8 pf = __builtin_bit_cast(bf16x8, pw);
                const int keybase = 32 * (grp0 + jp);
#pragma unroll
                for (int t = 0; t < 4; ++t) {
                    const LAS bf16_t* vp = VT + (16 * t + l15) * AV_LD + keybase + 4 * quad;
                    const u32x2 va = *(const LAS u32x2*)vp, vb = *(const LAS u32x2*)(vp + 16);
                    u32x4 vw; vw.x = va.x; vw.y = va.y; vw.z = vb.x; vw.w = vb.y;
                    oacc[t] = __builtin_amdgcn_mfma_f32_16x16x32_bf16(__builtin_bit_cast(bf16x8, vw), pf, oacc[t], 0, 0, 0);
                }
            }
            const float inv = 1.0f / l;
#pragma unroll
            for (int a = 0; a < 2; ++a) {
                u32x4 w; w.x = pk2(oacc[2 * a][0] * inv, oacc[2 * a][1] * inv); w.y = pk2(oacc[2 * a][2] * inv, oacc[2 * a][3] * inv);
                w.z = pk2(oacc[2 * a + 1][0] * inv, oacc[2 * a + 1][1] * inv); w.w = pk2(oacc[2 * a + 1][2] * inv, oacc[2 * a + 1][3] * inv);
                *(u32x4*)(mix + qtok * D + head * 64 + 32 * a + 8 * quad) = w;
            }
        }
        __syncthreads();
    }
}

__device__ __forceinline__ void phase_final(const Params& P) {
    const int tid_ = otid(); const int lane = tid_ & 63, wave = tid_ >> 6;
    const float* ssq = (const float*)(P.ws + WS_SSQ);
    const bf16_t* hi = (const bf16_t*)(P.ws + WS_MIX); const bf16_t* lo = (const bf16_t*)(P.ws + WS_HZ);
    for (int m = obid() * 8 + wave, mstep = ogrid() * 8; m < T; m += mstep) {
        const float s = pg8::row_scale(ssq, m);
        f32x4* xr = (f32x4*)(P.out + (size_t)m * D) + lane; const f32x4* gp = (const f32x4*)P.in[3] + lane;
        const u32x2* hp = (const u32x2*)(hi + (size_t)m * D) + lane; const u32x2* lp = (const u32x2*)(lo + (size_t)m * D) + lane;
#pragma unroll
        for (int j = 0; j < 4; ++j) {
            const u32x2 h2 = hp[64 * j], l2 = lp[64 * j]; const f32x4 g4 = gp[64 * j];
            f32x4 o; o[0] = (bf_lo(h2.x) + bf_lo(l2.x)) * s * g4[0]; o[1] = (bf_hi(h2.x) + bf_hi(l2.x)) * s * g4[1]; o[2] = (bf_lo(h2.y) + bf_lo(l2.y)) * s * g4[2]; o[3] = (bf_hi(h2.y) + bf_hi(l2.y)) * s * g4[3];
            xr[64 * j] = o;
        }
    }
}

#define XB_TMO      128
#define XB_XCNT(j)  (256  + 64 * (j))
#define XB_XSUB(j)  (1280 + 64 * (j))
#define XB_XGEN(j)  (2304 + 64 * (j))
#define XB_TOP      3328
#define XB_TOPGEN   3392
#define XCD_BAR_WORDS 3456
#define XB_SPIN_CAP (1u << 18)
__device__ __forceinline__ unsigned xb_ld(unsigned* p)              { return __hip_atomic_load(p, __ATOMIC_RELAXED, __HIP_MEMORY_SCOPE_AGENT); }
__device__ __forceinline__ unsigned xb_add(unsigned* p, unsigned v) { return __hip_atomic_fetch_add(p, v, __ATOMIC_RELAXED, __HIP_MEMORY_SCOPE_AGENT); }
__device__ __forceinline__ unsigned xb_xcc_id() { return (unsigned)__builtin_amdgcn_s_getreg((3 << 11) | 20) & 0xFu; }
#define XB_SPIN(cond, bar) do { unsigned _sp = 0; while (cond) { __builtin_amdgcn_s_sleep(1); \
    if ((++_sp & 255u) == 0u) { if (xb_ld(&(bar)[XB_TMO])) break; if (_sp > XB_SPIN_CAP) { atomicAdd(&(bar)[XB_TMO], 1u); break; } } } } while (0)
struct XcdBarrier { unsigned* bar; unsigned x; volatile LAS unsigned* st; };
__device__ __forceinline__ XcdBarrier xcd_barrier_post(unsigned* bar, volatile LAS unsigned* st) {
    XcdBarrier b; b.bar = bar; b.x = xb_xcc_id(); b.st = st;
    if (threadIdx.x == 0) (void)xb_add(&bar[XB_XCNT(b.x)], 1u);
    return b;
}
__device__ __forceinline__ void xcd_barrier_complete(unsigned* bar, unsigned x, unsigned& nloc, unsigned& nx) {
    const unsigned G = gridDim.x * gridDim.y * gridDim.z;
    unsigned sum, cnt, mine, sp = 0u;
    for (;;) {
        sum = 0u; cnt = 0u; mine = 0u;
#pragma unroll
        for (unsigned j = 0; j < 16; ++j) { const unsigned c = xb_ld(&bar[XB_XCNT(j)]); sum += c; cnt += (c > 0u) ? 1u : 0u; mine = (j == x) ? c : mine; }
        if (sum == G) break;
        __builtin_amdgcn_s_sleep(1);
        if ((++sp & 255u) == 0u) { if (xb_ld(&bar[XB_TMO])) break; if (sp > XB_SPIN_CAP) { atomicAdd(&bar[XB_TMO], 1u); break; } }
    }
    nloc = mine > 0u ? mine : 1u; nx = cnt > 0u ? cnt : 1u;
}
__device__ __forceinline__ void xcd_barrier(const XcdBarrier& b) {
    asm volatile("s_waitcnt vmcnt(0)" ::: "memory");
    __syncthreads();
    if (threadIdx.x == 0) {
        unsigned* bar = b.bar;
        __builtin_amdgcn_s_waitcnt(0);
        unsigned nloc = b.st[0], nx = b.st[1];
        if (nloc == 0u) { xcd_barrier_complete(bar, b.x, nloc, nx); b.st[0] = nloc; b.st[1] = nx; }
        const unsigned old = xb_add(&bar[XB_XSUB(b.x)], 1u);
        const unsigned gen = old / nloc;
        if (old + 1u == (gen + 1u) * nloc) {
            __builtin_amdgcn_fence(__ATOMIC_RELEASE, "agent");
            asm volatile("s_waitcnt vmcnt(0)" ::: "memory");
            const unsigned og = xb_add(&bar[XB_TOP], 1u);
            const unsigned tg = og / nx;
            if (og + 1u == (tg + 1u) * nx) xb_add(&bar[XB_TOPGEN], 1u);
            else XB_SPIN(xb_ld(&bar[XB_TOPGEN]) == tg, bar);
            __builtin_amdgcn_fence(__ATOMIC_ACQUIRE, "agent");
            xb_add(&bar[XB_XGEN(b.x)], 1u);
            asm volatile("s_waitcnt vmcnt(0)" ::: "memory");
        } else {
            XB_SPIN(xb_ld(&bar[XB_XGEN(b.x)]) == gen, bar);
            __builtin_amdgcn_fence(__ATOMIC_ACQUIRE, "agent");
            asm volatile("s_waitcnt vmcnt(0)" ::: "memory");
        }
    }
    __syncthreads();
}

__global__ void __launch_bounds__(NTHREADS, 2) mk_fwd(Params P_arg) {
    extern __shared__ __attribute__((aligned(16))) unsigned char lds_raw[];
    LAS unsigned char* lds = (LAS unsigned char*)lds_raw;
    cg::grid_group grid = cg::this_grid();
    volatile LAS unsigned* bar_st = (volatile LAS unsigned*)(lds + LDS_BYTES - 64);
    if (threadIdx.x == 0) { bar_st[0] = 0u; bar_st[1] = 0u; }
    __syncthreads();
    const XcdBarrier xbar = xcd_barrier_post((unsigned*)(P_arg.ws + WS_CTL), bar_st);
    for (int ph = P_arg.ph_lo; ph < P_arg.ph_hi; ++ph) {
        bool did = true;
        int nrep = 1;
        {
            const int s_ = (ph >= 1 && ph <= 40) ? (ph - 1) % 10 : -1, L_ = (ph - 1) / 10;
            if (PROBE_DUP == 1 && (s_ == 0)) nrep = 2;
            if (PROBE_DUP == 2 && ph == 0) nrep = 2;
            if (PROBE_DUP == 3 && (s_ == 3 || s_ == 5) && !(L_ & 1)) nrep = 2;
            if (PROBE_DUP == 4 && s_ == 3 && (L_ & 1)) nrep = 2;
            if (PROBE_DUP == 6 && s_ == 2) nrep = 2;
        }
#pragma nounroll
        for (int rep_ = 0; rep_ < nrep; ++rep_) {
        const __attribute__((address_space(4))) Params* Pk = (const __attribute__((address_space(4))) Params*)__builtin_amdgcn_kernarg_segment_ptr();
        asm volatile("" : "+s"(Pk));
        const Params& P = *(const Params*)Pk;
        unsigned char* ws = P.ws;
        float* ssq = (float*)(ws + WS_SSQ);
        bf16_t* XB = (bf16_t*)(ws + WS_XB); bf16_t* XBALT = (bf16_t*)(ws + WS_MIX); bf16_t* HZ = (bf16_t*)(ws + WS_HZ); bf16_t* MIX = (bf16_t*)(ws + WS_MIX);
        bf16_t* PP = (bf16_t*)(ws + WS_PP);
        bf16_t* XLO = (bf16_t*)P.out;
        if (ph == 0) phase_prepass(P, lds);
        else if (ph == 41) phase_final(P);
        else {
            const int L = (ph - 1) / 10, s = (ph - 1) % 10, even = !(L & 1), eo = L >> 1;
            if (s == 3) {
                if (even) { phase_g1(P, lds, eo); phase_l1(P, lds, eo); } else phase_attn(P, lds, eo);
            } else if (s == 4) {
                if (even) { phase_g2(P); phase_l2(P); } else did = false;
            } else if (s == 5) {
                if (even) { phase_g3(P, lds, eo); phase_l3(P); } else did = false;
            } else {
                const int ng = (s == 7) ? 2 : 1;
#pragma nounroll
                for (int gi = 0; gi < ng; ++gi) {
                    pg8::Epi E; E.mode = 0; E.ssq_in = nullptr; E.ssq_out = nullptr; E.xin = nullptr; E.hin = nullptr; E.lin = nullptr; E.lout = nullptr; E.xb = nullptr; E.ob = nullptr; E.ldo = 0; E.of = nullptr; E.bias = nullptr; E.alpha = 1.0f;
                    const bf16_t* A = XB; const bf16_t* Bt = nullptr; int N = 1024, K = 1024;
                    if (gi == 1) {
                        E.mode = 2; E.ob = PP; A = (const bf16_t*)(ws + WS_PB) + (size_t)L * T * 256; Bt = (const bf16_t*)(ws + WS_WPP) + (size_t)L * 1024 * 256; N = 1024; K = 256;
                    } else if (s == 0 || s == 7) {
                        const int w = (s == 7);
                        E.mode = 0; E.ssq_in = ssq + (size_t)((4 * L + (w ? 2 : 0)) & 1) * T * 16; E.ob = HZ; E.ldo = FF;
                        A = w ? XB : XBALT; Bt = (const bf16_t*)(ws + WS_WUP) + (size_t)(2 * L + w) * 5632 * 1024; N = 5632; K = 1024;
                    } else if (s == 1 || s == 8) {
                        const int w = (s == 8);
                        E.mode = (L == 0 && !w) ? 5 : 3; E.xin = P.in[0]; E.hin = w ? XB : XBALT; E.lin = XLO; E.lout = XLO; E.xb = XB; E.ssq_out = ssq + (size_t)((4 * L + (w ? 3 : 1)) & 1) * T * 16; E.alpha = 0.5f;
                        A = HZ; Bt = (const bf16_t*)(ws + WS_WDN) + (size_t)(2 * L + w) * 1024 * 2816; N = 1024; K = 2816;
                    } else if (s == 2) {
                        E.mode = 1; E.ssq_in = ssq + (size_t)((4 * L + 1) & 1) * T * 16; E.ob = HZ; A = XB; K = 1024;
                        if (even) { E.ldo = ZW; Bt = (const bf16_t*)(ws + WS_WIN) + (size_t)eo * 2816 * 1024; N = 2816; }
                        else { E.ldo = QKVW; E.bias = P.in[29] + eo * 1536; Bt = (const bf16_t*)(ws + WS_WQKV) + (size_t)eo * 1536 * 1024; N = 1536; }
                    } else if (s == 6) {
                        E.mode = 3; E.hin = XB; E.lin = XLO; E.lout = XLO; E.xb = XB; E.ssq_out = ssq + (size_t)((4 * L + 2) & 1) * T * 16; E.alpha = 1.0f;
                        E.bias = even ? nullptr : P.in[31] + eo * 1024;
                        A = MIX; Bt = even ? (const bf16_t*)(ws + WS_WOUT) + (size_t)eo * 1024 * 1024 : (const bf16_t*)(ws + WS_WO) + (size_t)eo * 1024 * 1024; N = 1024; K = 1024;
                    } else {
                        E.mode = 4; E.ssq_in = ssq + (size_t)((4 * L + 3) & 1) * T * 16; E.ssq_out = ssq + (size_t)((4 * L + 4) & 1) * T * 16; E.ob = PP; E.hin = XB; E.lin = XLO; E.lout = (L == 3) ? HZ : XLO; E.xb = XBALT;
                        A = XB; Bt = (const bf16_t*)(ws + WS_WPG) + (size_t)L * 1024 * 1024; N = 1024; K = 1024;
                    }
                    if (PROBE_DUP == 7 && s == 1) { pg8::Epi Ed = E; Ed.mode = 2; Ed.ob = PP; run_gemm(lds, A, Bt, N, K, Ed); }
                    if (PROBE_DUP == 8 && s == 6) { pg8::Epi Ed = E; Ed.mode = 2; Ed.ob = PP; run_gemm(lds, A, Bt, N, K, Ed); }
                    run_gemm(lds, A, Bt, N, K, E, (gi == 1 && gridDim.x == 256) ? 128 : 0);
                    if (s == 0) layer_small_cvt(P, L, gridDim.x == 256 ? 128 : 0);
                    if (s == 2 && even) first_token_qk(P, lds, L, gridDim.x == 256 ? 192 : 0);
                }
            }
        }
        }
        if (did && ph + 1 < P_arg.ph_hi) { if (ph == 99) grid.sync(); else xcd_barrier(xbar); if (PROBE_DUP == 5) xcd_barrier(xbar); }
    }
}

extern "C" void kernel_launch(void* const* d_in, const int* in_sizes, int n_in, void* d_out, int out_size, void* d_ws, size_t ws_size, hipStream_t stream) {
    static int grid = 0;
    if (grid == 0) {
        if (n_in != 33 || out_size != T * D || ws_size < WS_END) { fprintf(stderr, "kernel_launch: unexpected shapes (n_in %d out %d ws %zu need %zu)\n", n_in, out_size, ws_size, (size_t)WS_END); grid = -1; return; }
        int dev = 0, cus = 0, per_cu = 0;
        hipGetDevice(&dev); hipDeviceGetAttribute(&cus, hipDeviceAttributeMultiprocessorCount, dev);
        if (hipFuncSetAttribute((const void*)mk_fwd, hipFuncAttributeMaxDynamicSharedMemorySize, LDS_BYTES) != hipSuccess) { fprintf(stderr, "hipFuncSetAttribute failed\n"); grid = -1; return; }
        if (hipOccupancyMaxActiveBlocksPerMultiprocessor(&per_cu, (const void*)mk_fwd, NTHREADS, LDS_BYTES) != hipSuccess || per_cu < 1) per_cu = 1;
        (void)hipGetLastError();
        grid = cus * 1;
    }
    if (grid < 0) return;
    if (hipMemsetAsync((char*)d_ws + WS_CTL, 0, CTL_BYTES, stream) != hipSuccess) { fprintf(stderr, "memset failed\n"); return; }
    Params p{};
    for (int i = 0; i < 33; ++i) p.in[i] = (const float*)d_in[i];
    p.out = (float*)d_out; p.ws = (unsigned char*)d_ws;
#if COOP
    p.ph_lo = 0; p.ph_hi = 42;
    void* args[] = {&p};
    hipError_t e = hipLaunchCooperativeKernel((const void*)mk_fwd, dim3(grid), dim3(NTHREADS), args, LDS_BYTES, stream);
    if (e != hipSuccess) fprintf(stderr, "cooperative launch failed: %s (grid %d)\n", hipGetErrorString(e), grid);
#else
    for (int ph = 0; ph < 42; ++ph) {
        if (ph >= 1 && ph <= 40) { const int L = (ph - 1) / 10, s = (ph - 1) % 10; if ((L & 1) && (s == 4 || s == 5)) continue; }
        p.ph_lo = ph; p.ph_hi = ph + 1;
        hipLaunchKernelGGL(mk_fwd, dim3(grid), dim3(NTHREADS), LDS_BYTES, stream, p);
    }
#endif
}
```

```cpp
#include <hip/hip_runtime.h>
#include <hip/hip_cooperative_groups.h>
#include <cstdio>
namespace cg = cooperative_groups;

#ifndef COOP
#define COOP 1
#endif

#ifndef PROBE_DUP
#define PROBE_DUP 0
#endif
#define LAS __attribute__((address_space(3)))
typedef unsigned short bf16_t;
typedef short bf16x8 __attribute__((ext_vector_type(8)));
typedef float f32x4 __attribute__((ext_vector_type(4)));
typedef float f32x2 __attribute__((ext_vector_type(2)));
typedef unsigned u32x4 __attribute__((ext_vector_type(4)));
typedef unsigned u32x2 __attribute__((ext_vector_type(2)));

constexpr int T = 16384, D = 1024, FF = 2816, SEQ = 4096;
constexpr int ZW = 2816, QKVW = 1536;
constexpr float EPS = 1e-6f;
constexpr int NTHREADS = 512;
constexpr int LDS_BYTES = 147456;

constexpr size_t WS_SSQ = 0;
constexpr size_t WS_WUP = 2097152;
constexpr size_t WS_WDN = WS_WUP + 8ull * 5632 * 1024 * 2;
constexpr size_t WS_WIN = WS_WDN + 8ull * 1024 * 2816 * 2;
constexpr size_t WS_WOUT = WS_WIN + 2ull * 2816 * 1024 * 2;
constexpr size_t WS_WQKV = WS_WOUT + 2ull * 1024 * 1024 * 2;
constexpr size_t WS_WO = WS_WQKV + 2ull * 1536 * 1024 * 2;
constexpr size_t WS_WPG = WS_WO + 2ull * 1024 * 1024 * 2;
constexpr size_t WS_WPP = WS_WPG + 4ull * 1024 * 1024 * 2;
constexpr size_t WS_XB = WS_WPP + 4ull * 1024 * 256 * 2;
constexpr size_t WS_PB = WS_XB + (size_t)T * 1024 * 2;
constexpr size_t WS_HZ = WS_PB + 4ull * T * 256 * 2;
constexpr size_t WS_MIX = WS_HZ + (size_t)T * 2816 * 2;
constexpr size_t WS_SCR = WS_MIX + (size_t)T * 1024 * 2;
constexpr size_t WS_S = WS_SCR;
constexpr size_t WS_HL = WS_S + 1024ull * 8192 * 4;
constexpr size_t WS_AC = WS_HL + (size_t)T * 512 * 4;
constexpr size_t WS_CARRY = WS_AC + (size_t)T * 512 * 4;
constexpr size_t WS_DECAY = WS_CARRY + 4ull * 64 * 512 * 4;
constexpr size_t WS_CTL = WS_DECAY + 1024ull * 64 * 4;
constexpr size_t CTL_BYTES = 16384;
constexpr size_t WS_QK0 = WS_CTL + CTL_BYTES;
constexpr size_t WS_END = WS_QK0 + 8192;
constexpr size_t WS_PP = WS_SCR;

struct Params {
    const float* in[33];
    float* out;
    unsigned char* ws;
    int ph_lo, ph_hi;
};

__device__ __forceinline__ float bf_lo(unsigned w) { return __uint_as_float(w << 16); }
__device__ __forceinline__ float bf_hi(unsigned w) { return __uint_as_float(w & 0xffff0000u); }
__device__ __forceinline__ unsigned f2bf(float f) { unsigned u = __float_as_uint(f); return (u + 0x7fffu + ((u >> 16) & 1u)) >> 16; }
__device__ __forceinline__ unsigned pk2(float lo, float hi) { unsigned r; asm volatile("v_cvt_pk_bf16_f32 %0, %1, %2" : "=v"(r) : "v"(lo), "v"(hi)); return r; }
__device__ __forceinline__ float sigmoidf_(float x) { return __builtin_amdgcn_rcpf(1.0f + __expf(-x)); }
__device__ __forceinline__ float siluf_(float x) { return x * __builtin_amdgcn_rcpf(1.0f + __expf(-x)); }
__device__ __forceinline__ float gelu_tanh(float x) { const float y = 0.7978845608028654f * (x + 0.044715f * x * x * x); return x / (1.0f + __expf(-2.0f * y)); }
__device__ __forceinline__ float softplusf_(float x) { return fmaxf(x, 0.f) + log1pf(__expf(-fabsf(x))); }
__device__ __forceinline__ float logsigmoidf_(float x) { return fminf(x, 0.f) - __logf(1.0f + __expf(-fabsf(x))); }
__device__ __forceinline__ int otid() { int t = threadIdx.x; asm volatile("" : "+v"(t)); return t; }
__device__ __forceinline__ int obid() { int b = blockIdx.x; asm volatile("" : "+s"(b)); return b; }
__device__ __forceinline__ int ogrid() { int g = gridDim.x; asm volatile("" : "+s"(g)); return g; }
__device__ __forceinline__ int pinv32(int c) { return 16 * ((c >> 2) & 1) + 4 * (c >> 3) + (c & 3); }
__device__ __forceinline__ float wave_sum(float v) {
#pragma unroll
    for (int o = 1; o < 64; o <<= 1) v += __shfl_xor(v, o);
    return v;
}

namespace pg8 {
constexpr int BM = 256, BK = 64, HALF = 128, HTB = HALF * BK * 2, STAGE_BYTES = 8 * HTB, NXCD = 8, WGM = 8;
__host__ __device__ __forceinline__ int lds_byte(int r, int c) { const int st = (r >> 4) * 2 + (c >> 5), rr = r & 15, cc = c & 31, ob = rr * 64 + cc * 2; return st * 1024 + (ob ^ (((ob >> 9) & 1) << 5)); }
__host__ __device__ __forceinline__ void stage_rc(int b, int& R, int& C) { const int st = b / 1024, sb = b % 1024, swz = sb ^ (((sb >> 9) & 1) << 5); R = (st >> 1) * 16 + swz / 64; C = (st & 1) * 32 + (swz % 64) / 2; }
struct Unit { int pm, pn; };
struct Gemm { const bf16_t* A; const bf16_t* Bt; int M, N, K; };
struct StaticOrder {
    int nM, nN, nwg, G, c;
    __device__ void init(int M, int N, int G_, int c_) { nM = M / BM; nN = N / BM; nwg = nM * nN; G = G_; c = c_; }
    __device__ bool next(int i, Unit& u) const {
        const long L = (long)i * G + c; if (L >= nwg) return false;
        int wgid = (int)L; { const int q = nwg / NXCD, r = nwg % NXCD, xcd = wgid % NXCD, off = wgid / NXCD; wgid = (xcd < r ? xcd * (q + 1) : r * (q + 1) + (xcd - r) * q) + off; }
        const int nig = WGM * nN, gid = wgid / nig, fm = gid * WGM, gsz = (nM - fm) < WGM ? (nM - fm) : WGM;
        u.pm = fm + ((wgid % nig) % gsz); u.pn = (wgid % nig) / gsz; return true;
    }
};

__device__ __forceinline__ float row_scale(const float* part, int row) {
    const f32x4* p = (const f32x4*)(part + (size_t)row * 16);
    const f32x4 a = p[0], b = p[1], c = p[2], d = p[3];
    const float s = (((a[0] + a[1]) + (a[2] + a[3])) + ((b[0] + b[1]) + (b[2] + b[3]))) + (((c[0] + c[1]) + (c[2] + c[3])) + ((d[0] + d[1]) + (d[2] + d[3])));
    return rsqrtf(s * (1.0f / 1024.0f) + EPS);
}
struct Epi {
    int mode;
    const float* ssq_in;
    float* ssq_out;
    const float* xin;
    const bf16_t* hin; const bf16_t* lin; bf16_t* xb; bf16_t* lout;
    bf16_t* ob; int ldo;
    float* of;
    const float* bias;
    float alpha;
    __device__ __forceinline__ void scales2(const Unit& u, int wr, int fr, int fq, float& sA, float& sB) const {
        const int rowA = u.pm * BM + wr * 64 + fq * 16 + fr;
        const f32x4* pa = (const f32x4*)(ssq_in + (size_t)rowA * 16); const f32x4* pb = (const f32x4*)(ssq_in + (size_t)(rowA + HALF) * 16);
        const f32x4 a0 = pa[0], a1 = pa[1], a2 = pa[2], a3 = pa[3], b0 = pb[0], b1 = pb[1], b2 = pb[2], b3 = pb[3];
        const float ta = (((a0[0] + a0[1]) + (a0[2] + a0[3])) + ((a1[0] + a1[1]) + (a1[2] + a1[3]))) + (((a2[0] + a2[1]) + (a2[2] + a2[3])) + ((a3[0] + a3[1]) + (a3[2] + a3[3])));
        const float tb = (((b0[0] + b0[1]) + (b0[2] + b0[3])) + ((b1[0] + b1[1]) + (b1[2] + b1[3]))) + (((b2[0] + b2[1]) + (b2[2] + b2[3])) + ((b3[0] + b3[1]) + (b3[2] + b3[3])));
        sA = rsqrtf(ta * (1.0f / 1024.0f) + EPS); sB = rsqrtf(tb * (1.0f / 1024.0f) + EPS);
    }
    template <int mode> __device__ __forceinline__ void run(const f32x4 (&acc)[2][2][4][2], const Unit& u, int wr, int wc, int fr, int fq, const LAS float* sc) const {
        const int row0 = u.pm * BM + wr * 64 + fr;
        if (mode == 0) {
            const int col0 = u.pn * HALF + wc * 32 + 8 * fq;
#pragma unroll
            for (int ai = 0; ai < 2; ++ai)
#pragma unroll
                for (int m = 0; m < 4; ++m) {
                    const int row = row0 + ai * HALF + m * 16;
                    const float s = sc[ai * HALF + wr * 64 + m * 16 + fr];
                    const f32x4 g0 = acc[ai][0][m][0] * s, u0 = acc[ai][1][m][0] * s, g1 = acc[ai][0][m][1] * s, u1 = acc[ai][1][m][1] * s;
                    u32x4 w;
                    w.x = pk2(siluf_(g0[0]) * u0[0], siluf_(g0[1]) * u0[1]); w.y = pk2(siluf_(g0[2]) * u0[2], siluf_(g0[3]) * u0[3]);
                    w.z = pk2(siluf_(g1[0]) * u1[0], siluf_(g1[1]) * u1[1]); w.w = pk2(siluf_(g1[2]) * u1[2], siluf_(g1[3]) * u1[3]);
                    *(u32x4*)(ob + (size_t)row * FF + col0) = w;
                }
        } else if (mode == 1) {
            const int col0 = u.pn * BM + wc * 32 + 8 * fq;
            f32x4 bv[2][2];
#pragma unroll
            for (int bj = 0; bj < 2; ++bj)
#pragma unroll
                for (int n = 0; n < 2; ++n) bv[bj][n] = bias ? *(const f32x4*)(bias + col0 + bj * HALF + 4 * n) : (f32x4){0.f, 0.f, 0.f, 0.f};
#pragma unroll
            for (int ai = 0; ai < 2; ++ai)
#pragma unroll
                for (int m = 0; m < 4; ++m) {
                    const int row = row0 + ai * HALF + m * 16;
                    const float s = sc[ai * HALF + wr * 64 + m * 16 + fr];
                    bf16_t* rowp = ob + (size_t)row * ldo + col0;
#pragma unroll
                    for (int bj = 0; bj < 2; ++bj) {
                        const f32x4 v0 = acc[ai][bj][m][0] * s + bv[bj][0], v1 = acc[ai][bj][m][1] * s + bv[bj][1];
                        u32x4 w; w.x = pk2(v0[0], v0[1]); w.y = pk2(v0[2], v0[3]); w.z = pk2(v1[0], v1[1]); w.w = pk2(v1[2], v1[3]);
                        *(u32x4*)(rowp + bj * HALF) = w;
                    }
                }
        } else if (mode == 2) {
            const int col0 = u.pn * BM + wc * 32 + 8 * fq;
#pragma unroll
            for (int ai = 0; ai < 2; ++ai)
#pragma unroll
                for (int m = 0; m < 4; ++m) {
                    bf16_t* rowp = ob + (size_t)(row0 + ai * HALF + m * 16) * D + col0;
#pragma unroll
                    for (int bj = 0; bj < 2; ++bj) {
                        const f32x4 v0 = acc[ai][bj][m][0], v1 = acc[ai][bj][m][1];
                        u32x4 w; w.x = pk2(v0[0], v0[1]); w.y = pk2(v0[2], v0[3]); w.z = pk2(v1[0], v1[1]); w.w = pk2(v1[2], v1[3]);
                        *(u32x4*)(rowp + bj * HALF) = w;
                    }
                }
        } else {
            const int col0 = u.pn * BM + wc * 32 + 8 * fq;
            float sA = 1.f, sB = 1.f;
            if (mode == 4) scales2(u, wr, fr, fq, sA, sB);
            f32x4 bvv[4];
#pragma unroll
            for (int q = 0; q < 4; ++q) bvv[q] = (mode != 4 && bias) ? *(const f32x4*)(bias + col0 + (q >> 1) * HALF + (q & 1) * 4) : (f32x4){0.f, 0.f, 0.f, 0.f};
            constexpr int DEPTH = (mode == 3) ? 3 : 2;
            f32x4 xi[mode == 5 ? DEPTH : 1][4]; u32x4 pq[mode == 4 ? DEPTH : 1][2]; u32x4 xh[DEPTH][2], xl[DEPTH][2];
#pragma unroll
            for (int g0 = 0; g0 < DEPTH - 1; ++g0) {
                const size_t off = (size_t)(row0 + (g0 >> 2) * HALF + (g0 & 3) * 16) * D + col0;
#pragma unroll
                for (int bj = 0; bj < 2; ++bj) {
                    const size_t o = off + bj * HALF;
                    if (mode == 5) { xi[g0][2 * bj] = *(const f32x4*)(xin + o); xi[g0][2 * bj + 1] = *(const f32x4*)(xin + o + 4); }
                    else { xh[g0][bj] = *(const u32x4*)(hin + o); xl[g0][bj] = *(const u32x4*)(lin + o); }
                    if (mode == 4) pq[g0][bj] = *(const u32x4*)(ob + o);
                }
            }
#pragma unroll
            for (int g = 0; g < 8; ++g) {
                const int ai = g >> 2, m = g & 3, cb = g % DEPTH, nb = (g + DEPTH - 1) % DEPTH;
                const int row = row0 + ai * HALF + m * 16;
                const size_t off = (size_t)row * D + col0;
                if (g + DEPTH - 1 < 8) {
                    const int gn = g + DEPTH - 1;
                    const size_t offn = (size_t)(row0 + (gn >> 2) * HALF + (gn & 3) * 16) * D + col0;
#pragma unroll
                    for (int bj = 0; bj < 2; ++bj) {
                        const size_t o = offn + bj * HALF;
                        if (mode == 5) { xi[nb][2 * bj] = *(const f32x4*)(xin + o); xi[nb][2 * bj + 1] = *(const f32x4*)(xin + o + 4); }
                        else { xh[nb][bj] = *(const u32x4*)(hin + o); xl[nb][bj] = *(const u32x4*)(lin + o); }
                        if (mode == 4) pq[nb][bj] = *(const u32x4*)(ob + o);
                    }
                }
                float s = 1.f;
                if (mode == 4) s = __shfl(ai ? sB : sA, m * 16 + fr);
                float ss = 0.f;
#pragma unroll
                for (int bj = 0; bj < 2; ++bj) {
                    u32x4 wh, wl;
#pragma unroll
                    for (int n = 0; n < 2; ++n) {
                        const int q = 2 * bj + n;
                        const unsigned h0 = n ? xh[cb][bj].z : xh[cb][bj].x, h1 = n ? xh[cb][bj].w : xh[cb][bj].y, l0 = n ? xl[cb][bj].z : xl[cb][bj].x, l1 = n ? xl[cb][bj].w : xl[cb][bj].y;
                        f32x4 xo;
                        if (mode == 5) xo = xi[mode == 5 ? cb : 0][q];
                        else { xo[0] = bf_lo(h0) + bf_lo(l0); xo[1] = bf_hi(h0) + bf_hi(l0); xo[2] = bf_lo(h1) + bf_lo(l1); xo[3] = bf_hi(h1) + bf_hi(l1); }
                        f32x4 v;
                        if (mode != 4) v = xo + acc[ai][bj][m][n] * alpha + bvv[q];
                        else {
                            const f32x4 a = acc[ai][bj][m][n] * s;
                            const int pc = (mode == 4) ? cb : 0; const unsigned p0 = n ? pq[pc][bj].z : pq[pc][bj].x, p1 = n ? pq[pc][bj].w : pq[pc][bj].y;
                            v[0] = xo[0] + sigmoidf_(a[0]) * bf_lo(p0); v[1] = xo[1] + sigmoidf_(a[1]) * bf_hi(p0);
                            v[2] = xo[2] + sigmoidf_(a[2]) * bf_lo(p1); v[3] = xo[3] + sigmoidf_(a[3]) * bf_hi(p1);
                        }
                        const unsigned w0 = pk2(v[0], v[1]), w1 = pk2(v[2], v[3]);
                        const unsigned m0 = pk2(v[0] - bf_lo(w0), v[1] - bf_hi(w0)), m1 = pk2(v[2] - bf_lo(w1), v[3] - bf_hi(w1));
                        if (n == 0) { wh.x = w0; wh.y = w1; wl.x = m0; wl.y = m1; } else { wh.z = w0; wh.w = w1; wl.z = m0; wl.w = m1; }
                        ss += (v[0] * v[0] + v[1] * v[1]) + (v[2] * v[2] + v[3] * v[3]);
                    }
                    *(u32x4*)(xb + off + bj * HALF) = wh;
                    *(u32x4*)(lout + off + bj * HALF) = wl;
                }
                ss += __shfl_xor(ss, 16); ss += __shfl_xor(ss, 32);
                if (fq == 0) ssq_out[(size_t)row * 16 + u.pn * 4 + wc] = ss;
            }
        }
    }
};

template <int MODE, class EpiT, class Sched>
__device__ __forceinline__ void gemm_phase(LAS unsigned char* lds, const Gemm g, const Sched& S, const EpiT& E) {
    const int tid = otid(), wid = __builtin_amdgcn_readfirstlane(tid >> 6), lane = tid & 63, wr = wid >> 2, wc = wid & 3, fr = lane & 15, fq = lane >> 4;
    const int K = g.K, nt = K / BK;
    unsigned voffA[2], voffB[2];
#pragma unroll
    for (int i = 0; i < 2; ++i) { int R, C; stage_rc(tid * 16 + i * 8192, R, C); voffA[i] = (unsigned)(R * K + C) * 2u; voffB[i] = (unsigned)(R * K + C) * 2u; }
    const size_t kstep = (size_t)(BK * 2);
    const size_t hstep = (size_t)HALF * K * 2;
    const size_t tstep = 2 * hstep;
    const unsigned ldsw = (unsigned)wid * 1024u;
    const int aoff = lds_byte(wr * 64 + fr, fq * 8), boff = lds_byte(wc * 32 + fr, fq * 8);
#define PG8_SA(b, h) (((b) * 2 + (h)) * HTB)
#define PG8_SB(b, h) ((4 + (b) * 2 + (h)) * HTB)
#define PG8_STAGE(bufoff, gbase, voff) do { _Pragma("unroll") for (int _i = 0; _i < 2; ++_i) \
        __builtin_amdgcn_global_load_lds((const unsigned*)((const char*)(gbase) + (voff)[_i]), (LAS unsigned*)(lds + (bufoff) + ldsw + _i * 8192), 16, 0, 0); } while (0)
#define PG8_LDA(dst, b, h) do { _Pragma("unroll") for (int m = 0; m < 4; ++m) _Pragma("unroll") for (int k = 0; k < 2; ++k) dst[m][k] = *(const LAS bf16x8*)(lds + PG8_SA(b, h) + aoff + m * 2048 + k * 1024); } while (0)
#define PG8_LDB(dst, b, h) do { _Pragma("unroll") for (int n = 0; n < 2; ++n) _Pragma("unroll") for (int k = 0; k < 2; ++k) dst[n][k] = *(const LAS bf16x8*)(lds + PG8_SB(b, h) + boff + n * 2048 + k * 1024); } while (0)
#define PG8_MMA(ai, bj, At, Bt) do { __builtin_amdgcn_s_setprio(1); _Pragma("unroll") for (int m = 0; m < 4; ++m) _Pragma("unroll") for (int n = 0; n < 2; ++n) _Pragma("unroll") for (int k = 0; k < 2; ++k) \
        acc[ai][bj][m][n] = __builtin_amdgcn_mfma_f32_16x16x32_bf16(Bt[n][k], At[m][k], acc[ai][bj][m][n], 0, 0, 0); __builtin_amdgcn_s_setprio(0); } while (0)
#define PG8_WAIT_V(n) asm volatile("s_waitcnt vmcnt(" #n ")" ::: "memory")
#define PG8_WAIT_L(n) asm volatile("s_waitcnt lgkmcnt(" #n ")" ::: "memory")
#define PG8_BAR __builtin_amdgcn_s_barrier()
#define PG8_SCHED __builtin_amdgcn_sched_barrier(0)
    Unit cur, nxt; int ui = 0;
    if (!S.next(0, cur)) return;
    LAS float* SC = (LAS float*)(lds + STAGE_BYTES);
    if (MODE <= 1) {
        f32x4 pa[6], pb[6]; bool ok[6];
#pragma unroll
        for (int i = 0; i < 6; ++i) {
            Unit uu; ok[i] = S.next(i, uu);
            const int row = (ok[i] ? uu.pm : cur.pm) * BM + (tid >> 1);
            const f32x4* p = (const f32x4*)(E.ssq_in + (size_t)row * 16) + (tid & 1) * 2;
            pa[i] = p[0]; pb[i] = p[1];
        }
#pragma unroll
        for (int i = 0; i < 6; ++i) {
            float s = ((pa[i][0] + pa[i][1]) + (pa[i][2] + pa[i][3])) + ((pb[i][0] + pb[i][1]) + (pb[i][2] + pb[i][3]));
            s += __shfl_xor(s, 1);
            if (!(tid & 1)) SC[i * 256 + (tid >> 1)] = rsqrtf(s * (1.0f / 1024.0f) + EPS);
        }
        __syncthreads();
    }
    f32x4 acc[2][2][4][2];
#pragma unroll
    for (int a = 0; a < 2; ++a)
#pragma unroll
        for (int b = 0; b < 2; ++b)
#pragma unroll
            for (int m = 0; m < 4; ++m)
#pragma unroll
                for (int n = 0; n < 2; ++n) acc[a][b][m][n] = (f32x4){0.f, 0.f, 0.f, 0.f};
    bf16x8 At[4][2], B0[2][2], B1[2][2];
    const char* cA = (const char*)g.A + (size_t)cur.pm * tstep; const char* cB = (const char*)g.Bt + (size_t)cur.pn * tstep;
    PG8_STAGE(PG8_SB(0, 0), cB, voffB); PG8_STAGE(PG8_SA(0, 0), cA, voffA); PG8_STAGE(PG8_SB(0, 1), cB + hstep, voffB); PG8_STAGE(PG8_SA(0, 1), cA + hstep, voffA);
    if (wr == 1) PG8_BAR;
    PG8_WAIT_V(4); PG8_BAR;
    PG8_STAGE(PG8_SB(1, 0), cB + kstep, voffB); PG8_STAGE(PG8_SA(1, 0), cA + kstep, voffA); PG8_STAGE(PG8_SB(1, 1), cB + hstep + kstep, voffB);
    PG8_WAIT_V(6); PG8_BAR;
    for (;;) {
        const bool has_next = S.next(ui + 1, nxt);
        const char* nA = has_next ? (const char*)g.A + (size_t)nxt.pm * tstep : cA; const char* nB = has_next ? (const char*)g.Bt + (size_t)nxt.pn * tstep : cB;
        for (int t = 0; t < nt; t += 2) {
            const bool last = (t == nt - 2);
            const char* a1 = cA + (size_t)(t + 1) * kstep;
            const char* a2 = last ? nA : cA + (size_t)(t + 2) * kstep; const char* b2 = last ? nB : cB + (size_t)(t + 2) * kstep;
            const char* a3 = a2 + kstep; const char* b3 = b2 + kstep;
            PG8_LDB(B0, 0, 0); PG8_SCHED; PG8_LDA(At, 0, 0); PG8_STAGE(PG8_SA(1, 1), a1 + hstep, voffA);
            PG8_WAIT_L(8); PG8_BAR; PG8_WAIT_L(0); PG8_MMA(0, 0, At, B0); PG8_BAR; PG8_SCHED;
            PG8_LDB(B1, 0, 1); PG8_STAGE(PG8_SB(0, 0), b2, voffB);
            PG8_BAR; PG8_WAIT_L(0); PG8_MMA(0, 1, At, B1); PG8_BAR;
            PG8_LDA(At, 0, 1); PG8_STAGE(PG8_SA(0, 0), a2, voffA);
            PG8_BAR; PG8_WAIT_L(0); PG8_MMA(1, 0, At, B0); PG8_BAR; PG8_SCHED;
            PG8_STAGE(PG8_SB(0, 1), b2 + hstep, voffB);
            PG8_WAIT_V(6); PG8_BAR; PG8_MMA(1, 1, At, B1); PG8_BAR;
            PG8_LDB(B0, 1, 0); PG8_SCHED; PG8_LDA(At, 1, 0); PG8_STAGE(PG8_SA(0, 1), a2 + hstep, voffA);
            PG8_WAIT_L(8); PG8_BAR; PG8_WAIT_L(0); PG8_MMA(0, 0, At, B0); PG8_BAR; PG8_SCHED;
            PG8_LDB(B1, 1, 1); PG8_STAGE(PG8_SB(1, 0), b3, voffB);
            PG8_BAR; PG8_WAIT_L(0); PG8_MMA(0, 1, At, B1); PG8_BAR;
            PG8_LDA(At, 1, 1); PG8_STAGE(PG8_SA(1, 0), a3, voffA);
            PG8_BAR; PG8_WAIT_L(0); PG8_MMA(1, 0, At, B0); PG8_BAR; PG8_SCHED;
            PG8_STAGE(PG8_SB(1, 1), b3 + hstep, voffB);
            PG8_WAIT_V(6); PG8_BAR; PG8_MMA(1, 1, At, B1); PG8_BAR;
        }
        E.template run<MODE>(acc, cur, wr, wc, fr, fq, SC + ui * 256);
        if (!has_next) break;
#pragma unroll
        for (int a = 0; a < 2; ++a)
#pragma unroll
            for (int b = 0; b < 2; ++b)
#pragma unroll
                for (int m = 0; m < 4; ++m)
#pragma unroll
                    for (int n = 0; n < 2; ++n) acc[a][b][m][n] = (f32x4){0.f, 0.f, 0.f, 0.f};
        cur = nxt; cA = nA; cB = nB; ++ui;
    }
    PG8_WAIT_V(0);
    if (wr == 0) PG8_BAR;
    PG8_BAR;
#undef PG8_SA
#undef PG8_SB
#undef PG8_STAGE
#undef PG8_LDA
#undef PG8_LDB
#undef PG8_MMA
#undef PG8_WAIT_V
#undef PG8_WAIT_L
#undef PG8_BAR
#undef PG8_SCHED
}
}

__device__ __forceinline__ void run_gemm(LAS unsigned char* lds, const bf16_t* A, const bf16_t* Bt, int N, int K, const pg8::Epi& E, int c0 = 0) {
    const int G_ = ogrid() - c0, c_ = obid() - c0;
    if (c_ < 0) return;
    pg8::Gemm g{A, Bt, T, N, K}; pg8::StaticOrder S; S.init(T, N, G_, c_);
    switch (E.mode) {
    case 0: pg8::gemm_phase<0, pg8::Epi, pg8::StaticOrder>(lds, g, S, E); break;
    case 1: pg8::gemm_phase<1, pg8::Epi, pg8::StaticOrder>(lds, g, S, E); break;
    case 2: pg8::gemm_phase<2, pg8::Epi, pg8::StaticOrder>(lds, g, S, E); break;
    case 3: pg8::gemm_phase<3, pg8::Epi, pg8::StaticOrder>(lds, g, S, E); break;
    case 4: pg8::gemm_phase<4, pg8::Epi, pg8::StaticOrder>(lds, g, S, E); break;
    default: pg8::gemm_phase<5, pg8::Epi, pg8::StaticOrder>(lds, g, S, E); break;
    }
}

struct CvtJob { const float* W; const float* gain; bf16_t* dst; int K, ldw, col0, ncols, mode; };

__device__ __forceinline__ CvtJob get_job(const Params& P, int j) {
    CvtJob J; J.gain = nullptr; J.col0 = 0; J.mode = 0;
    unsigned char* ws = P.ws;
    if (j < 16) {
        const int f = j >> 1, part = j & 1, L = f >> 1, w = f & 1;
        const float* src = w ? (part ? P.in[11] : P.in[10]) : (part ? P.in[6] : P.in[5]);
        J.W = src + (size_t)L * 1024 * 2816; J.gain = (w ? P.in[9] : P.in[4]) + L * 1024;
        J.dst = (bf16_t*)(ws + WS_WUP) + (size_t)f * 5632 * 1024 + (size_t)part * 128 * 1024;
        J.K = 1024; J.ldw = 2816; J.ncols = 2816; J.mode = 1;
    } else if (j < 24) {
        const int f = j - 16, L = f >> 1, w = f & 1;
        J.W = (w ? P.in[12] : P.in[7]) + (size_t)L * 2816 * 1024;
        J.dst = (bf16_t*)(ws + WS_WDN) + (size_t)f * 1024 * 2816;
        J.K = 2816; J.ldw = 1024; J.ncols = 1024;
    } else if (j < 28) {
        const int e = (j - 24) >> 1, part = (j - 24) & 1;
        J.W = P.in[16] + (size_t)e * 1024 * 2576; J.gain = P.in[8] + (2 * e) * 1024;
        J.dst = (bf16_t*)(ws + WS_WIN) + (size_t)e * 2816 * 1024 + (part ? (size_t)1536 * 1024 : 0);
        J.K = 1024; J.ldw = 2576; J.col0 = part ? 1552 : 0; J.ncols = part ? 1024 : 1536;
    } else if (j < 30) {
        const int e = j - 28;
        J.W = P.in[17] + (size_t)e * 1024 * 1024; J.dst = (bf16_t*)(ws + WS_WOUT) + (size_t)e * 1024 * 1024;
        J.K = 1024; J.ldw = 1024; J.ncols = 1024;
    } else if (j < 32) {
        const int o = j - 30;
        J.W = P.in[28] + (size_t)o * 1024 * 1536; J.gain = P.in[8] + (2 * o + 1) * 1024;
        J.dst = (bf16_t*)(ws + WS_WQKV) + (size_t)o * 1536 * 1024;
        J.K = 1024; J.ldw = 1536; J.ncols = 1536;
    } else if (j < 34) {
        const int o = j - 32;
        J.W = P.in[30] + (size_t)o * 1024 * 1024; J.dst = (bf16_t*)(ws + WS_WO) + (size_t)o * 1024 * 1024;
        J.K = 1024; J.ldw = 1024; J.ncols = 1024;
    } else if (j < 38) {
        const int L = j - 34;
        J.W = P.in[15] + (size_t)L * 1024 * 1024; J.gain = P.in[13] + L * 1024;
        J.dst = (bf16_t*)(ws + WS_WPG) + (size_t)L * 1024 * 1024;
        J.K = 1024; J.ldw = 1024; J.ncols = 1024;
    } else {
        const int L = j - 38;
        J.W = P.in[14] + (size_t)L * 256 * 1024; J.dst = (bf16_t*)(ws + WS_WPP) + (size_t)L * 1024 * 256;
        J.K = 256; J.ldw = 1024; J.ncols = 1024;
    }
    return J;
}

__device__ __forceinline__ void cvt_item64(const CvtJob& J, int item, LAS float* scr, int lane) {
    const int nblk = J.ncols / 64, kb = item / nblk, nb = item - kb * nblk, k0 = 64 * kb, n0 = 64 * nb;
    const int r4 = lane >> 4, c4 = (lane & 15) * 4;
    f32x4 w[16];
#pragma unroll
    for (int i = 0; i < 16; ++i) w[i] = *(const f32x4*)(J.W + (size_t)(k0 + 4 * i + r4) * J.ldw + J.col0 + n0 + c4);
    if (J.gain) {
#pragma unroll
        for (int i = 0; i < 16; ++i) w[i] = w[i] * J.gain[k0 + 4 * i + r4];
    }
#pragma unroll
    for (int i = 0; i < 16; ++i) { LAS float* d = scr + (4 * i + r4) * 65 + c4; d[0] = w[i][0]; d[1] = w[i][1]; d[2] = w[i][2]; d[3] = w[i][3]; }
    asm volatile("s_waitcnt lgkmcnt(0)" ::: "memory");
    const int c = lane & 7;
#pragma unroll
    for (int j = 0; j < 8; ++j) {
        const int n = (lane >> 3) + 8 * j; const LAS float* s = scr + (8 * c) * 65 + n;
        u32x4 o; o.x = pk2(s[0 * 65], s[1 * 65]); o.y = pk2(s[2 * 65], s[3 * 65]); o.z = pk2(s[4 * 65], s[5 * 65]); o.w = pk2(s[6 * 65], s[7 * 65]);
        const int nn = n0 + n; const int row_ = J.mode ? ((nn >> 7) * 256 + (nn & 127)) : nn;
        const int row = (row_ & ~31) + pinv32(row_ & 31);
        *(u32x4*)(J.dst + (size_t)row * J.K + k0 + 8 * c) = o;
    }
    asm volatile("s_waitcnt lgkmcnt(0)" ::: "memory");
}
__device__ __forceinline__ void cvt_map(int it, int& job, int& local) {
    if (it < 16896) { job = it / 704; local = it - job * 704; }
    else {
        int r = it - 16896;
        if (r < 1280) { const int e = r / 640, rr = r - e * 640, part = rr >= 384; local = part ? rr - 384 : rr; job = 24 + 2 * e + part; }
        else { r -= 1280;
            if (r < 512) { job = 28 + (r >> 8); local = r & 255; }
            else { r -= 512;
                if (r < 768) { const int o = r / 384; job = 30 + o; local = r - o * 384; }
                else { r -= 768;
                    if (r < 1536) { job = 32 + (r >> 8); local = r & 255; }
                    else { r -= 1536; job = 38 + (r >> 6); local = r & 63; } } } }
    }
}

__device__ __forceinline__ void first_token_qk(const Params& P, LAS unsigned char* lds, int L, int c0) {
    const int j = obid() - c0;
    if (j < 0 || j >= 64) return;
    const int e = L >> 1, tid = otid(), col = tid & 7, dg = tid >> 3;
    const float* W = P.in[16] + (size_t)e * 1024 * 2576 + 8 * j + col;
    float w[16];
#pragma unroll
    for (int q = 0; q < 16; ++q) w[q] = W[(size_t)(dg * 16 + q) * 2576];
    LAS float* X = (LAS float*)lds;
    {
        const int b = tid >> 7, d0 = (tid & 127) * 8;
        const size_t o = (size_t)(b * SEQ) * D + d0;
        const u32x4 h8 = *(const u32x4*)((const bf16_t*)(P.ws + WS_XB) + o), l8 = *(const u32x4*)((const bf16_t*)P.out + o);
        const f32x4 g0 = *(const f32x4*)(P.in[8] + L * 1024 + d0), g1 = *(const f32x4*)(P.in[8] + L * 1024 + d0 + 4);
        f32x4 a, c;
        a[0] = (bf_lo(h8.x) + bf_lo(l8.x)) * g0[0]; a[1] = (bf_hi(h8.x) + bf_hi(l8.x)) * g0[1]; a[2] = (bf_lo(h8.y) + bf_lo(l8.y)) * g0[2]; a[3] = (bf_hi(h8.y) + bf_hi(l8.y)) * g0[3];
        c[0] = (bf_lo(h8.z) + bf_lo(l8.z)) * g1[0]; c[1] = (bf_hi(h8.z) + bf_hi(l8.z)) * g1[1]; c[2] = (bf_lo(h8.w) + bf_lo(l8.w)) * g1[2]; c[3] = (bf_hi(h8.w) + bf_hi(l8.w)) * g1[3];
        *(LAS f32x4*)(X + b * 1024 + d0) = a; *(LAS f32x4*)(X + b * 1024 + d0 + 4) = c;
    }
    __syncthreads();
    float acc[4] = {0.f, 0.f, 0.f, 0.f};
#pragma unroll
    for (int b = 0; b < 4; ++b)
#pragma unroll
        for (int q4 = 0; q4 < 4; ++q4) {
            const f32x4 xv = *(const LAS f32x4*)(X + b * 1024 + dg * 16 + 4 * q4);
            acc[b] += xv[0] * w[4 * q4] + xv[1] * w[4 * q4 + 1] + xv[2] * w[4 * q4 + 2] + xv[3] * w[4 * q4 + 3];
        }
    LAS float* R = X + 4096;
#pragma unroll
    for (int b = 0; b < 4; ++b) R[(dg * 8 + col) * 4 + b] = acc[b];
    __syncthreads();
    if (tid < 32) {
        const int c = tid & 7, b = tid >> 3;
        float s = 0.f;
        for (int g = 0; g < 64; ++g) s += R[(g * 8 + c) * 4 + b];
        const float* ssq = (const float*)(P.ws + WS_SSQ) + (size_t)((4 * L + 1) & 1) * T * 16;
        ((float*)(P.ws + WS_QK0))[b * 512 + 8 * j + c] = s * pg8::row_scale(ssq, b * SEQ);
    }
    __syncthreads();
}

__device__ __forceinline__ void layer_small_cvt(const Params& P, int L, int c0) {
    const int nb = ogrid() - c0, bi = obid() - c0;
    if (bi < 0) return;
    const int gt = bi * NTHREADS + otid(), NGT = nb * NTHREADS;
    unsigned char* ws = P.ws;
    const f32x4* p4 = (const f32x4*)P.in[1] + (size_t)L * (T * 256 / 4); u32x2* pb = (u32x2*)(ws + WS_PB) + (size_t)L * (T * 256 / 4);
#pragma unroll 8
    for (int i = gt; i < T * 256 / 4; i += NGT) { const f32x4 v = p4[i]; u32x2 w; w.x = pk2(v[0], v[1]); w.y = pk2(v[2], v[3]); pb[i] = w; }
    if (!(L & 1)) {
        const int e = L >> 1;
        for (int idx = gt; idx < 256 * 1024; idx += NGT) {
            const int n = idx >> 10, k = idx & 1023;
            const float* wi = P.in[16] + (size_t)e * 1024 * 2576 + (size_t)k * 2576 + 1536;
            const float* wf = P.in[18] + e * 16 * 256 + n;
            float s = 0.f;
#pragma unroll
            for (int r = 0; r < 16; ++r) s += wi[r] * wf[r * 256];
            s *= P.in[8][(2 * e) * 1024 + k];
            ((bf16_t*)(ws + WS_WIN))[(size_t)e * 2816 * 1024 + (size_t)(2560 + (n & ~31) + pinv32(n & 31)) * 1024 + k] = (bf16_t)f2bf(s);
        }
    }
}

__device__ __forceinline__ void phase_prepass(const Params& P, LAS unsigned char* lds) {
    const int tid = otid(), lane = tid & 63, wave = tid >> 6;
    const int gw = obid() * 8 + wave, NGW = ogrid() * 8;
    const int gt = obid() * NTHREADS + tid, NGT = ogrid() * NTHREADS;
    unsigned char* ws = P.ws;
    LAS float* scr = (LAS float*)(lds + wave * 16640);
    for (int rp_ = 0; rp_ < (PROBE_DUP == 9 ? 2 : 1); ++rp_)
    for (int it = gw; it < 21248; it += NGW) {
        int job, local; cvt_map(it, job, local);
        const CvtJob J = get_job(P, job);
        cvt_item64(J, local, scr, lane);
    }
    float* ssq = (float*)(ws + WS_SSQ);
    bf16_t* xb = (bf16_t*)(ws + WS_MIX);
    for (int m = gw; m < T; m += NGW) {
        const f32x4* xr = (const f32x4*)(P.in[0] + (size_t)m * D) + lane;
        f32x4 v[4]; float s = 0.f;
#pragma unroll
        for (int j = 0; j < 4; ++j) { v[j] = xr[64 * j]; s += (v[j][0] * v[j][0] + v[j][1] * v[j][1]) + (v[j][2] * v[j][2] + v[j][3] * v[j][3]); }
        s = wave_sum(s);
        u32x2* o8 = (u32x2*)(xb + (size_t)m * D) + lane;
#pragma unroll
        for (int j = 0; j < 4; ++j) { u32x2 w; w.x = pk2(v[j][0], v[j][1]); w.y = pk2(v[j][2], v[j][3]); o8[64 * j] = w; }
        if (lane < 16) ssq[(size_t)m * 16 + lane] = (lane == 0) ? s : 0.f;
    }
}

constexpr int LDT = 68;
constexpr int GO_BT = 0, GO_SEG = 4352, GO_QDT = 4864, GO_KDNT = 9216, GO_ATT = 13568, GO_V = 17920, GO_S = 26112;

template <bool WITH_Q>
__device__ __forceinline__ void gla_prolog(LAS float* L, const u32x4 k8, const u32x4 f8, const u32x4 q8, const f32x4 bf0, const f32x4 bf1, float (&kv)[8], float (&qv)[8]) {
    const int tid = otid(), lane = tid & 63, wave = tid >> 6;
    kv[0] = bf_lo(k8.x); kv[1] = bf_hi(k8.x); kv[2] = bf_lo(k8.y); kv[3] = bf_hi(k8.y); kv[4] = bf_lo(k8.z); kv[5] = bf_hi(k8.z); kv[6] = bf_lo(k8.w); kv[7] = bf_hi(k8.w);
    if (WITH_Q) {
        qv[0] = bf_lo(q8.x); qv[1] = bf_hi(q8.x); qv[2] = bf_lo(q8.y); qv[3] = bf_hi(q8.y); qv[4] = bf_lo(q8.z); qv[5] = bf_hi(q8.z); qv[6] = bf_lo(q8.w); qv[7] = bf_hi(q8.w);
    }
    float fv[8];
    fv[0] = bf_lo(f8.x); fv[1] = bf_hi(f8.x); fv[2] = bf_lo(f8.y); fv[3] = bf_hi(f8.y); fv[4] = bf_lo(f8.z); fv[5] = bf_hi(f8.z); fv[6] = bf_lo(f8.w); fv[7] = bf_hi(f8.w);
#pragma unroll
    for (int j = 0; j < 8; ++j) L[GO_BT + (8 * wave + j) * LDT + lane] = logsigmoidf_(fv[j] + (j < 4 ? bf0[j & 3] : bf1[j & 3])) * (1.0f / 16.0f);
    __syncthreads();
    float pr[8];
    {
        const f32x4 a = *(const LAS f32x4*)(L + GO_BT + lane * LDT + 8 * wave), b = *(const LAS f32x4*)(L + GO_BT + lane * LDT + 8 * wave + 4);
        pr[0] = a[0]; pr[1] = pr[0] + a[1]; pr[2] = pr[1] + a[2]; pr[3] = pr[2] + a[3]; pr[4] = pr[3] + b[0]; pr[5] = pr[4] + b[1]; pr[6] = pr[5] + b[2]; pr[7] = pr[6] + b[3];
        L[GO_SEG + wave * 64 + lane] = pr[7];
    }
    __syncthreads();
    {
        float off = 0.f;
        for (int s = 0; s < wave; ++s) off += L[GO_SEG + s * 64 + lane];
        f32x4 a, b; a[0] = pr[0] + off; a[1] = pr[1] + off; a[2] = pr[2] + off; a[3] = pr[3] + off; b[0] = pr[4] + off; b[1] = pr[5] + off; b[2] = pr[6] + off; b[3] = pr[7] + off;
        *(LAS f32x4*)(L + GO_BT + lane * LDT + 8 * wave) = a; *(LAS f32x4*)(L + GO_BT + lane * LDT + 8 * wave + 4) = b;
    }
    __syncthreads();
}

constexpr int MLD = 72;
constexpr int GB_QDB = 19456, GB_KDB = 28672, GB_VT = 37888, GB_STB = 56320, GB_RED = 74752;

__device__ __forceinline__ void stage_vT(LAS unsigned char* lds, int tid, const u32x4 (&vv)[2]) {
    LAS bf16_t* VT = (LAS bf16_t*)(lds + GB_VT);
#pragma unroll
    for (int r = 0; r < 2; ++r) {
        const int c = r * 512 + tid, j = c & 63, vc = c >> 6;
        const u32x4 v = vv[r];
        LAS bf16_t* d = VT + (32 * (vc >> 2) + 4 * (vc & 3)) * MLD + j;
        d[0 * MLD] = (bf16_t)(v.x & 0xffffu); d[1 * MLD] = (bf16_t)(v.x >> 16); d[2 * MLD] = (bf16_t)(v.y & 0xffffu); d[3 * MLD] = (bf16_t)(v.y >> 16);
        d[16 * MLD] = (bf16_t)(v.z & 0xffffu); d[17 * MLD] = (bf16_t)(v.z >> 16); d[18 * MLD] = (bf16_t)(v.w & 0xffffu); d[19 * MLD] = (bf16_t)(v.w >> 16);
    }
}

#define GLA_LOAD(ITEM, WITHQ) do { const int h_ = (ITEM) & 3, bn_ = (ITEM) >> 2, t0_ = (bn_ >> 6) * SEQ + (bn_ & 63) * 64; \
        const bf16_t* z_ = (const bf16_t*)(P.ws + WS_HZ) + (size_t)(t0_ + lane) * ZW; \
        k8 = *(const u32x4*)(z_ + 256 + h_ * 64 + 8 * wave); f8 = *(const u32x4*)(z_ + 2560 + h_ * 64 + 8 * wave); \
        if (WITHQ) q8 = *(const u32x4*)(z_ + h_ * 64 + 8 * wave); \
        _Pragma("unroll") for (int r_ = 0; r_ < 2; ++r_) { const int c_ = r_ * 512 + tid; \
            vv[r_] = *(const u32x4*)((const bf16_t*)(P.ws + WS_HZ) + (size_t)(t0_ + (c_ & 63)) * ZW + 512 + h_ * 128 + (c_ >> 6) * 8); } \
        const float* bfp_ = P.in[19] + e * 256 + h_ * 64 + 8 * wave; bf0 = *(const f32x4*)bfp_; bf1 = *(const f32x4*)(bfp_ + 4); } while (0)

__device__ __forceinline__ void phase_g1(const Params& P, LAS unsigned char* lds, int e) {
    LAS float* L = (LAS float*)lds;
    const int tid = otid(), lane = tid & 63, wave = tid >> 6, l15 = lane & 15, quad = lane >> 4;
    float* Sbuf = (float*)(P.ws + WS_S); float* decay = (float*)(P.ws + WS_DECAY);
    LAS bf16_t* KDB = (LAS bf16_t*)(lds + GB_KDB); LAS bf16_t* VT = (LAS bf16_t*)(lds + GB_VT);
    u32x4 k8, f8, q8 = (u32x4){0u, 0u, 0u, 0u}, vv[2]; f32x4 bf0, bf1;
    const int gstep = ogrid(), item0 = obid();
    if (item0 < 1024) GLA_LOAD(item0, false);
    for (int item = item0; item < 1024; item += gstep) {
        float kv[8], qv[8];
        gla_prolog<false>(L, k8, f8, q8, bf0, bf1, kv, qv);
#pragma unroll
        for (int j = 0; j < 8; ++j) {
            const float bv = L[GO_BT + (8 * wave + j) * LDT + lane], bl = L[GO_BT + (8 * wave + j) * LDT + 63];
            KDB[(8 * wave + j) * MLD + lane] = (bf16_t)f2bf(kv[j] * __expf(bl - bv));
        }
        stage_vT(lds, tid, vv);
        if (item + gstep < 1024) GLA_LOAD(item + gstep, false);
        if (tid < 64) decay[item * 64 + tid] = __expf(L[GO_BT + tid * LDT + 63]);
        __syncthreads();
        const int dk0 = 16 * (wave & 3);
        const bf16x8 bk0 = *(const LAS bf16x8*)(KDB + (dk0 + l15) * MLD + 8 * quad), bk1 = *(const LAS bf16x8*)(KDB + (dk0 + l15) * MLD + 32 + 8 * quad);
#pragma unroll
        for (int t = 0; t < 4; ++t) {
            const int dv0 = 16 * ((wave >> 2) * 4 + t);
            const bf16x8 a0 = *(const LAS bf16x8*)(VT + (dv0 + l15) * MLD + 8 * quad), a1 = *(const LAS bf16x8*)(VT + (dv0 + l15) * MLD + 32 + 8 * quad);
            f32x4 acc = (f32x4){0.f, 0.f, 0.f, 0.f};
            acc = __builtin_amdgcn_mfma_f32_16x16x32_bf16(a0, bk0, acc, 0, 0, 0);
            acc = __builtin_amdgcn_mfma_f32_16x16x32_bf16(a1, bk1, acc, 0, 0, 0);
            const int tp = (wave >> 2) * 4 + t;
            float* o = Sbuf + (size_t)item * 8192 + (32 * (tp >> 1) + 8 * quad + 4 * (tp & 1)) * 64 + dk0 + l15;
            o[0] = acc[0]; o[64] = acc[1]; o[128] = acc[2]; o[192] = acc[3];
        }
        __syncthreads();
    }
}

__device__ __forceinline__ void phase_g2(const Params& P) {
    const float* Sbuf = (const float*)(P.ws + WS_S); const float* decay = (const float*)(P.ws + WS_DECAY);
    bf16_t* Sb = (bf16_t*)P.out + (size_t)T * D;
    for (int idx = obid() * NTHREADS + otid(); idx < 16 * 8192; idx += ogrid() * NTHREADS) {
        const int bh = idx >> 13, el = idx & 8191, b = bh >> 2, h = bh & 3, dk = el & 63;
        float run = 0.f;
        for (int n0 = 0; n0 < 64; n0 += 32) {
            float kvn[32], dc[32];
#pragma unroll
            for (int j = 0; j < 32; ++j) { const int item = ((b * 64 + n0 + j) << 2) + h; kvn[j] = Sbuf[(size_t)item * 8192 + el]; dc[j] = decay[item * 64 + dk]; }
#pragma unroll
            for (int j = 0; j < 32; ++j) { const int item = ((b * 64 + n0 + j) << 2) + h; Sb[(size_t)item * 8192 + el] = (bf16_t)f2bf(run); run = dc[j] * run + kvn[j]; }
        }
    }
}

__device__ __forceinline__ void phase_g3(const Params& P, LAS unsigned char* lds, int e) {
    LAS float* L = (LAS float*)lds;
    const int tid = otid(), lane = tid & 63, wave = tid >> 6, l15 = lane & 15, quad = lane >> 4;
    const bf16_t* Sb = (const bf16_t*)P.out + (size_t)T * D;
    const bf16_t* zb = (const bf16_t*)(P.ws + WS_HZ);
    bf16_t* mix = (bf16_t*)(P.ws + WS_MIX);
    LAS bf16_t* QDB = (LAS bf16_t*)(lds + GB_QDB); LAS bf16_t* KDB = (LAS bf16_t*)(lds + GB_KDB); LAS bf16_t* VT = (LAS bf16_t*)(lds + GB_VT); LAS bf16_t* STB = (LAS bf16_t*)(lds + GB_STB);
    LAS float* RED = (LAS float*)(lds + GB_RED);
    u32x4 k8, f8, q8, vv[2], sv[2]; f32x4 bf0, bf1;
    const int gstep = ogrid(), item0 = obid();
#define G3_LOADS(ITEM) do { _Pragma("unroll") for (int r_ = 0; r_ < 2; ++r_) sv[r_] = *(const u32x4*)(Sb + (size_t)(ITEM) * 8192 + 8 * (r_ * 512 + tid)); } while (0)
    if (item0 < 1024) { GLA_LOAD(item0, true); G3_LOADS(item0); }
    for (int item = item0; item < 1024; item += gstep) {
        const int h = item & 3, bn = item >> 2, b = bn >> 6, n = bn & 63;
        const int t0 = b * SEQ + n * 64;
        float kv[8], qv[8];
        gla_prolog<true>(L, k8, f8, q8, bf0, bf1, kv, qv);
        {
            float qd[8], kd[8];
#pragma unroll
            for (int j = 0; j < 8; ++j) {
                const float bv = L[GO_BT + (8 * wave + j) * LDT + lane];
                qd[j] = qv[j] * 0.125f * __expf(bv); kd[j] = kv[j] * __expf(-bv);
            }
            u32x4 wq, wk;
            wq.x = pk2(qd[0], qd[1]); wq.y = pk2(qd[2], qd[3]); wq.z = pk2(qd[4], qd[5]); wq.w = pk2(qd[6], qd[7]);
            wk.x = pk2(kd[0], kd[1]); wk.y = pk2(kd[2], kd[3]); wk.z = pk2(kd[4], kd[5]); wk.w = pk2(kd[6], kd[7]);
            *(LAS u32x4*)(QDB + lane * MLD + 8 * wave) = wq; *(LAS u32x4*)(KDB + lane * MLD + 8 * wave) = wk;
        }
        stage_vT(lds, tid, vv);
#pragma unroll
        for (int r = 0; r < 2; ++r) {
            const int c = r * 512 + tid, v = c >> 3, k8i = (c & 7) * 8;
            *(LAS u32x4*)(STB + ((v & ~31) + pinv32(v & 31)) * MLD + k8i) = sv[r];
        }
        if (item + gstep < 1024) { GLA_LOAD(item + gstep, true); G3_LOADS(item + gstep); }
        __syncthreads();
        const int it = wave & 3, i0 = 16 * it, vh = wave >> 2;
        const bf16x8 bq0 = *(const LAS bf16x8*)(QDB + (i0 + l15) * MLD + 8 * quad), bq1 = *(const LAS bf16x8*)(QDB + (i0 + l15) * MLD + 32 + 8 * quad);
        f32x4 s[4];
#pragma unroll
        for (int jt = 0; jt < 4; ++jt) {
            const bf16x8 a0 = *(const LAS bf16x8*)(KDB + (16 * jt + l15) * MLD + 8 * quad), a1 = *(const LAS bf16x8*)(KDB + (16 * jt + l15) * MLD + 32 + 8 * quad);
            f32x4 z = (f32x4){0.f, 0.f, 0.f, 0.f};
            z = __builtin_amdgcn_mfma_f32_16x16x32_bf16(a0, bq0, z, 0, 0, 0);
            z = __builtin_amdgcn_mfma_f32_16x16x32_bf16(a1, bq1, z, 0, 0, 0);
#pragma unroll
            for (int r = 0; r < 4; ++r) z[r] = (16 * jt + 4 * quad + r <= i0 + l15) ? z[r] : 0.f;
            s[jt] = z;
            if (jt == 0 && n == 0 && it == 0) {
                const float* qk = (const float*)(P.ws + WS_QK0) + b * 512 + h * 64 + lane;
                const float c0v = wave_sum(qk[0] * qk[256]) * 0.125f;
                if (lane == 0) s[0][0] = c0v;
            }
        }
        bf16x8 pf[2];
#pragma unroll
        for (int jp = 0; jp < 2; ++jp) {
            u32x4 pw; pw.x = pk2(s[2 * jp][0], s[2 * jp][1]); pw.y = pk2(s[2 * jp][2], s[2 * jp][3]); pw.z = pk2(s[2 * jp + 1][0], s[2 * jp + 1][1]); pw.w = pk2(s[2 * jp + 1][2], s[2 * jp + 1][3]);
            pf[jp] = __builtin_bit_cast(bf16x8, pw);
        }
        f32x4 o[4]; float ss = 0.f;
#pragma unroll
        for (int t = 0; t < 4; ++t) {
            const int v0 = 16 * (vh * 4 + t);
            f32x4 acc = (f32x4){0.f, 0.f, 0.f, 0.f};
#pragma unroll
            for (int jp = 0; jp < 2; ++jp) {
                const LAS bf16_t* vp = VT + (v0 + l15) * MLD + 32 * jp + 4 * quad;
                const u32x2 va = *(const LAS u32x2*)vp, vb = *(const LAS u32x2*)(vp + 16);
                u32x4 vw; vw.x = va.x; vw.y = va.y; vw.z = vb.x; vw.w = vb.y;
                acc = __builtin_amdgcn_mfma_f32_16x16x32_bf16(__builtin_bit_cast(bf16x8, vw), pf[jp], acc, 0, 0, 0);
            }
            const bf16x8 s0 = *(const LAS bf16x8*)(STB + (v0 + l15) * MLD + 8 * quad), s1 = *(const LAS bf16x8*)(STB + (v0 + l15) * MLD + 32 + 8 * quad);
            acc = __builtin_amdgcn_mfma_f32_16x16x32_bf16(s0, bq0, acc, 0, 0, 0);
            acc = __builtin_amdgcn_mfma_f32_16x16x32_bf16(s1, bq1, acc, 0, 0, 0);
            o[t] = acc;
            ss += (acc[0] * acc[0] + acc[1] * acc[1]) + (acc[2] * acc[2] + acc[3] * acc[3]);
        }
        ss += __shfl_xor(ss, 16); ss += __shfl_xor(ss, 32);
        if (quad == 0) RED[vh * 64 + i0 + l15] = ss;
        __syncthreads();
        const float rs = rsqrtf((RED[i0 + l15] + RED[64 + i0 + l15]) * (1.0f / 128.0f) + EPS);
        const size_t tok = (size_t)(t0 + i0 + l15);
#pragma unroll
        for (int a = 0; a < 2; ++a) {
            const int v = 32 * (vh * 2 + a) + 8 * quad;
            const f32x4 ng0 = *(const f32x4*)(P.in[20] + e * 512 + h * 128 + v), ng1 = *(const f32x4*)(P.in[20] + e * 512 + h * 128 + v + 4);
            const u32x4 r4 = *(const u32x4*)(zb + tok * ZW + 1024 + h * 128 + v);
            u32x4 w;
            w.x = pk2(o[2 * a][0] * rs * ng0[0] * siluf_(bf_lo(r4.x)), o[2 * a][1] * rs * ng0[1] * siluf_(bf_hi(r4.x)));
            w.y = pk2(o[2 * a][2] * rs * ng0[2] * siluf_(bf_lo(r4.y)), o[2 * a][3] * rs * ng0[3] * siluf_(bf_hi(r4.y)));
            w.z = pk2(o[2 * a + 1][0] * rs * ng1[0] * siluf_(bf_lo(r4.z)), o[2 * a + 1][1] * rs * ng1[1] * siluf_(bf_hi(r4.z)));
            w.w = pk2(o[2 * a + 1][2] * rs * ng1[2] * siluf_(bf_lo(r4.w)), o[2 * a + 1][3] * rs * ng1[3] * siluf_(bf_hi(r4.w)));
            *(u32x4*)(mix + tok * D + h * 128 + v) = w;
        }
        __syncthreads();
    }
#undef G3_LOADS
}
#undef GLA_LOAD

constexpr int LO_XR = 0, LO_XCT = 4288;
constexpr int LB_XCB = 34560, LB_WAT = 43776, LB_WXT = 52992;
constexpr int LO_RT = 15552, LO_IT = 19904, LO_SEGA = 24256, LO_SEGH = 24768;

__device__ __forceinline__ void phase_l1(const Params& P, LAS unsigned char* lds, int e) {
    LAS float* L = (LAS float*)lds;
    const int tid = otid(), lane = tid & 63, wave = tid >> 6, l15 = lane & 15, quad = lane >> 4;
    const bf16_t* zb = (const bf16_t*)(P.ws + WS_HZ);
    float* HL = (float*)(P.ws + WS_HL); float* AC = (float*)(P.ws + WS_AC);
    LAS bf16_t* XCB = (LAS bf16_t*)(lds + LB_XCB); LAS bf16_t* WAT = (LAS bf16_t*)(lds + LB_WAT); LAS bf16_t* WXT = (LAS bf16_t*)(lds + LB_WXT);
    const int gstep = ogrid(), item0 = obid();
    const bool wconst = (gstep & 7) == 0;
    u32x4 xq0 = (u32x4){0u, 0u, 0u, 0u}, xq1 = (u32x4){0u, 0u, 0u, 0u};
#define L1_LOADXR(ITEM) do { const int g_ = (ITEM) & 7, bc_ = (ITEM) >> 3, c_ = bc_ & 63, t0_ = (bc_ >> 6) * SEQ + c_ * 64; \
        { const int row = tid >> 3, c8 = (tid & 7) * 8; xq0 = (u32x4){0u, 0u, 0u, 0u}; if (c_ > 0 || row >= 3) xq0 = *(const u32x4*)(zb + (size_t)(t0_ + row - 3) * ZW + 1536 + g_ * 64 + c8); } \
        if (tid < 24) { const int row = 64 + (tid >> 3), c8 = (tid & 7) * 8; xq1 = *(const u32x4*)(zb + (size_t)(t0_ + row - 3) * ZW + 1536 + g_ * 64 + c8); } } while (0)
    if (item0 < 2048) L1_LOADXR(item0);
    for (int item = item0; item < 2048; item += gstep) {
        const int g = item & 7, bc = item >> 3, b = bc >> 6, c = bc & 63;
        const int t0 = b * SEQ + c * 64, ch0 = g * 64;
        {
            const int row = tid >> 3, c8 = (tid & 7) * 8;
            f32x4 a, bq; a[0] = bf_lo(xq0.x); a[1] = bf_hi(xq0.x); a[2] = bf_lo(xq0.y); a[3] = bf_hi(xq0.y); bq[0] = bf_lo(xq0.z); bq[1] = bf_hi(xq0.z); bq[2] = bf_lo(xq0.w); bq[3] = bf_hi(xq0.w);
            *(LAS f32x4*)(L + LO_XR + row * 64 + c8) = a; *(LAS f32x4*)(L + LO_XR + row * 64 + c8 + 4) = bq;
            if (tid < 24) {
                const int row1 = 64 + (tid >> 3);
                a[0] = bf_lo(xq1.x); a[1] = bf_hi(xq1.x); a[2] = bf_lo(xq1.y); a[3] = bf_hi(xq1.y); bq[0] = bf_lo(xq1.z); bq[1] = bf_hi(xq1.z); bq[2] = bf_lo(xq1.w); bq[3] = bf_hi(xq1.w);
                *(LAS f32x4*)(L + LO_XR + row1 * 64 + c8) = a; *(LAS f32x4*)(L + LO_XR + row1 * 64 + c8 + 4) = bq;
            }
        }
        if (item + gstep < 2048) L1_LOADXR(item + gstep);
        if (!wconst || item == item0) {
            const f32x4* wa = (const f32x4*)(P.in[23] + (size_t)(e * 8 + g) * 4096); const f32x4* wx = (const f32x4*)(P.in[25] + (size_t)(e * 8 + g) * 4096);
#pragma unroll
            for (int r = 0; r < 2; ++r) {
                const int i4 = tid + 512 * r, i = i4 >> 4, j4 = (i4 & 15) * 4;
                const f32x4 va = wa[i4], vx = wx[i4];
#pragma unroll
                for (int q = 0; q < 4; ++q) { WAT[(j4 + q) * MLD + i] = (bf16_t)f2bf(va[q]); WXT[(j4 + q) * MLD + i] = (bf16_t)f2bf(vx[q]); }
            }
        }
        __syncthreads();
        {
            const float* cw = P.in[21] + e * 4 * 512 + ch0 + lane;
            const float w0 = cw[0], w1 = cw[512], w2 = cw[1024], w3 = cw[1536], cb = P.in[22][e * 512 + ch0 + lane];
            f32x4 a, bq;
#pragma unroll
            for (int j = 0; j < 8; ++j) {
                const int t = 8 * wave + j;
                const float v = L[LO_XR + (t + 0) * 64 + lane] * w0 + L[LO_XR + (t + 1) * 64 + lane] * w1 + L[LO_XR + (t + 2) * 64 + lane] * w2 + L[LO_XR + (t + 3) * 64 + lane] * w3 + cb;
                if (j < 4) a[j] = v; else bq[j - 4] = v;
                XCB[t * MLD + lane] = (bf16_t)f2bf(v);
            }
            *(LAS f32x4*)(L + LO_XCT + lane * LDT + 8 * wave) = a; *(LAS f32x4*)(L + LO_XCT + lane * LDT + 8 * wave + 4) = bq;
        }
        __syncthreads();
        {
            const int gate = wave >> 2, tt0 = 16 * (wave & 3);
            const LAS bf16_t* WT = gate ? WXT : WAT;
            const bf16x8 a0 = *(const LAS bf16x8*)(XCB + (tt0 + l15) * MLD + 8 * quad), a1 = *(const LAS bf16x8*)(XCB + (tt0 + l15) * MLD + 32 + 8 * quad);
            LAS float* O = L + (gate ? LO_IT : LO_RT);
            const float* bp = (gate ? P.in[26] : P.in[24]) + e * 512 + ch0;
#pragma unroll
            for (int jt = 0; jt < 4; ++jt) {
                const bf16x8 b0 = *(const LAS bf16x8*)(WT + (16 * jt + l15) * MLD + 8 * quad), b1 = *(const LAS bf16x8*)(WT + (16 * jt + l15) * MLD + 32 + 8 * quad);
                f32x4 acc = (f32x4){0.f, 0.f, 0.f, 0.f};
                acc = __builtin_amdgcn_mfma_f32_16x16x32_bf16(a0, b0, acc, 0, 0, 0);
                acc = __builtin_amdgcn_mfma_f32_16x16x32_bf16(a1, b1, acc, 0, 0, 0);
                const float bias = bp[16 * jt + l15];
                f32x4 w;
#pragma unroll
                for (int r = 0; r < 4; ++r) w[r] = sigmoidf_(acc[r] + bias);
                *(LAS f32x4*)(O + (16 * jt + l15) * LDT + tt0 + 4 * quad) = w;
            }
        }
        __syncthreads();
        {
            const float sp = softplusf_(-P.in[27][e * 512 + ch0 + lane]);
            const f32x4 r0 = *(const LAS f32x4*)(L + LO_RT + lane * LDT + 8 * wave), r1 = *(const LAS f32x4*)(L + LO_RT + lane * LDT + 8 * wave + 4);
            const f32x4 i0 = *(const LAS f32x4*)(L + LO_IT + lane * LDT + 8 * wave), i1 = *(const LAS f32x4*)(L + LO_IT + lane * LDT + 8 * wave + 4);
            const f32x4 x0 = *(const LAS f32x4*)(L + LO_XCT + lane * LDT + 8 * wave), x1 = *(const LAS f32x4*)(L + LO_XCT + lane * LDT + 8 * wave + 4);
            float Hl[8], Al[8]; float Hr = 0.f, Ar = 1.f;
#pragma unroll
            for (int j = 0; j < 8; ++j) {
                const float rr = j < 4 ? r0[j & 3] : r1[j & 3], ii = j < 4 ? i0[j & 3] : i1[j & 3], xx = j < 4 ? x0[j & 3] : x1[j & 3];
                const float la = -8.0f * rr * sp; const float a = __expf(la);
                const float u = __builtin_amdgcn_sqrtf(fmaxf(__builtin_fmaf(-a, a, 1.0f), 0.f)) * (ii * xx);
                Hr = a * Hr + u; Ar *= a; Hl[j] = Hr; Al[j] = Ar;
            }
            L[LO_SEGA + wave * 64 + lane] = Ar; L[LO_SEGH + wave * 64 + lane] = Hr;
            __syncthreads();
            float Hin = 0.f, Ain = 1.f;
            for (int s = 0; s < wave; ++s) { const float sa = L[LO_SEGA + s * 64 + lane], sh = L[LO_SEGH + s * 64 + lane]; Hin = sa * Hin + sh; Ain *= sa; }
#pragma unroll
            for (int j = 0; j < 8; ++j) {
                const size_t o = (size_t)(t0 + 8 * wave + j) * 512 + ch0 + lane;
                HL[o] = Hl[j] + Al[j] * Hin; AC[o] = Al[j] * Ain;
            }
        }
        __syncthreads();
    }
#undef L1_LOADXR
}

__device__ __forceinline__ void phase_l2(const Params& P) {
    const float* HL = (const float*)(P.ws + WS_HL); const float* AC = (const float*)(P.ws + WS_AC); float* carry = (float*)(P.ws + WS_CARRY);
    const int tid = otid(), lane = tid & 63, wave = tid >> 6;
    for (int seq = obid() * 8 + wave, sstep = ogrid() * 8; seq < 4 * 512; seq += sstep) {
        const int b = seq >> 9, ch = seq & 511;
        const size_t o = (size_t)(b * SEQ + lane * 64 + 63) * 512 + ch;
        float a = AC[o], h = HL[o];
#pragma unroll
        for (int d = 1; d < 64; d <<= 1) {
            const float ap = __shfl_up(a, d), hp = __shfl_up(h, d);
            if (lane >= d) { h = a * hp + h; a = ap * a; }
        }
        const float hin = __shfl_up(h, 1);
        carry[(b * 64 + lane) * 512 + ch] = lane == 0 ? 0.f : hin;
    }
}

__device__ __forceinline__ void phase_l3(const Params& P) {
    const float* HL = (const float*)(P.ws + WS_HL); const float* AC = (const float*)(P.ws + WS_AC); const float* carry = (const float*)(P.ws + WS_CARRY);
    const bf16_t* zb = (const bf16_t*)(P.ws + WS_HZ); bf16_t* mix = (bf16_t*)(P.ws + WS_MIX);
#pragma unroll 4
    for (int idx = obid() * NTHREADS + otid(); idx < T * 128; idx += ogrid() * NTHREADS) {
        const int tok = idx >> 7, ch = (idx & 127) * 4;
        const int b = tok >> 12, c = (tok & 4095) >> 6;
        const f32x4 hl = *(const f32x4*)(HL + (size_t)tok * 512 + ch), ac = *(const f32x4*)(AC + (size_t)tok * 512 + ch), cr = *(const f32x4*)(carry + (b * 64 + c) * 512 + ch);
        const u32x2 g2 = *(const u32x2*)(zb + (size_t)tok * ZW + 2048 + ch);
        const f32x4 hh = hl + ac * cr;
        u32x2 w; w.x = pk2(hh[0] * gelu_tanh(bf_lo(g2.x)), hh[1] * gelu_tanh(bf_hi(g2.x))); w.y = pk2(hh[2] * gelu_tanh(bf_lo(g2.y)), hh[3] * gelu_tanh(bf_hi(g2.y)));
        *(u32x2*)(mix + (size_t)tok * D + 512 + ch) = w;
    }
}

constexpr int AK_LD = 72, AV_LD = 264;
constexpr int AO_K = 0, AO_VT = 256 * AK_LD * 2, AO_BIAS = AO_VT + 64 * AV_LD * 2;

__device__ __forceinline__ void phase_attn(const Params& P, LAS unsigned char* lds, int o) {
    const int tid = otid(), lane = tid & 63, wave = tid >> 6, l15 = lane & 15, quad = lane >> 4;
    const bf16_t* qkv = (const bf16_t*)(P.ws + WS_HZ);
    bf16_t* mix = (bf16_t*)(P.ws + WS_MIX);
    LAS bf16_t* KS = (LAS bf16_t*)(lds + AO_K); LAS bf16_t* VT = (LAS bf16_t*)(lds + AO_VT); LAS float* BIAS = (LAS float*)(lds + AO_BIAS);
    const int gstep = ogrid(), item0 = obid();
    const bool hkconst = (gstep & 3) == 0;
    for (int item = item0; item < 512; item += gstep) {
        const int hk = item & 3, n = (item >> 2) & 31, b = item >> 7;
        const int tok0 = b * SEQ + n * 128 - 128;
#pragma unroll
        for (int r = 0; r < 4; ++r) {
            const int c = r * 512 + tid, key = c >> 3, dc = c & 7;
            u32x4 v = (u32x4){0u, 0u, 0u, 0u};
            if (n > 0 || key >= 128) v = *(const u32x4*)(qkv + (size_t)(tok0 + key) * QKVW + 1024 + hk * 64 + dc * 8);
            *(LAS u32x4*)(KS + key * AK_LD + dc * 8) = v;
        }
#pragma unroll
        for (int r = 0; r < 4; ++r) {
            const int c = r * 512 + tid, key = c & 255, dvc = c >> 8;
            u32x4 v = (u32x4){0u, 0u, 0u, 0u};
            if (n > 0 || key >= 128) v = *(const u32x4*)(qkv + (size_t)(tok0 + key) * QKVW + 1280 + hk * 64 + dvc * 8);
            LAS bf16_t* d = VT + (32 * (dvc >> 2) + 4 * (dvc & 3)) * AV_LD + key;
            d[0 * AV_LD] = (bf16_t)(v.x & 0xffffu); d[1 * AV_LD] = (bf16_t)(v.x >> 16); d[2 * AV_LD] = (bf16_t)(v.y & 0xffffu); d[3 * AV_LD] = (bf16_t)(v.y >> 16);
            d[16 * AV_LD] = (bf16_t)(v.z & 0xffffu); d[17 * AV_LD] = (bf16_t)(v.z >> 16); d[18 * AV_LD] = (bf16_t)(v.w & 0xffffu); d[19 * AV_LD] = (bf16_t)(v.w >> 16);
        }
        if (!hkconst || item == item0) {
            for (int idx = tid; idx < 4 * 192; idx += NTHREADS) {
                const int g = idx / 192, j = idx - g * 192, dist = (191 - j) - 32;
                float val = -1e30f;
                if (dist >= 0 && dist < 128) {
                    int bucket = dist;
                    if (dist >= 16) { int lg = 16 + (int)(__logf((float)dist * 0.0625f) / 2.0794415416798357f * 16.0f); bucket = lg < 31 ? lg : 31; }
                    val = P.in[2][bucket * 16 + hk * 4 + g] * 1.4426950408889634f;
                }
                BIAS[idx] = val;
            }
        }
        __syncthreads();
        const int g = wave >> 1, half = wave & 1, head = hk * 4 + g;
        const float sink2 = P.in[32][o * 16 + head] * 1.4426950408889634f;
        bf16x8 qn0, qn1;
        {
            const size_t qt = (size_t)(b * SEQ + n * 128 + 64 * half + l15);
            qn0 = *(const bf16x8*)(qkv + qt * QKVW + head * 64 + 8 * quad); qn1 = *(const bf16x8*)(qkv + qt * QKVW + head * 64 + 32 + 8 * quad);
        }
#pragma nounroll
        for (int rt = 0; rt < 4; ++rt) {
            const int q0 = 64 * half + 16 * rt, qi = q0 + l15;
            const size_t qtok = (size_t)(b * SEQ + n * 128 + qi);
            bf16x8 qf[2]; qf[0] = qn0; qf[1] = qn1;
            if (rt < 3) {
                const size_t qt = qtok + 16;
                qn0 = *(const bf16x8*)(qkv + qt * QKVW + head * 64 + 8 * quad); qn1 = *(const bf16x8*)(qkv + qt * QKVW + head * 64 + 32 + 8 * quad);
            }
            const int grp0 = q0 >> 5, tile0 = 2 * grp0;
            f32x4 s[10];
#pragma unroll
            for (int tt = 0; tt < 10; ++tt) {
                const int key = 16 * (tile0 + tt) + l15;
                const bf16x8 k0 = *(const LAS bf16x8*)(KS + key * AK_LD + 8 * quad), k1 = *(const LAS bf16x8*)(KS + key * AK_LD + 32 + 8 * quad);
                f32x4 z = (f32x4){0.f, 0.f, 0.f, 0.f};
                z = __builtin_amdgcn_mfma_f32_16x16x32_bf16(k0, qf[0], z, 0, 0, 0);
                z = __builtin_amdgcn_mfma_f32_16x16x32_bf16(k1, qf[1], z, 0, 0, 0);
                s[tt] = z;
            }
            float mx = sink2;
            {
                const LAS float* tb = BIAS + g * 192 + (31 - (q0 & 31) - l15 + 4 * quad);
#pragma unroll
                for (int tt = 0; tt < 10; ++tt)
#pragma unroll
                    for (int r = 0; r < 4; ++r) {
                        const float sc = __builtin_fmaf(s[tt][r], 0.125f * 1.4426950408889634f, tb[16 * tt + r]);
                        s[tt][r] = sc;
                    }
                if (n == 0) {
#pragma unroll
                    for (int tt = 0; tt < 10; ++tt)
#pragma unroll
                        for (int r = 0; r < 4; ++r) { const int kj = 16 * (tile0 + tt) + 4 * quad + r; if (kj < 128) s[tt][r] = -1e30f; }
                }
#pragma unroll
                for (int tt = 0; tt < 10; ++tt)
#pragma unroll
                    for (int r = 0; r < 4; ++r) mx = fmaxf(mx, s[tt][r]);
            }
            mx = fmaxf(mx, __shfl_xor(mx, 16)); mx = fmaxf(mx, __shfl_xor(mx, 32));
            float l = 0.f;
#pragma unroll
            for (int tt = 0; tt < 10; ++tt)
#pragma unroll
                for (int r = 0; r < 4; ++r) { const float p = __builtin_amdgcn_exp2f(s[tt][r] - mx); s[tt][r] = p; l += p; }
            l += __shfl_xor(l, 16); l += __shfl_xor(l, 32);
            l += __builtin_amdgcn_exp2f(sink2 - mx);
            f32x4 oacc[4];
#pragma unroll
            for (int t = 0; t < 4; ++t) oacc[t] = (f32x4){0.f, 0.f, 0.f, 0.f};
#pragma unroll
            for (int jp = 0; jp < 5; ++jp) {
                u32x4 pw; pw.x = pk2(s[2 * jp][0], s[2 * jp][1]); pw.y = pk2(s[2 * jp][2], s[2 * jp][3]); pw.z = pk2(s[2 * jp + 1][0], s[2 * jp + 1][1]); pw.w = pk2(s[2 * jp + 1][2], s[2 * jp + 1][3]);
                const bf16x8 pf = __builtin_bit_cast(bf16x8, pw);
                const int keybase = 32 * (grp0 + jp);
#pragma unroll
                for (int t = 0; t < 4; ++t) {
                    const LAS bf16_t* vp = VT + (16 * t + l15) * AV_LD + keybase + 4 * quad;
                    const u32x2 va = *(const LAS u32x2*)vp, vb = *(const LAS u32x2*)(vp + 16);
                    u32x4 vw; vw.x = va.x; vw.y = va.y; vw.z = vb.x; vw.w = vb.y;
                    oacc[t] = __builtin_amdgcn_mfma_f32_16x16x32_bf16(__builtin_bit_cast(bf16x8, vw), pf, oacc[t], 0, 0, 0);
                }
            }
            const float inv = 1.0f / l;
#pragma unroll
            for (int a = 0; a < 2; ++a) {
                u32x4 w; w.x = pk2(oacc[2 * a][0] * inv, oacc[2 * a][1] * inv); w.y = pk2(oacc[2 * a][2] * inv, oacc[2 * a][3] * inv);
                w.z = pk2(oacc[2 * a + 1][0] * inv, oacc[2 * a + 1][1] * inv); w.w = pk2(oacc[2 * a + 1][2] * inv, oacc[2 * a + 1][3] * inv);
                *(u32x4*)(mix + qtok * D + head * 64 + 32 * a + 8 * quad) = w;
            }
        }
        __syncthreads();
    }
}

__device__ __forceinline__ void phase_final(const Params& P) {
    const int tid_ = otid(); const int lane = tid_ & 63, wave = tid_ >> 6;
    const float* ssq = (const float*)(P.ws + WS_SSQ);
    const bf16_t* hi = (const bf16_t*)(P.ws + WS_MIX); const bf16_t* lo = (const bf16_t*)(P.ws + WS_HZ);
    for (int m = obid() * 8 + wave, mstep = ogrid() * 8; m < T; m += mstep) {
        const float s = pg8::row_scale(ssq, m);
        f32x4* xr = (f32x4*)(P.out + (size_t)m * D) + lane; const f32x4* gp = (const f32x4*)P.in[3] + lane;
        const u32x2* hp = (const u32x2*)(hi + (size_t)m * D) + lane; const u32x2* lp = (const u32x2*)(lo + (size_t)m * D) + lane;
#pragma unroll
        for (int j = 0; j < 4; ++j) {
            const u32x2 h2 = hp[64 * j], l2 = lp[64 * j]; const f32x4 g4 = gp[64 * j];
            f32x4 o; o[0] = (bf_lo(h2.x) + bf_lo(l2.x)) * s * g4[0]; o[1] = (bf_hi(h2.x) + bf_hi(l2.x)) * s * g4[1]; o[2] = (bf_lo(h2.y) + bf_lo(l2.y)) * s * g4[2]; o[3] = (bf_hi(h2.y) + bf_hi(l2.y)) * s * g4[3];
            xr[64 * j] = o;
        }
    }
}

#define XB_TMO      128
#define XB_XCNT(j)  (256  + 64 * (j))
#define XB_XSUB(j)  (1280 + 64 * (j))
#define XB_XGEN(j)  (2304 + 64 * (j))
#define XB_TOP      3328
#define XB_TOPGEN   3392
#define XCD_BAR_WORDS 3456
#define XB_SPIN_CAP (1u << 18)
__device__ __forceinline__ unsigned xb_ld(unsigned* p)              { return __hip_atomic_load(p, __ATOMIC_RELAXED, __HIP_MEMORY_SCOPE_AGENT); }
__device__ __forceinline__ unsigned xb_add(unsigned* p, unsigned v) { return __hip_atomic_fetch_add(p, v, __ATOMIC_RELAXED, __HIP_MEMORY_SCOPE_AGENT); }
__device__ __forceinline__ unsigned xb_xcc_id() { return (unsigned)__builtin_amdgcn_s_getreg((3 << 11) | 20) & 0xFu; }
#define XB_SPIN(cond, bar) do { unsigned _sp = 0; while (cond) { __builtin_amdgcn_s_sleep(1); \
    if ((++_sp & 255u) == 0u) { if (xb_ld(&(bar)[XB_TMO])) break; if (_sp > XB_SPIN_CAP) { atomicAdd(&(bar)[XB_TMO], 1u); break; } } } } while (0)
struct XcdBarrier { unsigned* bar; unsigned x; volatile LAS unsigned* st; };
__device__ __forceinline__ XcdBarrier xcd_barrier_post(unsigned* bar, volatile LAS unsigned* st) {
    XcdBarrier b; b.bar = bar; b.x = xb_xcc_id(); b.st = st;
    if (threadIdx.x == 0) (void)xb_add(&bar[XB_XCNT(b.x)], 1u);
    return b;
}
__device__ __forceinline__ void xcd_barrier_complete(unsigned* bar, unsigned x, unsigned& nloc, unsigned& nx) {
    const unsigned G = gridDim.x * gridDim.y * gridDim.z;
    unsigned sum, cnt, mine, sp = 0u;
    for (;;) {
        sum = 0u; cnt = 0u; mine = 0u;
#pragma unroll
        for (unsigned j = 0; j < 16; ++j) { const unsigned c = xb_ld(&bar[XB_XCNT(j)]); sum += c; cnt += (c > 0u) ? 1u : 0u; mine = (j == x) ? c : mine; }
        if (sum == G) break;
        __builtin_amdgcn_s_sleep(1);
        if ((++sp & 255u) == 0u) { if (xb_ld(&bar[XB_TMO])) break; if (sp > XB_SPIN_CAP) { atomicAdd(&bar[XB_TMO], 1u); break; } }
    }
    nloc = mine > 0u ? mine : 1u; nx = cnt > 0u ? cnt : 1u;
}
__device__ __forceinline__ void xcd_barrier(const XcdBarrier& b) {
    asm volatile("s_waitcnt vmcnt(0)" ::: "memory");
    __syncthreads();
    if (threadIdx.x == 0) {
        unsigned* bar = b.bar;
        __builtin_amdgcn_s_waitcnt(0);
        unsigned nloc = b.st[0], nx = b.st[1];
        if (nloc == 0u) { xcd_barrier_complete(bar, b.x, nloc, nx); b.st[0] = nloc; b.st[1] = nx; }
        const unsigned old = xb_add(&bar[XB_XSUB(b.x)], 1u);
        const unsigned gen = old / nloc;
        if (old + 1u == (gen + 1u) * nloc) {
            __builtin_amdgcn_fence(__ATOMIC_RELEASE, "agent");
            asm volatile("s_waitcnt vmcnt(0)" ::: "memory");
            const unsigned og = xb_add(&bar[XB_TOP], 1u);
            const unsigned tg = og / nx;
            if (og + 1u == (tg + 1u) * nx) xb_add(&bar[XB_TOPGEN], 1u);
            else XB_SPIN(xb_ld(&bar[XB_TOPGEN]) == tg, bar);
            __builtin_amdgcn_fence(__ATOMIC_ACQUIRE, "agent");
            xb_add(&bar[XB_XGEN(b.x)], 1u);
            asm volatile("s_waitcnt vmcnt(0)" ::: "memory");
        } else {
            XB_SPIN(xb_ld(&bar[XB_XGEN(b.x)]) == gen, bar);
            __builtin_amdgcn_fence(__ATOMIC_ACQUIRE, "agent");
            asm volatile("s_waitcnt vmcnt(0)" ::: "memory");
        }
    }
    __syncthreads();
}

__global__ void __launch_bounds__(NTHREADS, 2) mk_fwd(Params P_arg) {
    extern __shared__ __attribute__((aligned(16))) unsigned char lds_raw[];
    LAS unsigned char* lds = (LAS unsigned char*)lds_raw;
    cg::grid_group grid = cg::this_grid();
    volatile LAS unsigned* bar_st = (volatile LAS unsigned*)(lds + LDS_BYTES - 64);
    if (threadIdx.x == 0) { bar_st[0] = 0u; bar_st[1] = 0u; }
    __syncthreads();
    const XcdBarrier xbar = xcd_barrier_post((unsigned*)(P_arg.ws + WS_CTL), bar_st);
    for (int ph = P_arg.ph_lo; ph < P_arg.ph_hi; ++ph) {
        bool did = true;
        int nrep = 1;
        {
            const int s_ = (ph >= 1 && ph <= 40) ? (ph - 1) % 10 : -1, L_ = (ph - 1) / 10;
            if (PROBE_DUP == 1 && (s_ == 0)) nrep = 2;
            if (PROBE_DUP == 2 && ph == 0) nrep = 2;
            if (PROBE_DUP == 3 && (s_ == 3 || s_ == 5) && !(L_ & 1)) nrep = 2;
            if (PROBE_DUP == 4 && s_ == 3 && (L_ & 1)) nrep = 2;
            if (PROBE_DUP == 6 && s_ == 2) nrep = 2;
        }
#pragma nounroll
        for (int rep_ = 0; rep_ < nrep; ++rep_) {
        const __attribute__((address_space(4))) Params* Pk = (const __attribute__((address_space(4))) Params*)__builtin_amdgcn_kernarg_segment_ptr();
        asm volatile("" : "+s"(Pk));
        const Params& P = *(const Params*)Pk;
        unsigned char* ws = P.ws;
        float* ssq = (float*)(ws + WS_SSQ);
        bf16_t* XB = (bf16_t*)(ws + WS_XB); bf16_t* XBALT = (bf16_t*)(ws + WS_MIX); bf16_t* HZ = (bf16_t*)(ws + WS_HZ); bf16_t* MIX = (bf16_t*)(ws + WS_MIX);
        bf16_t* PP = (bf16_t*)(ws + WS_PP);
        bf16_t* XLO = (bf16_t*)P.out;
        if (ph == 0) phase_prepass(P, lds);
        else if (ph == 41) phase_final(P);
        else {
            const int L = (ph - 1) / 10, s = (ph - 1) % 10, even = !(L & 1), eo = L >> 1;
            if (s == 3) {
                if (even) { phase_g1(P, lds, eo); phase_l1(P, lds, eo); } else phase_attn(P, lds, eo);
            } else if (s == 4) {
                if (even) { phase_g2(P); phase_l2(P); } else did = false;
            } else if (s == 5) {
                if (even) { phase_g3(P, lds, eo); phase_l3(P); } else did = false;
            } else {
                const int ng = (s == 7) ? 2 : 1;
#pragma nounroll
                for (int gi = 0; gi < ng; ++gi) {
                    pg8::Epi E; E.mode = 0; E.ssq_in = nullptr; E.ssq_out = nullptr; E.xin = nullptr; E.hin = nullptr; E.lin = nullptr; E.lout = nullptr; E.xb = nullptr; E.ob = nullptr; E.ldo = 0; E.of = nullptr; E.bias = nullptr; E.alpha = 1.0f;
                    const bf16_t* A = XB; const bf16_t* Bt = nullptr; int N = 1024, K = 1024;
                    if (gi == 1) {
                        E.mode = 2; E.ob = PP; A = (const bf16_t*)(ws + WS_PB) + (size_t)L * T * 256; Bt = (const bf16_t*)(ws + WS_WPP) + (size_t)L * 1024 * 256; N = 1024; K = 256;
                    } else if (s == 0 || s == 7) {
                        const int w = (s == 7);
                        E.mode = 0; E.ssq_in = ssq + (size_t)((4 * L + (w ? 2 : 0)) & 1) * T * 16; E.ob = HZ; E.ldo = FF;
                        A = w ? XB : XBALT; Bt = (const bf16_t*)(ws + WS_WUP) + (size_t)(2 * L + w) * 5632 * 1024; N = 5632; K = 1024;
                    } else if (s == 1 || s == 8) {
                        const int w = (s == 8);
                        E.mode = (L == 0 && !w) ? 5 : 3; E.xin = P.in[0]; E.hin = w ? XB : XBALT; E.lin = XLO; E.lout = XLO; E.xb = XB; E.ssq_out = ssq + (size_t)((4 * L + (w ? 3 : 1)) & 1) * T * 16; E.alpha = 0.5f;
                        A = HZ; Bt = (const bf16_t*)(ws + WS_WDN) + (size_t)(2 * L + w) * 1024 * 2816; N = 1024; K = 2816;
                    } else if (s == 2) {
                        E.mode = 1; E.ssq_in = ssq + (size_t)((4 * L + 1) & 1) * T * 16; E.ob = HZ; A = XB; K = 1024;
                        if (even) { E.ldo = ZW; Bt = (const bf16_t*)(ws + WS_WIN) + (size_t)eo * 2816 * 1024; N = 2816; }
                        else { E.ldo = QKVW; E.bias = P.in[29] + eo * 1536; Bt = (const bf16_t*)(ws + WS_WQKV) + (size_t)eo * 1536 * 1024; N = 1536; }
                    } else if (s == 6) {
                        E.mode = 3; E.hin = XB; E.lin = XLO; E.lout = XLO; E.xb = XB; E.ssq_out = ssq + (size_t)((4 * L + 2) & 1) * T * 16; E.alpha = 1.0f;
                        E.bias = even ? nullptr : P.in[31] + eo * 1024;
                        A = MIX; Bt = even ? (const bf16_t*)(ws + WS_WOUT) + (size_t)eo * 1024 * 1024 : (const bf16_t*)(ws + WS_WO) + (size_t)eo * 1024 * 1024; N = 1024; K = 1024;
                    } else {
                        E.mode = 4; E.ssq_in = ssq + (size_t)((4 * L + 3) & 1) * T * 16; E.ssq_out = ssq + (size_t)((4 * L + 4) & 1) * T * 16; E.ob = PP; E.hin = XB; E.lin = XLO; E.lout = (L == 3) ? HZ : XLO; E.xb = XBALT;
                        A = XB; Bt = (const bf16_t*)(ws + WS_WPG) + (size_t)L * 1024 * 1024; N = 1024; K = 1024;
                    }
                    if (PROBE_DUP == 7 && s == 1) { pg8::Epi Ed = E; Ed.mode = 2; Ed.ob = PP; run_gemm(lds, A, Bt, N, K, Ed); }
                    if (PROBE_DUP == 8 && s == 6) { pg8::Epi Ed = E; Ed.mode = 2; Ed.ob = PP; run_gemm(lds, A, Bt, N, K, Ed); }
                    run_gemm(lds, A, Bt, N, K, E, (gi == 1 && gridDim.x == 256) ? 128 : 0);
                    if (s == 0) layer_small_cvt(P, L, gridDim.x == 256 ? 128 : 0);
                    if (s == 2 && even) first_token_qk(P, lds, L, gridDim.x == 256 ? 192 : 0);
                }
            }
        }
        }
        if (did && ph + 1 < P_arg.ph_hi) { if (ph == 99) grid.sync(); else xcd_barrier(xbar); if (PROBE_DUP == 5) xcd_barrier(xbar); }
    }
}

extern "C" void kernel_launch(void* const* d_in, const int* in_sizes, int n_in, void* d_out, int out_size, void* d_ws, size_t ws_size, hipStream_t stream) {
    static int grid = 0;
    if (grid == 0) {
        if (n_in != 33 || out_size != T * D || ws_size < WS_END) { fprintf(stderr, "kernel_launch: unexpected shapes (n_in %d out %d ws %zu need %zu)\n", n_in, out_size, ws_size, (size_t)WS_END); grid = -1; return; }
        int dev = 0, cus = 0, per_cu = 0;
        hipGetDevice(&dev); hipDeviceGetAttribute(&cus, hipDeviceAttributeMultiprocessorCount, dev);
        if (hipFuncSetAttribute((const void*)mk_fwd, hipFuncAttributeMaxDynamicSharedMemorySize, LDS_BYTES) != hipSuccess) { fprintf(stderr, "hipFuncSetAttribute failed\n"); grid = -1; return; }
        if (hipOccupancyMaxActiveBlocksPerMultiprocessor(&per_cu, (const void*)mk_fwd, NTHREADS, LDS_BYTES) != hipSuccess || per_cu < 1) per_cu = 1;
        (void)hipGetLastError();
        grid = cus * 1;
    }
    if (grid < 0) return;
    if (hipMemsetAsync((char*)d_ws + WS_CTL, 0, CTL_BYTES, stream) != hipSuccess) { fprintf(stderr, "memset failed\n"); return; }
    Params p{};
    for (int i = 0; i < 33; ++i) p.in[i] = (const float*)d_in[i];
    p.out = (float*)d_out; p.ws = (unsigned char*)d_ws;
#if COOP
    p.ph_lo = 0; p.ph_hi = 42;
    void* args[] = {&p};
    hipError_t e = hipLaunchCooperativeKernel((const void*)mk_fwd, dim3(grid), dim3(NTHREADS), args, LDS_BYTES, stream);
    if (e != hipSuccess) fprintf(stderr, "cooperative launch failed: %s (grid %d)\n", hipGetErrorString(e), grid);
#else
    for (int ph = 0; ph < 42; ++ph) {
        if (ph >= 1 && ph <= 40) { const int L = (ph - 1) / 10, s = (ph - 1) % 10; if ((L & 1) && (s == 4 || s == 5)) continue; }
        p.ph_lo = ph; p.ph_hi = ph + 1;
        hipLaunchKernelGGL(mk_fwd, dim3(grid), dim3(NTHREADS), LDS_BYTES, stream, p);
    }
#endif
}
```

```cpp
#include <hip/hip_runtime.h>
#include <hip/hip_cooperative_groups.h>
#include <cstdio>
namespace cg = cooperative_groups;

#ifndef COOP
#define COOP 1
#endif

#ifndef PROBE_DUP
#define PROBE_DUP 0
#endif
#define LAS __attribute__((address_space(3)))
typedef unsigned short bf16_t;
typedef short bf16x8 __attribute__((ext_vector_type(8)));
typedef float f32x4 __attribute__((ext_vector_type(4)));
typedef float f32x2 __attribute__((ext_vector_type(2)));
typedef unsigned u32x4 __attribute__((ext_vector_type(4)));
typedef unsigned u32x2 __attribute__((ext_vector_type(2)));

constexpr int T = 16384, D = 1024, FF = 2816, SEQ = 4096;
constexpr int ZW = 2816, QKVW = 1536;
constexpr float EPS = 1e-6f;
constexpr int NTHREADS = 512;
constexpr int LDS_BYTES = 147456;

constexpr size_t WS_SSQ = 0;
constexpr size_t WS_WUP = 2097152;
constexpr size_t WS_WDN = WS_WUP + 8ull * 5632 * 1024 * 2;
constexpr size_t WS_WIN = WS_WDN + 8ull * 1024 * 2816 * 2;
constexpr size_t WS_WOUT = WS_WIN + 2ull * 2816 * 1024 * 2;
constexpr size_t WS_WQKV = WS_WOUT + 2ull * 1024 * 1024 * 2;
constexpr size_t WS_WO = WS_WQKV + 2ull * 1536 * 1024 * 2;
constexpr size_t WS_WPG = WS_WO + 2ull * 1024 * 1024 * 2;
constexpr size_t WS_WPP = WS_WPG + 4ull * 1024 * 1024 * 2;
constexpr size_t WS_XB = WS_WPP + 4ull * 1024 * 256 * 2;
constexpr size_t WS_PB = WS_XB + (size_t)T * 1024 * 2;
constexpr size_t WS_HZ = WS_PB + 4ull * T * 256 * 2;
constexpr size_t WS_MIX = WS_HZ + (size_t)T * 2816 * 2;
constexpr size_t WS_SCR = WS_MIX + (size_t)T * 1024 * 2;
constexpr size_t WS_S = WS_SCR;
constexpr size_t WS_HL = WS_S + 1024ull * 8192 * 4;
constexpr size_t WS_AC = WS_HL + (size_t)T * 512 * 4;
constexpr size_t WS_CARRY = WS_AC + (size_t)T * 512 * 4;
constexpr size_t WS_DECAY = WS_CARRY + 4ull * 64 * 512 * 4;
constexpr size_t WS_CTL = WS_DECAY + 1024ull * 64 * 4;
constexpr size_t CTL_BYTES = 16384;
constexpr size_t WS_QK0 = WS_CTL + CTL_BYTES;
constexpr size_t WS_END = WS_QK0 + 8192;
constexpr size_t WS_PP = WS_SCR;

struct Params {
    const float* in[33];
    float* out;
    unsigned char* ws;
    int ph_lo, ph_hi;
};

__device__ __forceinline__ float bf_lo(unsigned w) { return __uint_as_float(w << 16); }
__device__ __forceinline__ float bf_hi(unsigned w) { return __uint_as_float(w & 0xffff0000u); }
__device__ __forceinline__ unsigned f2bf(float f) { unsigned u = __float_as_uint(f); return (u + 0x7fffu + ((u >> 16) & 1u)) >> 16; }
__device__ __forceinline__ unsigned pk2(float lo, float hi) { unsigned r; asm volatile("v_cvt_pk_bf16_f32 %0, %1, %2" : "=v"(r) : "v"(lo), "v"(hi)); return r; }
__device__ __forceinline__ float sigmoidf_(float x) { return __builtin_amdgcn_rcpf(1.0f + __expf(-x)); }
__device__ __forceinline__ float siluf_(float x) { return x * __builtin_amdgcn_rcpf(1.0f + __expf(-x)); }
__device__ __forceinline__ float gelu_tanh(float x) { const float y = 0.7978845608028654f * (x + 0.044715f * x * x * x); return x / (1.0f + __expf(-2.0f * y)); }
__device__ __forceinline__ float softplusf_(float x) { return fmaxf(x, 0.f) + log1pf(__expf(-fabsf(x))); }
__device__ __forceinline__ float logsigmoidf_(float x) { return fminf(x, 0.f) - __logf(1.0f + __expf(-fabsf(x))); }
__device__ __forceinline__ int otid() { int t = threadIdx.x; asm volatile("" : "+v"(t)); return t; }
__device__ __forceinline__ int obid() { int b = blockIdx.x; asm volatile("" : "+s"(b)); return b; }
__device__ __forceinline__ int ogrid() { int g = gridDim.x; asm volatile("" : "+s"(g)); return g; }
__device__ __forceinline__ int pinv32(int c) { return 16 * ((c >> 2) & 1) + 4 * (c >> 3) + (c & 3); }
__device__ __forceinline__ float wave_sum(float v) {
#pragma unroll
    for (int o = 1; o < 64; o <<= 1) v += __shfl_xor(v, o);
    return v;
}

namespace pg8 {
constexpr int BM = 256, BK = 64, HALF = 128, HTB = HALF * BK * 2, STAGE_BYTES = 8 * HTB, NXCD = 8, WGM = 8;
__host__ __device__ __forceinline__ int lds_byte(int r, int c) { const int st = (r >> 4) * 2 + (c >> 5), rr = r & 15, cc = c & 31, ob = rr * 64 + cc * 2; return st * 1024 + (ob ^ (((ob >> 9) & 1) << 5)); }
__host__ __device__ __forceinline__ void stage_rc(int b, int& R, int& C) { const int st = b / 1024, sb = b % 1024, swz = sb ^ (((sb >> 9) & 1) << 5); R = (st >> 1) * 16 + swz / 64; C = (st & 1) * 32 + (swz % 64) / 2; }
struct Unit { int pm, pn; };
struct Gemm { const bf16_t* A; const bf16_t* Bt; int M, N, K; };
struct StaticOrder {
    int nM, nN, nwg, G, c;
    __device__ void init(int M, int N, int G_, int c_) { nM = M / BM; nN = N / BM; nwg = nM * nN; G = G_; c = c_; }
    __device__ bool next(int i, Unit& u) const {
        const long L = (long)i * G + c; if (L >= nwg) return false;
        int wgid = (int)L; { const int q = nwg / NXCD, r = nwg % NXCD, xcd = wgid % NXCD, off = wgid / NXCD; wgid = (xcd < r ? xcd * (q + 1) : r * (q + 1) + (xcd - r) * q) + off; }
        const int nig = WGM * nN, gid = wgid / nig, fm = gid * WGM, gsz = (nM - fm) < WGM ? (nM - fm) : WGM;
        u.pm = fm + ((wgid % nig) % gsz); u.pn = (wgid % nig) / gsz; return true;
    }
};

__device__ __forceinline__ float row_scale(const float* part, int row) {
    const f32x4* p = (const f32x4*)(part + (size_t)row * 16);
    const f32x4 a = p[0], b = p[1], c = p[2], d = p[3];
    const float s = (((a[0] + a[1]) + (a[2] + a[3])) + ((b[0] + b[1]) + (b[2] + b[3]))) + (((c[0] + c[1]) + (c[2] + c[3])) + ((d[0] + d[1]) + (d[2] + d[3])));
    return rsqrtf(s * (1.0f / 1024.0f) + EPS);
}
struct Epi {
    int mode;
    const float* ssq_in;
    float* ssq_out;
    const float* xin;
    const bf16_t* hin; const bf16_t* lin; bf16_t* xb; bf16_t* lout;
    bf16_t* ob; int ldo;
    float* of;
    const float* bias;
    float alpha;
    __device__ __forceinline__ void scales2(const Unit& u, int wr, int fr, int fq, float& sA, float& sB) const {
        const int rowA = u.pm * BM + wr * 64 + fq * 16 + fr;
        const f32x4* pa = (const f32x4*)(ssq_in + (size_t)rowA * 16); const f32x4* pb = (const f32x4*)(ssq_in + (size_t)(rowA + HALF) * 16);
        const f32x4 a0 = pa[0], a1 = pa[1], a2 = pa[2], a3 = pa[3], b0 = pb[0], b1 = pb[1], b2 = pb[2], b3 = pb[3];
        const float ta = (((a0[0] + a0[1]) + (a0[2] + a0[3])) + ((a1[0] + a1[1]) + (a1[2] + a1[3]))) + (((a2[0] + a2[1]) + (a2[2] + a2[3])) + ((a3[0] + a3[1]) + (a3[2] + a3[3])));
        const float tb = (((b0[0] + b0[1]) + (b0[2] + b0[3])) + ((b1[0] + b1[1]) + (b1[2] + b1[3]))) + (((b2[0] + b2[1]) + (b2[2] + b2[3])) + ((b3[0] + b3[1]) + (b3[2] + b3[3])));
        sA = rsqrtf(ta * (1.0f / 1024.0f) + EPS); sB = rsqrtf(tb * (1.0f / 1024.0f) + EPS);
    }
    template <int mode> __device__ __forceinline__ void run(const f32x4 (&acc)[2][2][4][2], const Unit& u, int wr, int wc, int fr, int fq, const LAS float* sc) const {
        const int row0 = u.pm * BM + wr * 64 + fr;
        if (mode == 0) {
            const int col0 = u.pn * HALF + wc * 32 + 8 * fq;
#pragma unroll
            for (int ai = 0; ai < 2; ++ai)
#pragma unroll
                for (int m = 0; m < 4; ++m) {
                    const int row = row0 + ai * HALF + m * 16;
                    const float s = sc[ai * HALF + wr * 64 + m * 16 + fr];
                    const f32x4 g0 = acc[ai][0][m][0] * s, u0 = acc[ai][1][m][0] * s, g1 = acc[ai][0][m][1] * s, u1 = acc[ai][1][m][1] * s;
                    u32x4 w;
                    w.x = pk2(siluf_(g0[0]) * u0[0], siluf_(g0[1]) * u0[1]); w.y = pk2(siluf_(g0[2]) * u0[2], siluf_(g0[3]) * u0[3]);
                    w.z = pk2(siluf_(g1[0]) * u1[0], siluf_(g1[1]) * u1[1]); w.w = pk2(siluf_(g1[2]) * u1[2], siluf_(g1[3]) * u1[3]);
                    *(u32x4*)(ob + (size_t)row * FF + col0) = w;
                }
        } else if (mode == 1) {
            const int col0 = u.pn * BM + wc * 32 + 8 * fq;
            f32x4 bv[2][2];
#pragma unroll
            for (int bj = 0; bj < 2; ++bj)
#pragma unroll
                for (int n = 0; n < 2; ++n) bv[bj][n] = bias ? *(const f32x4*)(bias + col0 + bj * HALF + 4 * n) : (f32x4){0.f, 0.f, 0.f, 0.f};
#pragma unroll
            for (int ai = 0; ai < 2; ++ai)
#pragma unroll
                for (int m = 0; m < 4; ++m) {
                    const int row = row0 + ai * HALF + m * 16;
                    const float s = sc[ai * HALF + wr * 64 + m * 16 + fr];
                    bf16_t* rowp = ob + (size_t)row * ldo + col0;
#pragma unroll
                    for (int bj = 0; bj < 2; ++bj) {
                        const f32x4 v0 = acc[ai][bj][m][0] * s + bv[bj][0], v1 = acc[ai][bj][m][1] * s + bv[bj][1];
                        u32x4 w; w.x = pk2(v0[0], v0[1]); w.y = pk2(v0[2], v0[3]); w.z = pk2(v1[0], v1[1]); w.w = pk2(v1[2], v1[3]);
                        *(u32x4*)(rowp + bj * HALF) = w;
                    }
                }
        } else if (mode == 2) {
            const int col0 = u.pn * BM + wc * 32 + 8 * fq;
#pragma unroll
            for (int ai = 0; ai < 2; ++ai)
#pragma unroll
                for (int m = 0; m < 4; ++m) {
                    bf16_t* rowp = ob + (size_t)(row0 + ai * HALF + m * 16) * D + col0;
#pragma unroll
                    for (int bj = 0; bj < 2; ++bj) {
                        const f32x4 v0 = acc[ai][bj][m][0], v1 = acc[ai][bj][m][1];
                        u32x4 w; w.x = pk2(v0[0], v0[1]); w.y = pk2(v0[2], v0[3]); w.z = pk2(v1[0], v1[1]); w.w = pk2(v1[2], v1[3]);
                        *(u32x4*)(rowp + bj * HALF) = w;
                    }
                }
        } else {
            const int col0 = u.pn * BM + wc * 32 + 8 * fq;
            float sA = 1.f, sB = 1.f;
            if (mode == 4) scales2(u, wr, fr, fq, sA, sB);
            f32x4 bvv[4];
#pragma unroll
            for (int q = 0; q < 4; ++q) bvv[q] = (mode != 4 && bias) ? *(const f32x4*)(bias + col0 + (q >> 1) * HALF + (q & 1) * 4) : (f32x4){0.f, 0.f, 0.f, 0.f};
            f32x4 xi[2][4]; u32x4 pq[2][2]; u32x4 xh[2][2], xl[2][2];
            {
                const size_t off = (size_t)row0 * D + col0;
#pragma unroll
                for (int bj = 0; bj < 2; ++bj) {
                    const size_t o = off + bj * HALF;
                    if (mode == 5) { xi[0][2 * bj] = *(const f32x4*)(xin + o); xi[0][2 * bj + 1] = *(const f32x4*)(xin + o + 4); }
                    else { xh[0][bj] = *(const u32x4*)(hin + o); xl[0][bj] = *(const u32x4*)(lin + o); }
                    if (mode == 4) pq[0][bj] = *(const u32x4*)(ob + o);
                }
            }
#pragma unroll
            for (int g = 0; g < 8; ++g) {
                const int ai = g >> 2, m = g & 3, cb = g & 1, nb = cb ^ 1;
                const int row = row0 + ai * HALF + m * 16;
                const size_t off = (size_t)row * D + col0;
                if (g < 7) {
                    const size_t offn = (size_t)(row0 + ((g + 1) >> 2) * HALF + ((g + 1) & 3) * 16) * D + col0;
#pragma unroll
                    for (int bj = 0; bj < 2; ++bj) {
                        const size_t o = offn + bj * HALF;
                        if (mode == 5) { xi[nb][2 * bj] = *(const f32x4*)(xin + o); xi[nb][2 * bj + 1] = *(const f32x4*)(xin + o + 4); }
                        else { xh[nb][bj] = *(const u32x4*)(hin + o); xl[nb][bj] = *(const u32x4*)(lin + o); }
                        if (mode == 4) pq[nb][bj] = *(const u32x4*)(ob + o);
                    }
                }
                float s = 1.f;
                if (mode == 4) s = __shfl(ai ? sB : sA, m * 16 + fr);
                float ss = 0.f;
#pragma unroll
                for (int bj = 0; bj < 2; ++bj) {
                    u32x4 wh, wl;
#pragma unroll
                    for (int n = 0; n < 2; ++n) {
                        const int q = 2 * bj + n;
                        const unsigned h0 = n ? xh[cb][bj].z : xh[cb][bj].x, h1 = n ? xh[cb][bj].w : xh[cb][bj].y, l0 = n ? xl[cb][bj].z : xl[cb][bj].x, l1 = n ? xl[cb][bj].w : xl[cb][bj].y;
                        f32x4 xo;
                        if (mode == 5) xo = xi[cb][q];
                        else { xo[0] = bf_lo(h0) + bf_lo(l0); xo[1] = bf_hi(h0) + bf_hi(l0); xo[2] = bf_lo(h1) + bf_lo(l1); xo[3] = bf_hi(h1) + bf_hi(l1); }
                        f32x4 v;
                        if (mode != 4) v = xo + acc[ai][bj][m][n] * alpha + bvv[q];
                        else {
                            const f32x4 a = acc[ai][bj][m][n] * s;
                            const unsigned p0 = n ? pq[cb][bj].z : pq[cb][bj].x, p1 = n ? pq[cb][bj].w : pq[cb][bj].y;
                            v[0] = xo[0] + sigmoidf_(a[0]) * bf_lo(p0); v[1] = xo[1] + sigmoidf_(a[1]) * bf_hi(p0);
                            v[2] = xo[2] + sigmoidf_(a[2]) * bf_lo(p1); v[3] = xo[3] + sigmoidf_(a[3]) * bf_hi(p1);
                        }
                        const unsigned w0 = pk2(v[0], v[1]), w1 = pk2(v[2], v[3]);
                        const unsigned m0 = pk2(v[0] - bf_lo(w0), v[1] - bf_hi(w0)), m1 = pk2(v[2] - bf_lo(w1), v[3] - bf_hi(w1));
                        if (n == 0) { wh.x = w0; wh.y = w1; wl.x = m0; wl.y = m1; } else { wh.z = w0; wh.w = w1; wl.z = m0; wl.w = m1; }
                        ss += (v[0] * v[0] + v[1] * v[1]) + (v[2] * v[2] + v[3] * v[3]);
                    }
                    *(u32x4*)(xb + off + bj * HALF) = wh;
                    *(u32x4*)(lout + off + bj * HALF) = wl;
                }
                ss += __shfl_xor(ss, 16); ss += __shfl_xor(ss, 32);
                if (fq == 0) ssq_out[(size_t)row * 16 + u.pn * 4 + wc] = ss;
            }
        }
    }
};

template <int MODE, class EpiT, class Sched>
__device__ __forceinline__ void gemm_phase(LAS unsigned char* lds, const Gemm g, const Sched& S, const EpiT& E) {
    const int tid = otid(), wid = __builtin_amdgcn_readfirstlane(tid >> 6), lane = tid & 63, wr = wid >> 2, wc = wid & 3, fr = lane & 15, fq = lane >> 4;
    const int K = g.K, nt = K / BK;
    unsigned voffA[2], voffB[2];
#pragma unroll
    for (int i = 0; i < 2; ++i) { int R, C; stage_rc(tid * 16 + i * 8192, R, C); voffA[i] = (unsigned)(R * K + C) * 2u; voffB[i] = (unsigned)(R * K + C) * 2u; }
    const size_t kstep = (size_t)(BK * 2);
    const size_t hstep = (size_t)HALF * K * 2;
    const size_t tstep = 2 * hstep;
    const unsigned ldsw = (unsigned)wid * 1024u;
    const int aoff = lds_byte(wr * 64 + fr, fq * 8), boff = lds_byte(wc * 32 + fr, fq * 8);
#define PG8_SA(b, h) (((b) * 2 + (h)) * HTB)
#define PG8_SB(b, h) ((4 + (b) * 2 + (h)) * HTB)
#define PG8_STAGE(bufoff, gbase, voff) do { _Pragma("unroll") for (int _i = 0; _i < 2; ++_i) \
        __builtin_amdgcn_global_load_lds((const unsigned*)((const char*)(gbase) + (voff)[_i]), (LAS unsigned*)(lds + (bufoff) + ldsw + _i * 8192), 16, 0, 0); } while (0)
#define PG8_LDA(dst, b, h) do { _Pragma("unroll") for (int m = 0; m < 4; ++m) _Pragma("unroll") for (int k = 0; k < 2; ++k) dst[m][k] = *(const LAS bf16x8*)(lds + PG8_SA(b, h) + aoff + m * 2048 + k * 1024); } while (0)
#define PG8_LDB(dst, b, h) do { _Pragma("unroll") for (int n = 0; n < 2; ++n) _Pragma("unroll") for (int k = 0; k < 2; ++k) dst[n][k] = *(const LAS bf16x8*)(lds + PG8_SB(b, h) + boff + n * 2048 + k * 1024); } while (0)
#define PG8_MMA(ai, bj, At, Bt) do { __builtin_amdgcn_s_setprio(1); _Pragma("unroll") for (int m = 0; m < 4; ++m) _Pragma("unroll") for (int n = 0; n < 2; ++n) _Pragma("unroll") for (int k = 0; k < 2; ++k) \
        acc[ai][bj][m][n] = __builtin_amdgcn_mfma_f32_16x16x32_bf16(Bt[n][k], At[m][k], acc[ai][bj][m][n], 0, 0, 0); __builtin_amdgcn_s_setprio(0); } while (0)
#define PG8_WAIT_V(n) asm volatile("s_waitcnt vmcnt(" #n ")" ::: "memory")
#define PG8_WAIT_L(n) asm volatile("s_waitcnt lgkmcnt(" #n ")" ::: "memory")
#define PG8_BAR __builtin_amdgcn_s_barrier()
#define PG8_SCHED __builtin_amdgcn_sched_barrier(0)
    Unit cur, nxt; int ui = 0;
    if (!S.next(0, cur)) return;
    LAS float* SC = (LAS float*)(lds + STAGE_BYTES);
    if (MODE <= 1) {
        f32x4 pa[6], pb[6]; bool ok[6];
#pragma unroll
        for (int i = 0; i < 6; ++i) {
            Unit uu; ok[i] = S.next(i, uu);
            const int row = (ok[i] ? uu.pm : cur.pm) * BM + (tid >> 1);
            const f32x4* p = (const f32x4*)(E.ssq_in + (size_t)row * 16) + (tid & 1) * 2;
            pa[i] = p[0]; pb[i] = p[1];
        }
#pragma unroll
        for (int i = 0; i < 6; ++i) {
            float s = ((pa[i][0] + pa[i][1]) + (pa[i][2] + pa[i][3])) + ((pb[i][0] + pb[i][1]) + (pb[i][2] + pb[i][3]));
            s += __shfl_xor(s, 1);
            if (!(tid & 1)) SC[i * 256 + (tid >> 1)] = rsqrtf(s * (1.0f / 1024.0f) + EPS);
        }
        __syncthreads();
    }
    f32x4 acc[2][2][4][2];
#pragma unroll
    for (int a = 0; a < 2; ++a)
#pragma unroll
        for (int b = 0; b < 2; ++b)
#pragma unroll
            for (int m = 0; m < 4; ++m)
#pragma unroll
                for (int n = 0; n < 2; ++n) acc[a][b][m][n] = (f32x4){0.f, 0.f, 0.f, 0.f};
    bf16x8 At[4][2], B0[2][2], B1[2][2];
    const char* cA = (const char*)g.A + (size_t)cur.pm * tstep; const char* cB = (const char*)g.Bt + (size_t)cur.pn * tstep;
    PG8_STAGE(PG8_SB(0, 0), cB, voffB); PG8_STAGE(PG8_SA(0, 0), cA, voffA); PG8_STAGE(PG8_SB(0, 1), cB + hstep, voffB); PG8_STAGE(PG8_SA(0, 1), cA + hstep, voffA);
    if (wr == 1) PG8_BAR;
    PG8_WAIT_V(4); PG8_BAR;
    PG8_STAGE(PG8_SB(1, 0), cB + kstep, voffB); PG8_STAGE(PG8_SA(1, 0), cA + kstep, voffA); PG8_STAGE(PG8_SB(1, 1), cB + hstep + kstep, voffB);
    PG8_WAIT_V(6); PG8_BAR;
    for (;;) {
        const bool has_next = S.next(ui + 1, nxt);
        const char* nA = has_next ? (const char*)g.A + (size_t)nxt.pm * tstep : cA; const char* nB = has_next ? (const char*)g.Bt + (size_t)nxt.pn * tstep : cB;
        for (int t = 0; t < nt; t += 2) {
            const bool last = (t == nt - 2);
            const char* a1 = cA + (size_t)(t + 1) * kstep;
            const char* a2 = last ? nA : cA + (size_t)(t + 2) * kstep; const char* b2 = last ? nB : cB + (size_t)(t + 2) * kstep;
            const char* a3 = a2 + kstep; const char* b3 = b2 + kstep;
            PG8_LDB(B0, 0, 0); PG8_SCHED; PG8_LDA(At, 0, 0); PG8_STAGE(PG8_SA(1, 1), a1 + hstep, voffA);
            PG8_WAIT_L(8); PG8_BAR; PG8_WAIT_L(0); PG8_MMA(0, 0, At, B0); PG8_BAR; PG8_SCHED;
            PG8_LDB(B1, 0, 1); PG8_STAGE(PG8_SB(0, 0), b2, voffB);
            PG8_BAR; PG8_WAIT_L(0); PG8_MMA(0, 1, At, B1); PG8_BAR;
            PG8_LDA(At, 0, 1); PG8_STAGE(PG8_SA(0, 0), a2, voffA);
            PG8_BAR; PG8_WAIT_L(0); PG8_MMA(1, 0, At, B0); PG8_BAR; PG8_SCHED;
            PG8_STAGE(PG8_SB(0, 1), b2 + hstep, voffB);
            PG8_WAIT_V(6); PG8_BAR; PG8_MMA(1, 1, At, B1); PG8_BAR;
            PG8_LDB(B0, 1, 0); PG8_SCHED; PG8_LDA(At, 1, 0); PG8_STAGE(PG8_SA(0, 1), a2 + hstep, voffA);
            PG8_WAIT_L(8); PG8_BAR; PG8_WAIT_L(0); PG8_MMA(0, 0, At, B0); PG8_BAR; PG8_SCHED;
            PG8_LDB(B1, 1, 1); PG8_STAGE(PG8_SB(1, 0), b3, voffB);
            PG8_BAR; PG8_WAIT_L(0); PG8_MMA(0, 1, At, B1); PG8_BAR;
            PG8_LDA(At, 1, 1); PG8_STAGE(PG8_SA(1, 0), a3, voffA);
            PG8_BAR; PG8_WAIT_L(0); PG8_MMA(1, 0, At, B0); PG8_BAR; PG8_SCHED;
            PG8_STAGE(PG8_SB(1, 1), b3 + hstep, voffB);
            PG8_WAIT_V(6); PG8_BAR; PG8_MMA(1, 1, At, B1); PG8_BAR;
        }
        E.template run<MODE>(acc, cur, wr, wc, fr, fq, SC + ui * 256);
        if (!has_next) break;
#pragma unroll
        for (int a = 0; a < 2; ++a)
#pragma unroll
            for (int b = 0; b < 2; ++b)
#pragma unroll
                for (int m = 0; m < 4; ++m)
#pragma unroll
                    for (int n = 0; n < 2; ++n) acc[a][b][m][n] = (f32x4){0.f, 0.f, 0.f, 0.f};
        cur = nxt; cA = nA; cB = nB; ++ui;
    }
    PG8_WAIT_V(0);
    if (wr == 0) PG8_BAR;
    PG8_BAR;
#undef PG8_SA
#undef PG8_SB
#undef PG8_STAGE
#undef PG8_LDA
#undef PG8_LDB
#undef PG8_MMA
#undef PG8_WAIT_V
#undef PG8_WAIT_L
#undef PG8_BAR
#undef PG8_SCHED
}
}

__device__ __forceinline__ void run_gemm(LAS unsigned char* lds, const bf16_t* A, const bf16_t* Bt, int N, int K, const pg8::Epi& E, int c0 = 0) {
    const int G_ = ogrid() - c0, c_ = obid() - c0;
    if (c_ < 0) return;
    pg8::Gemm g{A, Bt, T, N, K}; pg8::StaticOrder S; S.init(T, N, G_, c_);
    switch (E.mode) {
    case 0: pg8::gemm_phase<0, pg8::Epi, pg8::StaticOrder>(lds, g, S, E); break;
    case 1: pg8::gemm_phase<1, pg8::Epi, pg8::StaticOrder>(lds, g, S, E); break;
    case 2: pg8::gemm_phase<2, pg8::Epi, pg8::StaticOrder>(lds, g, S, E); break;
    case 3: pg8::gemm_phase<3, pg8::Epi, pg8::StaticOrder>(lds, g, S, E); break;
    case 4: pg8::gemm_phase<4, pg8::Epi, pg8::StaticOrder>(lds, g, S, E); break;
    default: pg8::gemm_phase<5, pg8::Epi, pg8::StaticOrder>(lds, g, S, E); break;
    }
}

struct CvtJob { const float* W; const float* gain; bf16_t* dst; int K, ldw, col0, ncols, mode; };

__device__ __forceinline__ CvtJob get_job(const Params& P, int j) {
    CvtJob J; J.gain = nullptr; J.col0 = 0; J.mode = 0;
    unsigned char* ws = P.ws;
    if (j < 16) {
        const int f = j >> 1, part = j & 1, L = f >> 1, w = f & 1;
        const float* src = w ? (part ? P.in[11] : P.in[10]) : (part ? P.in[6] : P.in[5]);
        J.W = src + (size_t)L * 1024 * 2816; J.gain = (w ? P.in[9] : P.in[4]) + L * 1024;
        J.dst = (bf16_t*)(ws + WS_WUP) + (size_t)f * 5632 * 1024 + (size_t)part * 128 * 1024;
        J.K = 1024; J.ldw = 2816; J.ncols = 2816; J.mode = 1;
    } else if (j < 24) {
        const int f = j - 16, L = f >> 1, w = f & 1;
        J.W = (w ? P.in[12] : P.in[7]) + (size_t)L * 2816 * 1024;
        J.dst = (bf16_t*)(ws + WS_WDN) + (size_t)f * 1024 * 2816;
        J.K = 2816; J.ldw = 1024; J.ncols = 1024;
    } else if (j < 28) {
        const int e = (j - 24) >> 1, part = (j - 24) & 1;
        J.W = P.in[16] + (size_t)e * 1024 * 2576; J.gain = P.in[8] + (2 * e) * 1024;
        J.dst = (bf16_t*)(ws + WS_WIN) + (size_t)e * 2816 * 1024 + (part ? (size_t)1536 * 1024 : 0);
        J.K = 1024; J.ldw = 2576; J.col0 = part ? 1552 : 0; J.ncols = part ? 1024 : 1536;
    } else if (j < 30) {
        const int e = j - 28;
        J.W = P.in[17] + (size_t)e * 1024 * 1024; J.dst = (bf16_t*)(ws + WS_WOUT) + (size_t)e * 1024 * 1024;
        J.K = 1024; J.ldw = 1024; J.ncols = 1024;
    } else if (j < 32) {
        const int o = j - 30;
        J.W = P.in[28] + (size_t)o * 1024 * 1536; J.gain = P.in[8] + (2 * o + 1) * 1024;
        J.dst = (bf16_t*)(ws + WS_WQKV) + (size_t)o * 1536 * 1024;
        J.K = 1024; J.ldw = 1536; J.ncols = 1536;
    } else if (j < 34) {
        const int o = j - 32;
        J.W = P.in[30] + (size_t)o * 1024 * 1024; J.dst = (bf16_t*)(ws + WS_WO) + (size_t)o * 1024 * 1024;
        J.K = 1024; J.ldw = 1024; J.ncols = 1024;
    } else if (j < 38) {
        const int L = j - 34;
        J.W = P.in[15] + (size_t)L * 1024 * 1024; J.gain = P.in[13] + L * 1024;
        J.dst = (bf16_t*)(ws + WS_WPG) + (size_t)L * 1024 * 1024;
        J.K = 1024; J.ldw = 1024; J.ncols = 1024;
    } else {
        const int L = j - 38;
        J.W = P.in[14] + (size_t)L * 256 * 1024; J.dst = (bf16_t*)(ws + WS_WPP) + (size_t)L * 1024 * 256;
        J.K = 256; J.ldw = 1024; J.ncols = 1024;
    }
    return J;
}

__device__ __forceinline__ void cvt_item64(const CvtJob& J, int item, LAS float* scr, int lane) {
    const int nblk = J.ncols / 64, kb = item / nblk, nb = item - kb * nblk, k0 = 64 * kb, n0 = 64 * nb;
    const int r4 = lane >> 4, c4 = (lane & 15) * 4;
    f32x4 w[16];
#pragma unroll
    for (int i = 0; i < 16; ++i) w[i] = *(const f32x4*)(J.W + (size_t)(k0 + 4 * i + r4) * J.ldw + J.col0 + n0 + c4);
    if (J.gain) {
#pragma unroll
        for (int i = 0; i < 16; ++i) w[i] = w[i] * J.gain[k0 + 4 * i + r4];
    }
#pragma unroll
    for (int i = 0; i < 16; ++i) { LAS float* d = scr + (4 * i + r4) * 65 + c4; d[0] = w[i][0]; d[1] = w[i][1]; d[2] = w[i][2]; d[3] = w[i][3]; }
    asm volatile("s_waitcnt lgkmcnt(0)" ::: "memory");
    const int c = lane & 7;
#pragma unroll
    for (int j = 0; j < 8; ++j) {
        const int n = (lane >> 3) + 8 * j; const LAS float* s = scr + (8 * c) * 65 + n;
        u32x4 o; o.x = pk2(s[0 * 65], s[1 * 65]); o.y = pk2(s[2 * 65], s[3 * 65]); o.z = pk2(s[4 * 65], s[5 * 65]); o.w = pk2(s[6 * 65], s[7 * 65]);
        const int nn = n0 + n; const int row_ = J.mode ? ((nn >> 7) * 256 + (nn & 127)) : nn;
        const int row = (row_ & ~31) + pinv32(row_ & 31);
        *(u32x4*)(J.dst + (size_t)row * J.K + k0 + 8 * c) = o;
    }
    asm volatile("s_waitcnt lgkmcnt(0)" ::: "memory");
}
__device__ __forceinline__ void cvt_map(int it, int& job, int& local) {
    if (it < 16896) { job = it / 704; local = it - job * 704; }
    else {
        int r = it - 16896;
        if (r < 1280) { const int e = r / 640, rr = r - e * 640, part = rr >= 384; local = part ? rr - 384 : rr; job = 24 + 2 * e + part; }
        else { r -= 1280;
            if (r < 512) { job = 28 + (r >> 8); local = r & 255; }
            else { r -= 512;
                if (r < 768) { const int o = r / 384; job = 30 + o; local = r - o * 384; }
                else { r -= 768;
                    if (r < 1536) { job = 32 + (r >> 8); local = r & 255; }
                    else { r -= 1536; job = 38 + (r >> 6); local = r & 63; } } } }
    }
}

__device__ __forceinline__ void first_token_qk(const Params& P, LAS unsigned char* lds, int L, int c0) {
    const int j = obid() - c0;
    if (j < 0 || j >= 64) return;
    const int e = L >> 1, tid = otid(), col = tid & 7, dg = tid >> 3;
    const float* W = P.in[16] + (size_t)e * 1024 * 2576 + 8 * j + col;
    float w[16];
#pragma unroll
    for (int q = 0; q < 16; ++q) w[q] = W[(size_t)(dg * 16 + q) * 2576];
    LAS float* X = (LAS float*)lds;
    {
        const int b = tid >> 7, d0 = (tid & 127) * 8;
        const size_t o = (size_t)(b * SEQ) * D + d0;
        const u32x4 h8 = *(const u32x4*)((const bf16_t*)(P.ws + WS_XB) + o), l8 = *(const u32x4*)((const bf16_t*)P.out + o);
        const f32x4 g0 = *(const f32x4*)(P.in[8] + L * 1024 + d0), g1 = *(const f32x4*)(P.in[8] + L * 1024 + d0 + 4);
        f32x4 a, c;
        a[0] = (bf_lo(h8.x) + bf_lo(l8.x)) * g0[0]; a[1] = (bf_hi(h8.x) + bf_hi(l8.x)) * g0[1]; a[2] = (bf_lo(h8.y) + bf_lo(l8.y)) * g0[2]; a[3] = (bf_hi(h8.y) + bf_hi(l8.y)) * g0[3];
        c[0] = (bf_lo(h8.z) + bf_lo(l8.z)) * g1[0]; c[1] = (bf_hi(h8.z) + bf_hi(l8.z)) * g1[1]; c[2] = (bf_lo(h8.w) + bf_lo(l8.w)) * g1[2]; c[3] = (bf_hi(h8.w) + bf_hi(l8.w)) * g1[3];
        *(LAS f32x4*)(X + b * 1024 + d0) = a; *(LAS f32x4*)(X + b * 1024 + d0 + 4) = c;
    }
    __syncthreads();
    float acc[4] = {0.f, 0.f, 0.f, 0.f};
#pragma unroll
    for (int b = 0; b < 4; ++b)
#pragma unroll
        for (int q4 = 0; q4 < 4; ++q4) {
            const f32x4 xv = *(const LAS f32x4*)(X + b * 1024 + dg * 16 + 4 * q4);
            acc[b] += xv[0] * w[4 * q4] + xv[1] * w[4 * q4 + 1] + xv[2] * w[4 * q4 + 2] + xv[3] * w[4 * q4 + 3];
        }
    LAS float* R = X + 4096;
#pragma unroll
    for (int b = 0; b < 4; ++b) R[(dg * 8 + col) * 4 + b] = acc[b];
    __syncthreads();
    if (tid < 32) {
        const int c = tid & 7, b = tid >> 3;
        float s = 0.f;
        for (int g = 0; g < 64; ++g) s += R[(g * 8 + c) * 4 + b];
        const float* ssq = (const float*)(P.ws + WS_SSQ) + (size_t)((4 * L + 1) & 1) * T * 16;
        ((float*)(P.ws + WS_QK0))[b * 512 + 8 * j + c] = s * pg8::row_scale(ssq, b * SEQ);
    }
    __syncthreads();
}

__device__ __forceinline__ void layer_small_cvt(const Params& P, int L, int c0) {
    const int nb = ogrid() - c0, bi = obid() - c0;
    if (bi < 0) return;
    const int gt = bi * NTHREADS + otid(), NGT = nb * NTHREADS;
    unsigned char* ws = P.ws;
    const f32x4* p4 = (const f32x4*)P.in[1] + (size_t)L * (T * 256 / 4); u32x2* pb = (u32x2*)(ws + WS_PB) + (size_t)L * (T * 256 / 4);
#pragma unroll 8
    for (int i = gt; i < T * 256 / 4; i += NGT) { const f32x4 v = p4[i]; u32x2 w; w.x = pk2(v[0], v[1]); w.y = pk2(v[2], v[3]); pb[i] = w; }
    if (!(L & 1)) {
        const int e = L >> 1;
        for (int idx = gt; idx < 256 * 1024; idx += NGT) {
            const int n = idx >> 10, k = idx & 1023;
            const float* wi = P.in[16] + (size_t)e * 1024 * 2576 + (size_t)k * 2576 + 1536;
            const float* wf = P.in[18] + e * 16 * 256 + n;
            float s = 0.f;
#pragma unroll
            for (int r = 0; r < 16; ++r) s += wi[r] * wf[r * 256];
            s *= P.in[8][(2 * e) * 1024 + k];
            ((bf16_t*)(ws + WS_WIN))[(size_t)e * 2816 * 1024 + (size_t)(2560 + (n & ~31) + pinv32(n & 31)) * 1024 + k] = (bf16_t)f2bf(s);
        }
    }
}

__device__ __forceinline__ void phase_prepass(const Params& P, LAS unsigned char* lds) {
    const int tid = otid(), lane = tid & 63, wave = tid >> 6;
    const int gw = obid() * 8 + wave, NGW = ogrid() * 8;
    const int gt = obid() * NTHREADS + tid, NGT = ogrid() * NTHREADS;
    unsigned char* ws = P.ws;
    LAS float* scr = (LAS float*)(lds + wave * 16640);
    for (int rp_ = 0; rp_ < (PROBE_DUP == 9 ? 2 : 1); ++rp_)
    for (int it = gw; it < 21248; it += NGW) {
        int job, local; cvt_map(it, job, local);
        const CvtJob J = get_job(P, job);
        cvt_item64(J, local, scr, lane);
    }
    float* ssq = (float*)(ws + WS_SSQ);
    bf16_t* xb = (bf16_t*)(ws + WS_MIX);
    for (int m = gw; m < T; m += NGW) {
        const f32x4* xr = (const f32x4*)(P.in[0] + (size_t)m * D) + lane;
        f32x4 v[4]; float s = 0.f;
#pragma unroll
        for (int j = 0; j < 4; ++j) { v[j] = xr[64 * j]; s += (v[j][0] * v[j][0] + v[j][1] * v[j][1]) + (v[j][2] * v[j][2] + v[j][3] * v[j][3]); }
        s = wave_sum(s);
        u32x2* o8 = (u32x2*)(xb + (size_t)m * D) + lane;
#pragma unroll
        for (int j = 0; j < 4; ++j) { u32x2 w; w.x = pk2(v[j][0], v[j][1]); w.y = pk2(v[j][2], v[j][3]); o8[64 * j] = w; }
        if (lane < 16) ssq[(size_t)m * 16 + lane] = (lane == 0) ? s : 0.f;
    }
}

constexpr int LDT = 68;
constexpr int GO_BT = 0, GO_SEG = 4352, GO_QDT = 4864, GO_KDNT = 9216, GO_ATT = 13568, GO_V = 17920, GO_S = 26112;

template <bool WITH_Q>
__device__ __forceinline__ void gla_prolog(LAS float* L, const u32x4 k8, const u32x4 f8, const u32x4 q8, const f32x4 bf0, const f32x4 bf1, float (&kv)[8], float (&qv)[8]) {
    const int tid = otid(), lane = tid & 63, wave = tid >> 6;
    kv[0] = bf_lo(k8.x); kv[1] = bf_hi(k8.x); kv[2] = bf_lo(k8.y); kv[3] = bf_hi(k8.y); kv[4] = bf_lo(k8.z); kv[5] = bf_hi(k8.z); kv[6] = bf_lo(k8.w); kv[7] = bf_hi(k8.w);
    if (WITH_Q) {
        qv[0] = bf_lo(q8.x); qv[1] = bf_hi(q8.x); qv[2] = bf_lo(q8.y); qv[3] = bf_hi(q8.y); qv[4] = bf_lo(q8.z); qv[5] = bf_hi(q8.z); qv[6] = bf_lo(q8.w); qv[7] = bf_hi(q8.w);
    }
    float fv[8];
    fv[0] = bf_lo(f8.x); fv[1] = bf_hi(f8.x); fv[2] = bf_lo(f8.y); fv[3] = bf_hi(f8.y); fv[4] = bf_lo(f8.z); fv[5] = bf_hi(f8.z); fv[6] = bf_lo(f8.w); fv[7] = bf_hi(f8.w);
#pragma unroll
    for (int j = 0; j < 8; ++j) L[GO_BT + (8 * wave + j) * LDT + lane] = logsigmoidf_(fv[j] + (j < 4 ? bf0[j & 3] : bf1[j & 3])) * (1.0f / 16.0f);
    __syncthreads();
    float pr[8];
    {
        const f32x4 a = *(const LAS f32x4*)(L + GO_BT + lane * LDT + 8 * wave), b = *(const LAS f32x4*)(L + GO_BT + lane * LDT + 8 * wave + 4);
        pr[0] = a[0]; pr[1] = pr[0] + a[1]; pr[2] = pr[1] + a[2]; pr[3] = pr[2] + a[3]; pr[4] = pr[3] + b[0]; pr[5] = pr[4] + b[1]; pr[6] = pr[5] + b[2]; pr[7] = pr[6] + b[3];
        L[GO_SEG + wave * 64 + lane] = pr[7];
    }
    __syncthreads();
    {
        float off = 0.f;
        for (int s = 0; s < wave; ++s) off += L[GO_SEG + s * 64 + lane];
        f32x4 a, b; a[0] = pr[0] + off; a[1] = pr[1] + off; a[2] = pr[2] + off; a[3] = pr[3] + off; b[0] = pr[4] + off; b[1] = pr[5] + off; b[2] = pr[6] + off; b[3] = pr[7] + off;
        *(LAS f32x4*)(L + GO_BT + lane * LDT + 8 * wave) = a; *(LAS f32x4*)(L + GO_BT + lane * LDT + 8 * wave + 4) = b;
    }
    __syncthreads();
}

constexpr int MLD = 72;
constexpr int GB_QDB = 19456, GB_KDB = 28672, GB_VT = 37888, GB_STB = 56320, GB_RED = 74752;

__device__ __forceinline__ void stage_vT(LAS unsigned char* lds, int tid, const u32x4 (&vv)[2]) {
    LAS bf16_t* VT = (LAS bf16_t*)(lds + GB_VT);
#pragma unroll
    for (int r = 0; r < 2; ++r) {
        const int c = r * 512 + tid, j = c & 63, vc = c >> 6;
        const u32x4 v = vv[r];
        LAS bf16_t* d = VT + (32 * (vc >> 2) + 4 * (vc & 3)) * MLD + j;
        d[0 * MLD] = (bf16_t)(v.x & 0xffffu); d[1 * MLD] = (bf16_t)(v.x >> 16); d[2 * MLD] = (bf16_t)(v.y & 0xffffu); d[3 * MLD] = (bf16_t)(v.y >> 16);
        d[16 * MLD] = (bf16_t)(v.z & 0xffffu); d[17 * MLD] = (bf16_t)(v.z >> 16); d[18 * MLD] = (bf16_t)(v.w & 0xffffu); d[19 * MLD] = (bf16_t)(v.w >> 16);
    }
}

#define GLA_LOAD(ITEM, WITHQ) do { const int h_ = (ITEM) & 3, bn_ = (ITEM) >> 2, t0_ = (bn_ >> 6) * SEQ + (bn_ & 63) * 64; \
        const bf16_t* z_ = (const bf16_t*)(P.ws + WS_HZ) + (size_t)(t0_ + lane) * ZW; \
        k8 = *(const u32x4*)(z_ + 256 + h_ * 64 + 8 * wave); f8 = *(const u32x4*)(z_ + 2560 + h_ * 64 + 8 * wave); \
        if (WITHQ) q8 = *(const u32x4*)(z_ + h_ * 64 + 8 * wave); \
        _Pragma("unroll") for (int r_ = 0; r_ < 2; ++r_) { const int c_ = r_ * 512 + tid; \
            vv[r_] = *(const u32x4*)((const bf16_t*)(P.ws + WS_HZ) + (size_t)(t0_ + (c_ & 63)) * ZW + 512 + h_ * 128 + (c_ >> 6) * 8); } \
        const float* bfp_ = P.in[19] + e * 256 + h_ * 64 + 8 * wave; bf0 = *(const f32x4*)bfp_; bf1 = *(const f32x4*)(bfp_ + 4); } while (0)

__device__ __forceinline__ void phase_g1(const Params& P, LAS unsigned char* lds, int e) {
    LAS float* L = (LAS float*)lds;
    const int tid = otid(), lane = tid & 63, wave = tid >> 6, l15 = lane & 15, quad = lane >> 4;
    float* Sbuf = (float*)(P.ws + WS_S); float* decay = (float*)(P.ws + WS_DECAY);
    LAS bf16_t* KDB = (LAS bf16_t*)(lds + GB_KDB); LAS bf16_t* VT = (LAS bf16_t*)(lds + GB_VT);
    u32x4 k8, f8, q8 = (u32x4){0u, 0u, 0u, 0u}, vv[2]; f32x4 bf0, bf1;
    const int gstep = ogrid(), item0 = obid();
    if (item0 < 1024) GLA_LOAD(item0, false);
    for (int item = item0; item < 1024; item += gstep) {
        float kv[8], qv[8];
        gla_prolog<false>(L, k8, f8, q8, bf0, bf1, kv, qv);
#pragma unroll
        for (int j = 0; j < 8; ++j) {
            const float bv = L[GO_BT + (8 * wave + j) * LDT + lane], bl = L[GO_BT + (8 * wave + j) * LDT + 63];
            KDB[(8 * wave + j) * MLD + lane] = (bf16_t)f2bf(kv[j] * __expf(bl - bv));
        }
        stage_vT(lds, tid, vv);
        if (item + gstep < 1024) GLA_LOAD(item + gstep, false);
        if (tid < 64) decay[item * 64 + tid] = __expf(L[GO_BT + tid * LDT + 63]);
        __syncthreads();
        const int dk0 = 16 * (wave & 3);
        const bf16x8 bk0 = *(const LAS bf16x8*)(KDB + (dk0 + l15) * MLD + 8 * quad), bk1 = *(const LAS bf16x8*)(KDB + (dk0 + l15) * MLD + 32 + 8 * quad);
#pragma unroll
        for (int t = 0; t < 4; ++t) {
            const int dv0 = 16 * ((wave >> 2) * 4 + t);
            const bf16x8 a0 = *(const LAS bf16x8*)(VT + (dv0 + l15) * MLD + 8 * quad), a1 = *(const LAS bf16x8*)(VT + (dv0 + l15) * MLD + 32 + 8 * quad);
            f32x4 acc = (f32x4){0.f, 0.f, 0.f, 0.f};
            acc = __builtin_amdgcn_mfma_f32_16x16x32_bf16(a0, bk0, acc, 0, 0, 0);
            acc = __builtin_amdgcn_mfma_f32_16x16x32_bf16(a1, bk1, acc, 0, 0, 0);
            const int tp = (wave >> 2) * 4 + t;
            float* o = Sbuf + (size_t)item * 8192 + (32 * (tp >> 1) + 8 * quad + 4 * (tp & 1)) * 64 + dk0 + l15;
            o[0] = acc[0]; o[64] = acc[1]; o[128] = acc[2]; o[192] = acc[3];
        }
        __syncthreads();
    }
}

__device__ __forceinline__ void phase_g2(const Params& P) {
    const float* Sbuf = (const float*)(P.ws + WS_S); const float* decay = (const float*)(P.ws + WS_DECAY);
    bf16_t* Sb = (bf16_t*)P.out + (size_t)T * D;
    for (int idx = obid() * NTHREADS + otid(); idx < 16 * 8192; idx += ogrid() * NTHREADS) {
        const int bh = idx >> 13, el = idx & 8191, b = bh >> 2, h = bh & 3, dk = el & 63;
        float run = 0.f;
        for (int n0 = 0; n0 < 64; n0 += 32) {
            float kvn[32], dc[32];
#pragma unroll
            for (int j = 0; j < 32; ++j) { const int item = ((b * 64 + n0 + j) << 2) + h; kvn[j] = Sbuf[(size_t)item * 8192 + el]; dc[j] = decay[item * 64 + dk]; }
#pragma unroll
            for (int j = 0; j < 32; ++j) { const int item = ((b * 64 + n0 + j) << 2) + h; Sb[(size_t)item * 8192 + el] = (bf16_t)f2bf(run); run = dc[j] * run + kvn[j]; }
        }
    }
}

__device__ __forceinline__ void phase_g3(const Params& P, LAS unsigned char* lds, int e) {
    LAS float* L = (LAS float*)lds;
    const int tid = otid(), lane = tid & 63, wave = tid >> 6, l15 = lane & 15, quad = lane >> 4;
    const bf16_t* Sb = (const bf16_t*)P.out + (size_t)T * D;
    const bf16_t* zb = (const bf16_t*)(P.ws + WS_HZ);
    bf16_t* mix = (bf16_t*)(P.ws + WS_MIX);
    LAS bf16_t* QDB = (LAS bf16_t*)(lds + GB_QDB); LAS bf16_t* KDB = (LAS bf16_t*)(lds + GB_KDB); LAS bf16_t* VT = (LAS bf16_t*)(lds + GB_VT); LAS bf16_t* STB = (LAS bf16_t*)(lds + GB_STB);
    LAS float* RED = (LAS float*)(lds + GB_RED);
    u32x4 k8, f8, q8, vv[2], sv[2]; f32x4 bf0, bf1;
    const int gstep = ogrid(), item0 = obid();
#define G3_LOADS(ITEM) do { _Pragma("unroll") for (int r_ = 0; r_ < 2; ++r_) sv[r_] = *(const u32x4*)(Sb + (size_t)(ITEM) * 8192 + 8 * (r_ * 512 + tid)); } while (0)
    if (item0 < 1024) { GLA_LOAD(item0, true); G3_LOADS(item0); }
    for (int item = item0; item < 1024; item += gstep) {
        const int h = item & 3, bn = item >> 2, b = bn >> 6, n = bn & 63;
        const int t0 = b * SEQ + n * 64;
        float kv[8], qv[8];
        gla_prolog<true>(L, k8, f8, q8, bf0, bf1, kv, qv);
        {
            float qd[8], kd[8];
#pragma unroll
            for (int j = 0; j < 8; ++j) {
                const float bv = L[GO_BT + (8 * wave + j) * LDT + lane];
                qd[j] = qv[j] * 0.125f * __expf(bv); kd[j] = kv[j] * __expf(-bv);
            }
            u32x4 wq, wk;
            wq.x = pk2(qd[0], qd[1]); wq.y = pk2(qd[2], qd[3]); wq.z = pk2(qd[4], qd[5]); wq.w = pk2(qd[6], qd[7]);
            wk.x = pk2(kd[0], kd[1]); wk.y = pk2(kd[2], kd[3]); wk.z = pk2(kd[4], kd[5]); wk.w = pk2(kd[6], kd[7]);
            *(LAS u32x4*)(QDB + lane * MLD + 8 * wave) = wq; *(LAS u32x4*)(KDB + lane * MLD + 8 * wave) = wk;
        }
        stage_vT(lds, tid, vv);
#pragma unroll
        for (int r = 0; r < 2; ++r) {
            const int c = r * 512 + tid, v = c >> 3, k8i = (c & 7) * 8;
            *(LAS u32x4*)(STB + ((v & ~31) + pinv32(v & 31)) * MLD + k8i) = sv[r];
        }
        if (item + gstep < 1024) { GLA_LOAD(item + gstep, true); G3_LOADS(item + gstep); }
        __syncthreads();
        const int it = wave & 3, i0 = 16 * it, vh = wave >> 2;
        const bf16x8 bq0 = *(const LAS bf16x8*)(QDB + (i0 + l15) * MLD + 8 * quad), bq1 = *(const LAS bf16x8*)(QDB + (i0 + l15) * MLD + 32 + 8 * quad);
        f32x4 s[4];
#pragma unroll
        for (int jt = 0; jt < 4; ++jt) {
            const bf16x8 a0 = *(const LAS bf16x8*)(KDB + (16 * jt + l15) * MLD + 8 * quad), a1 = *(const LAS bf16x8*)(KDB + (16 * jt + l15) * MLD + 32 + 8 * quad);
            f32x4 z = (f32x4){0.f, 0.f, 0.f, 0.f};
            z = __builtin_amdgcn_mfma_f32_16x16x32_bf16(a0, bq0, z, 0, 0, 0);
            z = __builtin_amdgcn_mfma_f32_16x16x32_bf16(a1, bq1, z, 0, 0, 0);
#pragma unroll
            for (int r = 0; r < 4; ++r) z[r] = (16 * jt + 4 * quad + r <= i0 + l15) ? z[r] : 0.f;
            s[jt] = z;
            if (jt == 0 && n == 0 && it == 0) {
                const float* qk = (const float*)(P.ws + WS_QK0) + b * 512 + h * 64 + lane;
                const float c0v = wave_sum(qk[0] * qk[256]) * 0.125f;
                if (lane == 0) s[0][0] = c0v;
            }
        }
        bf16x8 pf[2];
#pragma unroll
        for (int jp = 0; jp < 2; ++jp) {
            u32x4 pw; pw.x = pk2(s[2 * jp][0], s[2 * jp][1]); pw.y = pk2(s[2 * jp][2], s[2 * jp][3]); pw.z = pk2(s[2 * jp + 1][0], s[2 * jp + 1][1]); pw.w = pk2(s[2 * jp + 1][2], s[2 * jp + 1][3]);
            pf[jp] = __builtin_bit_cast(bf16x8, pw);
        }
        f32x4 o[4]; float ss = 0.f;
#pragma unroll
        for (int t = 0; t < 4; ++t) {
            const int v0 = 16 * (vh * 4 + t);
            f32x4 acc = (f32x4){0.f, 0.f, 0.f, 0.f};
#pragma unroll
            for (int jp = 0; jp < 2; ++jp) {
                const LAS bf16_t* vp = VT + (v0 + l15) * MLD + 32 * jp + 4 * quad;
                const u32x2 va = *(const LAS u32x2*)vp, vb = *(const LAS u32x2*)(vp + 16);
                u32x4 vw; vw.x = va.x; vw.y = va.y; vw.z = vb.x; vw.w = vb.y;
                acc = __builtin_amdgcn_mfma_f32_16x16x32_bf16(__builtin_bit_cast(bf16x8, vw), pf[jp], acc, 0, 0, 0);
            }
            const bf16x8 s0 = *(const LAS bf16x8*)(STB + (v0 + l15) * MLD + 8 * quad), s1 = *(const LAS bf16x8*)(STB + (v0 + l15) * MLD + 32 + 8 * quad);
            acc = __builtin_amdgcn_mfma_f32_16x16x32_bf16(s0, bq0, acc, 0, 0, 0);
            acc = __builtin_amdgcn_mfma_f32_16x16x32_bf16(s1, bq1, acc, 0, 0, 0);
            o[t] = acc;
            ss += (acc[0] * acc[0] + acc[1] * acc[1]) + (acc[2] * acc[2] + acc[3] * acc[3]);
        }
        ss += __shfl_xor(ss, 16); ss += __shfl_xor(ss, 32);
        if (quad == 0) RED[vh * 64 + i0 + l15] = ss;
        __syncthreads();
        const float rs = rsqrtf((RED[i0 + l15] + RED[64 + i0 + l15]) * (1.0f / 128.0f) + EPS);
        const size_t tok = (size_t)(t0 + i0 + l15);
#pragma unroll
        for (int a = 0; a < 2; ++a) {
            const int v = 32 * (vh * 2 + a) + 8 * quad;
            const f32x4 ng0 = *(const f32x4*)(P.in[20] + e * 512 + h * 128 + v), ng1 = *(const f32x4*)(P.in[20] + e * 512 + h * 128 + v + 4);
            const u32x4 r4 = *(const u32x4*)(zb + tok * ZW + 1024 + h * 128 + v);
            u32x4 w;
            w.x = pk2(o[2 * a][0] * rs * ng0[0] * siluf_(bf_lo(r4.x)), o[2 * a][1] * rs * ng0[1] * siluf_(bf_hi(r4.x)));
            w.y = pk2(o[2 * a][2] * rs * ng0[2] * siluf_(bf_lo(r4.y)), o[2 * a][3] * rs * ng0[3] * siluf_(bf_hi(r4.y)));
            w.z = pk2(o[2 * a + 1][0] * rs * ng1[0] * siluf_(bf_lo(r4.z)), o[2 * a + 1][1] * rs * ng1[1] * siluf_(bf_hi(r4.z)));
            w.w = pk2(o[2 * a + 1][2] * rs * ng1[2] * siluf_(bf_lo(r4.w)), o[2 * a + 1][3] * rs * ng1[3] * siluf_(bf_hi(r4.w)));
            *(u32x4*)(mix + tok * D + h * 128 + v) = w;
        }
        __syncthreads();
    }
#undef G3_LOADS
}
#undef GLA_LOAD

constexpr int LO_XR = 0, LO_XCT = 4288;
constexpr int LB_XCB = 34560, LB_WAT = 43776, LB_WXT = 52992;
constexpr int LO_RT = 15552, LO_IT = 19904, LO_SEGA = 24256, LO_SEGH = 24768;

__device__ __forceinline__ void phase_l1(const Params& P, LAS unsigned char* lds, int e) {
    LAS float* L = (LAS float*)lds;
    const int tid = otid(), lane = tid & 63, wave = tid >> 6, l15 = lane & 15, quad = lane >> 4;
    const bf16_t* zb = (const bf16_t*)(P.ws + WS_HZ);
    float* HL = (float*)(P.ws + WS_HL); float* AC = (float*)(P.ws + WS_AC);
    LAS bf16_t* XCB = (LAS bf16_t*)(lds + LB_XCB); LAS bf16_t* WAT = (LAS bf16_t*)(lds + LB_WAT); LAS bf16_t* WXT = (LAS bf16_t*)(lds + LB_WXT);
    const int gstep = ogrid(), item0 = obid();
    const bool wconst = (gstep & 7) == 0;
    u32x4 xq0 = (u32x4){0u, 0u, 0u, 0u}, xq1 = (u32x4){0u, 0u, 0u, 0u};
#define L1_LOADXR(ITEM) do { const int g_ = (ITEM) & 7, bc_ = (ITEM) >> 3, c_ = bc_ & 63, t0_ = (bc_ >> 6) * SEQ + c_ * 64; \
        { const int row = tid >> 3, c8 = (tid & 7) * 8; xq0 = (u32x4){0u, 0u, 0u, 0u}; if (c_ > 0 || row >= 3) xq0 = *(const u32x4*)(zb + (size_t)(t0_ + row - 3) * ZW + 1536 + g_ * 64 + c8); } \
        if (tid < 24) { const int row = 64 + (tid >> 3), c8 = (tid & 7) * 8; xq1 = *(const u32x4*)(zb + (size_t)(t0_ + row - 3) * ZW + 1536 + g_ * 64 + c8); } } while (0)
    if (item0 < 2048) L1_LOADXR(item0);
    for (int item = item0; item < 2048; item += gstep) {
        const int g = item & 7, bc = item >> 3, b = bc >> 6, c = bc & 63;
        const int t0 = b * SEQ + c * 64, ch0 = g * 64;
        {
            const int row = tid >> 3, c8 = (tid & 7) * 8;
            f32x4 a, bq; a[0] = bf_lo(xq0.x); a[1] = bf_hi(xq0.x); a[2] = bf_lo(xq0.y); a[3] = bf_hi(xq0.y); bq[0] = bf_lo(xq0.z); bq[1] = bf_hi(xq0.z); bq[2] = bf_lo(xq0.w); bq[3] = bf_hi(xq0.w);
            *(LAS f32x4*)(L + LO_XR + row * 64 + c8) = a; *(LAS f32x4*)(L + LO_XR + row * 64 + c8 + 4) = bq;
            if (tid < 24) {
                const int row1 = 64 + (tid >> 3);
                a[0] = bf_lo(xq1.x); a[1] = bf_hi(xq1.x); a[2] = bf_lo(xq1.y); a[3] = bf_hi(xq1.y); bq[0] = bf_lo(xq1.z); bq[1] = bf_hi(xq1.z); bq[2] = bf_lo(xq1.w); bq[3] = bf_hi(xq1.w);
                *(LAS f32x4*)(L + LO_XR + row1 * 64 + c8) = a; *(LAS f32x4*)(L + LO_XR + row1 * 64 + c8 + 4) = bq;
            }
        }
        if (item + gstep < 2048) L1_LOADXR(item + gstep);
        if (!wconst || item == item0) {
            const f32x4* wa = (const f32x4*)(P.in[23] + (size_t)(e * 8 + g) * 4096); const f32x4* wx = (const f32x4*)(P.in[25] + (size_t)(e * 8 + g) * 4096);
#pragma unroll
            for (int r = 0; r < 2; ++r) {
                const int i4 = tid + 512 * r, i = i4 >> 4, j4 = (i4 & 15) * 4;
                const f32x4 va = wa[i4], vx = wx[i4];
#pragma unroll
                for (int q = 0; q < 4; ++q) { WAT[(j4 + q) * MLD + i] = (bf16_t)f2bf(va[q]); WXT[(j4 + q) * MLD + i] = (bf16_t)f2bf(vx[q]); }
            }
        }
        __syncthreads();
        {
            const float* cw = P.in[21] + e * 4 * 512 + ch0 + lane;
            const float w0 = cw[0], w1 = cw[512], w2 = cw[1024], w3 = cw[1536], cb = P.in[22][e * 512 + ch0 + lane];
            f32x4 a, bq;
#pragma unroll
            for (int j = 0; j < 8; ++j) {
                const int t = 8 * wave + j;
                const float v = L[LO_XR + (t + 0) * 64 + lane] * w0 + L[LO_XR + (t + 1) * 64 + lane] * w1 + L[LO_XR + (t + 2) * 64 + lane] * w2 + L[LO_XR + (t + 3) * 64 + lane] * w3 + cb;
                if (j < 4) a[j] = v; else bq[j - 4] = v;
                XCB[t * MLD + lane] = (bf16_t)f2bf(v);
            }
            *(LAS f32x4*)(L + LO_XCT + lane * LDT + 8 * wave) = a; *(LAS f32x4*)(L + LO_XCT + lane * LDT + 8 * wave + 4) = bq;
        }
        __syncthreads();
        {
            const int gate = wave >> 2, tt0 = 16 * (wave & 3);
            const LAS bf16_t* WT = gate ? WXT : WAT;
            const bf16x8 a0 = *(const LAS bf16x8*)(XCB + (tt0 + l15) * MLD + 8 * quad), a1 = *(const LAS bf16x8*)(XCB + (tt0 + l15) * MLD + 32 + 8 * quad);
            LAS float* O = L + (gate ? LO_IT : LO_RT);
            const float* bp = (gate ? P.in[26] : P.in[24]) + e * 512 + ch0;
#pragma unroll
            for (int jt = 0; jt < 4; ++jt) {
                const bf16x8 b0 = *(const LAS bf16x8*)(WT + (16 * jt + l15) * MLD + 8 * quad), b1 = *(const LAS bf16x8*)(WT + (16 * jt + l15) * MLD + 32 + 8 * quad);
                f32x4 acc = (f32x4){0.f, 0.f, 0.f, 0.f};
                acc = __builtin_amdgcn_mfma_f32_16x16x32_bf16(a0, b0, acc, 0, 0, 0);
                acc = __builtin_amdgcn_mfma_f32_16x16x32_bf16(a1, b1, acc, 0, 0, 0);
                const float bias = bp[16 * jt + l15];
                f32x4 w;
#pragma unroll
                for (int r = 0; r < 4; ++r) w[r] = sigmoidf_(acc[r] + bias);
                *(LAS f32x4*)(O + (16 * jt + l15) * LDT + tt0 + 4 * quad) = w;
            }
        }
        __syncthreads();
        {
            const float sp = softplusf_(-P.in[27][e * 512 + ch0 + lane]);
            const f32x4 r0 = *(const LAS f32x4*)(L + LO_RT + lane * LDT + 8 * wave), r1 = *(const LAS f32x4*)(L + LO_RT + lane * LDT + 8 * wave + 4);
            const f32x4 i0 = *(const LAS f32x4*)(L + LO_IT + lane * LDT + 8 * wave), i1 = *(const LAS f32x4*)(L + LO_IT + lane * LDT + 8 * wave + 4);
            const f32x4 x0 = *(const LAS f32x4*)(L + LO_XCT + lane * LDT + 8 * wave), x1 = *(const LAS f32x4*)(L + LO_XCT + lane * LDT + 8 * wave + 4);
            float Hl[8], Al[8]; float Hr = 0.f, Ar = 1.f;
#pragma unroll
            for (int j = 0; j < 8; ++j) {
                const float rr = j < 4 ? r0[j & 3] : r1[j & 3], ii = j < 4 ? i0[j & 3] : i1[j & 3], xx = j < 4 ? x0[j & 3] : x1[j & 3];
                const float la = -8.0f * rr * sp; const float a = __expf(la);
                const float u = __builtin_amdgcn_sqrtf(fmaxf(__builtin_fmaf(-a, a, 1.0f), 0.f)) * (ii * xx);
                Hr = a * Hr + u; Ar *= a; Hl[j] = Hr; Al[j] = Ar;
            }
            L[LO_SEGA + wave * 64 + lane] = Ar; L[LO_SEGH + wave * 64 + lane] = Hr;
            __syncthreads();
            float Hin = 0.f, Ain = 1.f;
            for (int s = 0; s < wave; ++s) { const float sa = L[LO_SEGA + s * 64 + lane], sh = L[LO_SEGH + s * 64 + lane]; Hin = sa * Hin + sh; Ain *= sa; }
#pragma unroll
            for (int j = 0; j < 8; ++j) {
                const size_t o = (size_t)(t0 + 8 * wave + j) * 512 + ch0 + lane;
                HL[o] = Hl[j] + Al[j] * Hin; AC[o] = Al[j] * Ain;
            }
        }
        __syncthreads();
    }
#undef L1_LOADXR
}

__device__ __forceinline__ void phase_l2(const Params& P) {
    const float* HL = (const float*)(P.ws + WS_HL); const float* AC = (const float*)(P.ws + WS_AC); float* carry = (float*)(P.ws + WS_CARRY);
    const int tid = otid(), lane = tid & 63, wave = tid >> 6;
    for (int seq = obid() * 8 + wave, sstep = ogrid() * 8; seq < 4 * 512; seq += sstep) {
        const int b = seq >> 9, ch = seq & 511;
        const size_t o = (size_t)(b * SEQ + lane * 64 + 63) * 512 + ch;
        float a = AC[o], h = HL[o];
#pragma unroll
        for (int d = 1; d < 64; d <<= 1) {
            const float ap = __shfl_up(a, d), hp = __shfl_up(h, d);
            if (lane >= d) { h = a * hp + h; a = ap * a; }
        }
        const float hin = __shfl_up(h, 1);
        carry[(b * 64 + lane) * 512 + ch] = lane == 0 ? 0.f : hin;
    }
}

__device__ __forceinline__ void phase_l3(const Params& P) {
    const float* HL = (const float*)(P.ws + WS_HL); const float* AC = (const float*)(P.ws + WS_AC); const float* carry = (const float*)(P.ws + WS_CARRY);
    const bf16_t* zb = (const bf16_t*)(P.ws + WS_HZ); bf16_t* mix = (bf16_t*)(P.ws + WS_MIX);
#pragma unroll 4
    for (int idx = obid() * NTHREADS + otid(); idx < T * 128; idx += ogrid() * NTHREADS) {
        const int tok = idx >> 7, ch = (idx & 127) * 4;
        const int b = tok >> 12, c = (tok & 4095) >> 6;
        const f32x4 hl = *(const f32x4*)(HL + (size_t)tok * 512 + ch), ac = *(const f32x4*)(AC + (size_t)tok * 512 + ch), cr = *(const f32x4*)(carry + (b * 64 + c) * 512 + ch);
        const u32x2 g2 = *(const u32x2*)(zb + (size_t)tok * ZW + 2048 + ch);
        const f32x4 hh = hl + ac * cr;
        u32x2 w; w.x = pk2(hh[0] * gelu_tanh(bf_lo(g2.x)), hh[1] * gelu_tanh(bf_hi(g2.x))); w.y = pk2(hh[2] * gelu_tanh(bf_lo(g2.y)), hh[3] * gelu_tanh(bf_hi(g2.y)));
        *(u32x2*)(mix + (size_t)tok * D + 512 + ch) = w;
    }
}

constexpr int AK_LD = 72, AV_LD = 264;
constexpr int AO_K = 0, AO_VT = 256 * AK_LD * 2, AO_BIAS = AO_VT + 64 * AV_LD * 2;

__device__ __forceinline__ void phase_attn(const Params& P, LAS unsigned char* lds, int o) {
    const int tid = otid(), lane = tid & 63, wave = tid >> 6, l15 = lane & 15, quad = lane >> 4;
    const bf16_t* qkv = (const bf16_t*)(P.ws + WS_HZ);
    bf16_t* mix = (bf16_t*)(P.ws + WS_MIX);
    LAS bf16_t* KS = (LAS bf16_t*)(lds + AO_K); LAS bf16_t* VT = (LAS bf16_t*)(lds + AO_VT); LAS float* BIAS = (LAS float*)(lds + AO_BIAS);
    const int gstep = ogrid(), item0 = obid();
    const bool hkconst = (gstep & 3) == 0;
    for (int item = item0; item < 512; item += gstep) {
        const int hk = item & 3, n = (item >> 2) & 31, b = item >> 7;
        const int tok0 = b * SEQ + n * 128 - 128;
#pragma unroll
        for (int r = 0; r < 4; ++r) {
            const int c = r * 512 + tid, key = c >> 3, dc = c & 7;
            u32x4 v = (u32x4){0u, 0u, 0u, 0u};
            if (n > 0 || key >= 128) v = *(const u32x4*)(qkv + (size_t)(tok0 + key) * QKVW + 1024 + hk * 64 + dc * 8);
            *(LAS u32x4*)(KS + key * AK_LD + dc * 8) = v;
        }
#pragma unroll
        for (int r = 0; r < 4; ++r) {
            const int c = r * 512 + tid, key = c & 255, dvc = c >> 8;
            u32x4 v = (u32x4){0u, 0u, 0u, 0u};
            if (n > 0 || key >= 128) v = *(const u32x4*)(qkv + (size_t)(tok0 + key) * QKVW + 1280 + hk * 64 + dvc * 8);
            LAS bf16_t* d = VT + (32 * (dvc >> 2) + 4 * (dvc & 3)) * AV_LD + key;
            d[0 * AV_LD] = (bf16_t)(v.x & 0xffffu); d[1 * AV_LD] = (bf16_t)(v.x >> 16); d[2 * AV_LD] = (bf16_t)(v.y & 0xffffu); d[3 * AV_LD] = (bf16_t)(v.y >> 16);
            d[16 * AV_LD] = (bf16_t)(v.z & 0xffffu); d[17 * AV_LD] = (bf16_t)(v.z >> 16); d[18 * AV_LD] = (bf16_t)(v.w & 0xffffu); d[19 * AV_LD] = (bf16_t)(v.w >> 16);
        }
        if (!hkconst || item == item0) {
            for (int idx = tid; idx < 4 * 192; idx += NTHREADS) {
                const int g = idx / 192, j = idx - g * 192, dist = (191 - j) - 32;
                float val = -1e30f;
                if (dist >= 0 && dist < 128) {
                    int bucket = dist;
                    if (dist >= 16) { int lg = 16 + (int)(__logf((float)dist * 0.0625f) / 2.0794415416798357f * 16.0f); bucket = lg < 31 ? lg : 31; }
                    val = P.in[2][bucket * 16 + hk * 4 + g] * 1.4426950408889634f;
                }
                BIAS[idx] = val;
            }
        }
        __syncthreads();
        const int g = wave >> 1, half = wave & 1, head = hk * 4 + g;
        const float sink2 = P.in[32][o * 16 + head] * 1.4426950408889634f;
        bf16x8 qn0, qn1;
        {
            const size_t qt = (size_t)(b * SEQ + n * 128 + 64 * half + l15);
            qn0 = *(const bf16x8*)(qkv + qt * QKVW + head * 64 + 8 * quad); qn1 = *(const bf16x8*)(qkv + qt * QKVW + head * 64 + 32 + 8 * quad);
        }
#pragma nounroll
        for (int rt = 0; rt < 4; ++rt) {
            const int q0 = 64 * half + 16 * rt, qi = q0 + l15;
            const size_t qtok = (size_t)(b * SEQ + n * 128 + qi);
            bf16x8 qf[2]; qf[0] = qn0; qf[1] = qn1;
            if (rt < 3) {
                const size_t qt = qtok + 16;
                qn0 = *(const bf16x8*)(qkv + qt * QKVW + head * 64 + 8 * quad); qn1 = *(const bf16x8*)(qkv + qt * QKVW + head * 64 + 32 + 8 * quad);
            }
            const int grp0 = q0 >> 5, tile0 = 2 * grp0;
            f32x4 s[10];
#pragma unroll
            for (int tt = 0; tt < 10; ++tt) {
                const int key = 16 * (tile0 + tt) + l15;
                const bf16x8 k0 = *(const LAS bf16x8*)(KS + key * AK_LD + 8 * quad), k1 = *(const LAS bf16x8*)(KS + key * AK_LD + 32 + 8 * quad);
                f32x4 z = (f32x4){0.f, 0.f, 0.f, 0.f};
                z = __builtin_amdgcn_mfma_f32_16x16x32_bf16(k0, qf[0], z, 0, 0, 0);
                z = __builtin_amdgcn_mfma_f32_16x16x32_bf16(k1, qf[1], z, 0, 0, 0);
                s[tt] = z;
            }
            float mx = sink2;
            {
                const LAS float* tb = BIAS + g * 192 + (31 - (q0 & 31) - l15 + 4 * quad);
#pragma unroll
                for (int tt = 0; tt < 10; ++tt)
#pragma unroll
                    for (int r = 0; r < 4; ++r) {
                        const float sc = __builtin_fmaf(s[tt][r], 0.125f * 1.4426950408889634f, tb[16 * tt + r]);
                        s[tt][r] = sc;
                    }
                if (n == 0) {
#pragma unroll
                    for (int tt = 0; tt < 10; ++tt)
#pragma unroll
                        for (int r = 0; r < 4; ++r) { const int kj = 16 * (tile0 + tt) + 4 * quad + r; if (kj < 128) s[tt][r] = -1e30f; }
                }
#pragma unroll
                for (int tt = 0; tt < 10; ++tt)
#pragma unroll
                    for (int r = 0; r < 4; ++r) mx = fmaxf(mx, s[tt][r]);
            }
            mx = fmaxf(mx, __shfl_xor(mx, 16)); mx = fmaxf(mx, __shfl_xor(mx, 32));
            float l = 0.f;
#pragma unroll
            for (int tt = 0; tt < 10; ++tt)
#pragma unroll
                for (int r = 0; r < 4; ++r) { const float p = __builtin_amdgcn_exp2f(s[tt][r] - mx); s[tt][r] = p; l += p; }
            l += __shfl_xor(l, 16); l += __shfl_xor(l, 32);
            l += __builtin_amdgcn_exp2f(sink2 - mx);
            f32x4 oacc[4];
#pragma unroll
            for (int t = 0; t < 4; ++t) oacc[t] = (f32x4){0.f, 0.f, 0.f, 0.f};
#pragma unroll
            for (int jp = 0; jp < 5; ++jp) {
                u32x4 pw; pw.x = pk2(s[2 * jp][0], s[2 * jp][1]); pw.y = pk2(s[2 * jp][2], s[2 * jp][3]); pw.z = pk2(s[2 * jp + 1][0], s[2 * jp + 1][1]); pw.w = pk2(s[2 * jp + 1][2], s[2 * jp + 1][3]);
                const bf16x8 pf = __builtin_bit_cast(bf16x8, pw);
                const int keybase = 32 * (grp0 + jp);
#pragma unroll
                for (int t = 0; t < 4; ++t) {
                    const LAS bf16_t* vp = VT + (16 * t + l15) * AV_LD + keybase + 4 * quad;
                    const u32x2 va = *(const LAS u32x2*)vp, vb = *(const LAS u32x2*)(vp + 16);
                    u32x4 vw; vw.x = va.x; vw.y = va.y; vw.z = vb.x; vw.w = vb.y;
                    oacc[t] = __builtin_amdgcn_mfma_f32_16x16x32_bf16(__builtin_bit_cast(bf16x8, vw), pf, oacc[t], 0, 0, 0);
                }
            }
            const float inv = 1.0f / l;
#pragma unroll
            for (int a = 0; a < 2; ++a) {
                u32x4 w; w.x = pk2(oacc[2 * a][0] * inv, oacc[2 * a][1] * inv); w.y = pk2(oacc[2 * a][2] * inv, oacc[2 * a][3] * inv);
                w.z = pk2(oacc[2 * a + 1][0] * inv, oacc[2 * a + 1][1] * inv); w.w = pk2(oacc[2 * a + 1][2] * inv, oacc[2 * a + 1][3] * inv);
                *(u32x4*)(mix + qtok * D + head * 64 + 32 * a + 8 * quad) = w;
            }
        }
        __syncthreads();
    }
}

__device__ __forceinline__ void phase_final(const Params& P) {
    const int tid_ = otid(); const int lane = tid_ & 63, wave = tid_ >> 6;
    const float* ssq = (const float*)(P.ws + WS_SSQ);
    const bf16_t* hi = (const bf16_t*)(P.ws + WS_MIX); const bf16_t* lo = (const bf16_t*)(P.ws + WS_HZ);
    for (int m = obid() * 8 + wave, mstep = ogrid() * 8; m < T; m += mstep) {
        const float s = pg8::row_scale(ssq, m);
        f32x4* xr = (f32x4*)(P.out + (size_t)m * D) + lane; const f32x4* gp = (const f32x4*)P.in[3] + lane;
        const u32x2* hp = (const u32x2*)(hi + (size_t)m * D) + lane; const u32x2* lp = (const u32x2*)(lo + (size_t)m * D) + lane;
#pragma unroll
        for (int j = 0; j < 4; ++j) {
            const u32x2 h2 = hp[64 * j], l2 = lp[64 * j]; const f32x4 g4 = gp[64 * j];
            f32x4 o; o[0] = (bf_lo(h2.x) + bf_lo(l2.x)) * s * g4[0]; o[1] = (bf_hi(h2.x) + bf_hi(l2.x)) * s * g4[1]; o[2] = (bf_lo(h2.y) + bf_lo(l2.y)) * s * g4[2]; o[3] = (bf_hi(h2.y) + bf_hi(l2.y)) * s * g4[3];
            xr[64 * j] = o;
        }
    }
}

#define XB_TMO      128
#define XB_XCNT(j)  (256  + 64 * (j))
#define XB_XSUB(j)  (1280 + 64 * (j))
#define XB_XGEN(j)  (2304 + 64 * (j))
#define XB_TOP      3328
#define XB_TOPGEN   3392
#define XCD_BAR_WORDS 3456
#define XB_SPIN_CAP (1u << 18)
__device__ __forceinline__ unsigned xb_ld(unsigned* p)              { return __hip_atomic_load(p, __ATOMIC_RELAXED, __HIP_MEMORY_SCOPE_AGENT); }
__device__ __forceinline__ unsigned xb_add(unsigned* p, unsigned v) { return __hip_atomic_fetch_add(p, v, __ATOMIC_RELAXED, __HIP_MEMORY_SCOPE_AGENT); }
__device__ __forceinline__ unsigned xb_xcc_id() { return (unsigned)__builtin_amdgcn_s_getreg((3 << 11) | 20) & 0xFu; }
#define XB_SPIN(cond, bar) do { unsigned _sp = 0; while (cond) { __builtin_amdgcn_s_sleep(1); \
    if ((++_sp & 255u) == 0u) { if (xb_ld(&(bar)[XB_TMO])) break; if (_sp > XB_SPIN_CAP) { atomicAdd(&(bar)[XB_TMO], 1u); break; } } } } while (0)
struct XcdBarrier { unsigned* bar; unsigned x; volatile LAS unsigned* st; };
__device__ __forceinline__ XcdBarrier xcd_barrier_post(unsigned* bar, volatile LAS unsigned* st) {
    XcdBarrier b; b.bar = bar; b.x = xb_xcc_id(); b.st = st;
    if (threadIdx.x == 0) (void)xb_add(&bar[XB_XCNT(b.x)], 1u);
    return b;
}
__device__ __forceinline__ void xcd_barrier_complete(unsigned* bar, unsigned x, unsigned& nloc, unsigned& nx) {
    const unsigned G = gridDim.x * gridDim.y * gridDim.z;
    unsigned sum, cnt, mine, sp = 0u;
    for (;;) {
        sum = 0u; cnt = 0u; mine = 0u;
#pragma unroll
        for (unsigned j = 0; j < 16; ++j) { const unsigned c = xb_ld(&bar[XB_XCNT(j)]); sum += c; cnt += (c > 0u) ? 1u : 0u; mine = (j == x) ? c : mine; }
        if (sum == G) break;
        __builtin_amdgcn_s_sleep(1);
        if ((++sp & 255u) == 0u) { if (xb_ld(&bar[XB_TMO])) break; if (sp > XB_SPIN_CAP) { atomicAdd(&bar[XB_TMO], 1u); break; } }
    }
    nloc = mine > 0u ? mine : 1u; nx = cnt > 0u ? cnt : 1u;
}
__device__ __forceinline__ void xcd_barrier(const XcdBarrier& b) {
    asm volatile("s_waitcnt vmcnt(0)" ::: "memory");
    __syncthreads();
    if (threadIdx.x == 0) {
        unsigned* bar = b.bar;
        __builtin_amdgcn_s_waitcnt(0);
        unsigned nloc = b.st[0], nx = b.st[1];
        if (nloc == 0u) { xcd_barrier_complete(bar, b.x, nloc, nx); b.st[0] = nloc; b.st[1] = nx; }
        const unsigned old = xb_add(&bar[XB_XSUB(b.x)], 1u);
        const unsigned gen = old / nloc;
        if (old + 1u == (gen + 1u) * nloc) {
            __builtin_amdgcn_fence(__ATOMIC_RELEASE, "agent");
            asm volatile("s_waitcnt vmcnt(0)" ::: "memory");
            const unsigned og = xb_add(&bar[XB_TOP], 1u);
            const unsigned tg = og / nx;
            if (og + 1u == (tg + 1u) * nx) xb_add(&bar[XB_TOPGEN], 1u);
            else XB_SPIN(xb_ld(&bar[XB_TOPGEN]) == tg, bar);
            __builtin_amdgcn_fence(__ATOMIC_ACQUIRE, "agent");
            xb_add(&bar[XB_XGEN(b.x)], 1u);
            asm volatile("s_waitcnt vmcnt(0)" ::: "memory");
        } else {
            XB_SPIN(xb_ld(&bar[XB_XGEN(b.x)]) == gen, bar);
            __builtin_amdgcn_fence(__ATOMIC_ACQUIRE, "agent");
            asm volatile("s_waitcnt vmcnt(0)" ::: "memory");
        }
    }
    __syncthreads();
}

__global__ void __launch_bounds__(NTHREADS, 2) mk_fwd(Params P_arg) {
    extern __shared__ __attribute__((aligned(16))) unsigned char lds_raw[];
    LAS unsigned char* lds = (LAS unsigned char*)lds_raw;
    cg::grid_group grid = cg::this_grid();
    volatile LAS unsigned* bar_st = (volatile LAS unsigned*)(lds + LDS_BYTES - 64);
    if (threadIdx.x == 0) { bar_st[0] = 0u; bar_st[1] = 0u; }
    __syncthreads();
    const XcdBarrier xbar = xcd_barrier_post((unsigned*)(P_arg.ws + WS_CTL), bar_st);
    for (int ph = P_arg.ph_lo; ph < P_arg.ph_hi; ++ph) {
        bool did = true;
        int nrep = 1;
        {
            const int s_ = (ph >= 1 && ph <= 40) ? (ph - 1) % 10 : -1, L_ = (ph - 1) / 10;
            if (PROBE_DUP == 1 && (s_ == 0)) nrep = 2;
            if (PROBE_DUP == 2 && ph == 0) nrep = 2;
            if (PROBE_DUP == 3 && (s_ == 3 || s_ == 5) && !(L_ & 1)) nrep = 2;
            if (PROBE_DUP == 4 && s_ == 3 && (L_ & 1)) nrep = 2;
            if (PROBE_DUP == 6 && s_ == 2) nrep = 2;
        }
#pragma nounroll
        for (int rep_ = 0; rep_ < nrep; ++rep_) {
        const __attribute__((address_space(4))) Params* Pk = (const __attribute__((address_space(4))) Params*)__builtin_amdgcn_kernarg_segment_ptr();
        asm volatile("" : "+s"(Pk));
        const Params& P = *(const Params*)Pk;
        unsigned char* ws = P.ws;
        float* ssq = (float*)(ws + WS_SSQ);
        bf16_t* XB = (bf16_t*)(ws + WS_XB); bf16_t* XBALT = (bf16_t*)(ws + WS_MIX); bf16_t* HZ = (bf16_t*)(ws + WS_HZ); bf16_t* MIX = (bf16_t*)(ws + WS_MIX);
        bf16_t* PP = (bf16_t*)(ws + WS_PP);
        bf16_t* XLO = (bf16_t*)P.out;
        if (ph == 0) phase_prepass(P, lds);
        else if (ph == 41) phase_final(P);
        else {
            const int L = (ph - 1) / 10, s = (ph - 1) % 10, even = !(L & 1), eo = L >> 1;
            if (s == 3) {
                if (even) { phase_g1(P, lds, eo); phase_l1(P, lds, eo); } else phase_attn(P, lds, eo);
            } else if (s == 4) {
                if (even) { phase_g2(P); phase_l2(P); } else did = false;
            } else if (s == 5) {
                if (even) { phase_g3(P, lds, eo); phase_l3(P); } else did = false;
            } else {
                const int ng = (s == 7) ? 2 : 1;
#pragma nounroll
                for (int gi = 0; gi < ng; ++gi) {
                    pg8::Epi E; E.mode = 0; E.ssq_in = nullptr; E.ssq_out = nullptr; E.xin = nullptr; E.hin = nullptr; E.lin = nullptr; E.lout = nullptr; E.xb = nullptr; E.ob = nullptr; E.ldo = 0; E.of = nullptr; E.bias = nullptr; E.alpha = 1.0f;
                    const bf16_t* A = XB; const bf16_t* Bt = nullptr; int N = 1024, K = 1024;
                    if (gi == 1) {
                        E.mode = 2; E.ob = PP; A = (const bf16_t*)(ws + WS_PB) + (size_t)L * T * 256; Bt = (const bf16_t*)(ws + WS_WPP) + (size_t)L * 1024 * 256; N = 1024; K = 256;
                    } else if (s == 0 || s == 7) {
                        const int w = (s == 7);
                        E.mode = 0; E.ssq_in = ssq + (size_t)((4 * L + (w ? 2 : 0)) & 1) * T * 16; E.ob = HZ; E.ldo = FF;
                        A = w ? XB : XBALT; Bt = (const bf16_t*)(ws + WS_WUP) + (size_t)(2 * L + w) * 5632 * 1024; N = 5632; K = 1024;
                    } else if (s == 1 || s == 8) {
                        const int w = (s == 8);
                        E.mode = (L == 0 && !w) ? 5 : 3; E.xin = P.in[0]; E.hin = w ? XB : XBALT; E.lin = XLO; E.lout = XLO; E.xb = XB; E.ssq_out = ssq + (size_t)((4 * L + (w ? 3 : 1)) & 1) * T * 16; E.alpha = 0.5f;
                        A = HZ; Bt = (const bf16_t*)(ws + WS_WDN) + (size_t)(2 * L + w) * 1024 * 2816; N = 1024; K = 2816;
                    } else if (s == 2) {
                        E.mode = 1; E.ssq_in = ssq + (size_t)((4 * L + 1) & 1) * T * 16; E.ob = HZ; A = XB; K = 1024;
                        if (even) { E.ldo = ZW; Bt = (const bf16_t*)(ws + WS_WIN) + (size_t)eo * 2816 * 1024; N = 2816; }
                        else { E.ldo = QKVW; E.bias = P.in[29] + eo * 1536; Bt = (const bf16_t*)(ws + WS_WQKV) + (size_t)eo * 1536 * 1024; N = 1536; }
                    } else if (s == 6) {
                        E.mode = 3; E.hin = XB; E.lin = XLO; E.lout = XLO; E.xb = XB; E.ssq_out = ssq + (size_t)((4 * L + 2) & 1) * T * 16; E.alpha = 1.0f;
                        E.bias = even ? nullptr : P.in[31] + eo * 1024;
                        A = MIX; Bt = even ? (const bf16_t*)(ws + WS_WOUT) + (size_t)eo * 1024 * 1024 : (const bf16_t*)(ws + WS_WO) + (size_t)eo * 1024 * 1024; N = 1024; K = 1024;
                    } else {
                        E.mode = 4; E.ssq_in = ssq + (size_t)((4 * L + 3) & 1) * T * 16; E.ssq_out = ssq + (size_t)((4 * L + 4) & 1) * T * 16; E.ob = PP; E.hin = XB; E.lin = XLO; E.lout = (L == 3) ? HZ : XLO; E.xb = XBALT;
                        A = XB; Bt = (const bf16_t*)(ws + WS_WPG) + (size_t)L * 1024 * 1024; N = 1024; K = 1024;
                    }
                    if (PROBE_DUP == 7 && s == 1) { pg8::Epi Ed = E; Ed.mode = 2; Ed.ob = PP; run_gemm(lds, A, Bt, N, K, Ed); }
                    if (PROBE_DUP == 8 && s == 6) { pg8::Epi Ed = E; Ed.mode = 2; Ed.ob = PP; run_gemm(lds, A, Bt, N, K, Ed); }
                    run_gemm(lds, A, Bt, N, K, E, (gi == 1 && gridDim.x == 256) ? 128 : 0);
                    if (s == 0) layer_small_cvt(P, L, gridDim.x == 256 ? 128 : 0);
                    if (s == 2 && even) first_token_qk(P, lds, L, gridDim.x == 256 ? 192 : 0);
                }
            }
        }
        }
        if (did && ph + 1 < P_arg.ph_hi) { if (ph == 99) grid.sync(); else xcd_barrier(xbar); if (PROBE_DUP == 5) xcd_barrier(xbar); }
    }
}

extern "C" void kernel_launch(void* const* d_in, const int* in_sizes, int n_in, void* d_out, int out_size, void* d_ws, size_t ws_size, hipStream_t stream) {
    static int grid = 0;
    if (grid == 0) {
        if (n_in != 33 || out_size != T * D || ws_size < WS_END) { fprintf(stderr, "kernel_launch: unexpected shapes (n_in %d out %d ws %zu need %zu)\n", n_in, out_size, ws_size, (size_t)WS_END); grid = -1; return; }
        int dev = 0, cus = 0, per_cu = 0;
        hipGetDevice(&dev); hipDeviceGetAttribute(&cus, hipDeviceAttributeMultiprocessorCount, dev);
        if (hipFuncSetAttribute((const void*)mk_fwd, hipFuncAttributeMaxDynamicSharedMemorySize, LDS_BYTES) != hipSuccess) { fprintf(stderr, "hipFuncSetAttribute failed\n"); grid = -1; return; }
        if (hipOccupancyMaxActiveBlocksPerMultiprocessor(&per_cu, (const void*)mk_fwd, NTHREADS, LDS_BYTES) != hipSuccess || per_cu < 1) per_cu = 1;
        (void)hipGetLastError();
        grid = cus * 1;
    }
    if (grid < 0) return;
    if (hipMemsetAsync((char*)d_ws + WS_CTL, 0, CTL_BYTES, stream) != hipSuccess) { fprintf(stderr, "memset failed\n"); return; }
    Params p{};
    for (int i = 0; i < 33; ++i) p.in[i] = (const float*)d_in[i];
    p.out = (float*)d_out; p.ws = (unsigned char*)d_ws;
#if COOP
    p.ph_lo = 0; p.ph_hi = 42;
    void* args[] = {&p};
    hipError_t e = hipLaunchCooperativeKernel((const void*)mk_fwd, dim3(grid), dim3(NTHREADS), args, LDS_BYTES, stream);
    if (e != hipSuccess) fprintf(stderr, "cooperative launch failed: %s (grid %d)\n", hipGetErrorString(e), grid);
#else
    for (int ph = 0; ph < 42; ++ph) {
        if (ph >= 1 && ph <= 40) { const int L = (ph - 1) / 10, s = (ph - 1) % 10; if ((L & 1) && (s == 4 || s == 5)) continue; }
        p.ph_lo = ph; p.ph_hi = ph + 1;
        hipLaunchKernelGGL(mk_fwd, dim3(grid), dim3(NTHREADS), LDS_BYTES, stream, p);
    }
#endif
}
```
